# Optimizing an MI355X kernel written in HIP

```python
import jax, jax.numpy as jnp
from jax import lax
import numpy as np

D_MODEL = 1024
BATCH = 2
SEQ = 8192
DEPTH = 1

PLE_DIM = 256
EPS = 1e-6
HG_HEADS = 4
HG_DK = 128
HG_DV = 128
HG_WIDTH = HG_HEADS * HG_DK
HG_CHUNK = 64
RET_HEADS = 4
RET_DK = 128
RET_DV = 256
RET_QK_WIDTH = RET_HEADS * RET_DK
RET_V_WIDTH = RET_HEADS * RET_DV
RET_CHUNK = 128
ROPE_BASE = 10000.0
IN_SPLITS = [HG_WIDTH, HG_WIDTH, HG_WIDTH, HG_WIDTH,
             RET_QK_WIDTH, RET_QK_WIDTH, RET_V_WIDTH, RET_V_WIDTH,
             D_MODEL, D_MODEL]
IN_TOTAL = sum(IN_SPLITS)
N_GROUPS = 4
EXPERTS_PER_GROUP = 8
N_EXPERTS = N_GROUPS * EXPERTS_PER_GROUP
TOP_K_IN_GROUP = 2
D_EXPERT = 256

kernel_name = 'hybrid_hgrn2_retention_hmoe_block'


def rmsnorm(x, g):
    xf = x.astype(jnp.float32)
    y = xf * lax.rsqrt(jnp.mean(xf * xf, axis=-1, keepdims=True) + EPS)
    return (y * g.astype(jnp.float32)).astype(x.dtype)


def _chunks(t, n_heads, chunk):
    b, s, w = t.shape
    return t.reshape(b, s // chunk, chunk, n_heads, w // n_heads).transpose(1, 0, 3, 2, 4)


def _unchunks(t):
    nc, b, h, c, d = t.shape
    return t.transpose(1, 0, 3, 2, 4).reshape(b, nc * c, h, d)


def hgrn2_lower_bound(lb_logits, layer):
    sm = jax.nn.softmax(lb_logits.astype(jnp.float32), axis=0)
    return jnp.cumsum(sm, axis=0)[layer]


def hgrn2_mix(q, f_logit, i, g, lb, norm_g):
    B, S, _ = q.shape
    C = HG_CHUNK
    qf = jax.nn.silu(q.astype(jnp.float32))
    z = f_logit.astype(jnp.float32)
    log_f = jnp.logaddexp(jnp.log(lb), jnp.log1p(-lb) + jax.nn.log_sigmoid(z))
    k = -jnp.expm1(log_f)
    qc = _chunks(qf, HG_HEADS, C)
    kc = _chunks(k, HG_HEADS, C)
    lc = _chunks(log_f, HG_HEADS, C)
    vc = _chunks(i.astype(jnp.float32), HG_HEADS, C)
    causal = jnp.tril(jnp.ones((C, C), dtype=bool))[:, :, None]

    def step(state, inp):
        q_, k_, lf, v_ = inp
        b = jnp.cumsum(lf, axis=2)
        diff = b[:, :, :, None, :] - b[:, :, None, :, :]
        decay = jnp.exp(jnp.where(causal, diff, -jnp.inf))
        scores = jnp.einsum('bhtk,bhsk,bhtsk->bhts', q_, k_, decay)
        o = (jnp.einsum('bhts,bhsv->bhtv', scores, v_)
             + jnp.einsum('bhtk,bhkv->bhtv', q_ * jnp.exp(b), state))
        b_last = b[:, :, -1, :]
        new_state = (jnp.exp(b_last)[..., None] * state
                     + jnp.einsum('bhsk,bhsv->bhkv', k_ * jnp.exp(b_last[:, :, None, :] - b), v_))
        return new_state, o

    s0 = jnp.zeros((B, HG_HEADS, HG_DK, HG_DV), jnp.float32)
    _, o = lax.scan(step, s0, (qc, kc, lc, vc))
    o = rmsnorm(_unchunks(o), norm_g).reshape(B, S, HG_HEADS * HG_DV)
    return (o * jax.nn.silu(g.astype(jnp.float32))).astype(q.dtype)


def rotary(t, pos):
    d = t.shape[-1]
    inv = ROPE_BASE ** (-jnp.arange(0, d, 2, dtype=jnp.float32) / d)
    ang = pos[:, None] * inv[None, :]
    cos = jnp.cos(ang)[None, :, None, :]
    sin = jnp.sin(ang)[None, :, None, :]
    t1, t2 = t[..., : d // 2], t[..., d // 2:]
    return jnp.concatenate([t1 * cos - t2 * sin, t1 * sin + t2 * cos], axis=-1)


def retention_mix(q, k, v, g, pos, norm_g):
    B, S, _ = q.shape
    C = RET_CHUNK
    qh = rotary(q.astype(jnp.float32).reshape(B, S, RET_HEADS, RET_DK), pos) * (RET_DK ** -0.5)
    kh = rotary(k.astype(jnp.float32).reshape(B, S, RET_HEADS, RET_DK), pos)
    qc = _chunks(qh.reshape(B, S, RET_QK_WIDTH), RET_HEADS, C)
    kc = _chunks(kh.reshape(B, S, RET_QK_WIDTH), RET_HEADS, C)
    vc = _chunks(v.astype(jnp.float32), RET_HEADS, C)
    lg = jnp.log1p(-jnp.exp2(-5.0 - jnp.arange(RET_HEADS, dtype=jnp.float32)))
    idx = jnp.arange(C, dtype=jnp.float32)
    rel = idx[:, None] - idx[None, :]
    intra = jnp.exp(jnp.where(rel >= 0, rel[None] * lg[:, None, None], -jnp.inf))
    inter = jnp.exp((idx[None, :] + 1.0) * lg[:, None])
    to_state = jnp.exp((C - 1.0 - idx[None, :]) * lg[:, None])
    chunk_decay = jnp.exp(C * lg)

    def step(R, inp):
        q_, k_, v_ = inp
        att = jnp.einsum('bhtk,bhsk->bhts', q_, k_) * intra
        o = (jnp.einsum('bhts,bhsv->bhtv', att, v_)
             + jnp.einsum('bhtk,bhkv->bhtv', q_, R) * inter[:, :, None])
        R = (chunk_decay[:, None, None] * R
             + jnp.einsum('bhsk,bhsv->bhkv', k_ * to_state[:, :, None], v_))
        return R, o

    r0 = jnp.zeros((B, RET_HEADS, RET_DK, RET_DV), jnp.float32)
    _, o = lax.scan(step, r0, (qc, kc, vc))
    o = rmsnorm(_unchunks(o), norm_g).reshape(B, S, RET_V_WIDTH)
    return (o * jax.nn.silu(g.astype(jnp.float32))).astype(q.dtype)


def hier_moe(h, w_rg, b_rg, w_re, b_re, w_gate, w_up, w_down):
    T, D = h.shape
    g_logits = (h @ w_rg).astype(jnp.float32) + b_rg.astype(jnp.float32)
    g_prob = jax.nn.softmax(g_logits, axis=-1)
    g_idx = jnp.argmax(g_logits, axis=-1)
    g_w = jnp.take_along_axis(g_prob, g_idx[:, None], axis=-1)[:, 0]
    e_logits = ((h @ w_re).astype(jnp.float32) + b_re.astype(jnp.float32)).reshape(T, N_GROUPS, EXPERTS_PER_GROUP)
    e_logits = jnp.take_along_axis(e_logits, g_idx[:, None, None], axis=1)[:, 0]
    top_l, top_i = lax.top_k(e_logits, TOP_K_IN_GROUP)
    w = jax.nn.softmax(top_l, axis=-1) * g_w[:, None]
    eid = (g_idx[:, None] * EXPERTS_PER_GROUP + top_i).reshape(-1)
    order = jnp.argsort(eid)
    xs = h[order // TOP_K_IN_GROUP]
    sizes = jnp.bincount(eid, length=N_EXPERTS).astype(jnp.int32)
    a = lax.ragged_dot(xs, w_gate, sizes)
    u = lax.ragged_dot(xs, w_up, sizes)
    ys = lax.ragged_dot(jax.nn.silu(a) * u, w_down, sizes)
    y = jnp.zeros_like(ys).at[order].set(ys).reshape(T, TOP_K_IN_GROUP, D)
    return jnp.einsum('tkd,tk->td', y, w.astype(y.dtype))


def setup_inputs(seed: int = 0) -> dict:
    key = jax.random.key(seed)
    ks = jax.random.split(key, 24)
    f32 = jnp.float32

    def nrm(k, shape, fan):
        return jax.random.normal(k, shape, f32) * (fan ** -0.5)

    def gain(k, shape):
        return 1.0 + 0.02 * jax.random.normal(k, shape, f32)

    return {
        'x': jax.random.normal(ks[0], (BATCH, SEQ, D_MODEL), f32),
        'p': jax.random.normal(ks[1], (DEPTH, BATCH, SEQ, PLE_DIM), f32),
        'mix_norm': gain(ks[2], (DEPTH, D_MODEL)),
        'w_in': nrm(ks[3], (DEPTH, D_MODEL, IN_TOTAL), D_MODEL),
        'hg_lb_logits': 0.5 * jax.random.normal(ks[4], (DEPTH + 1, HG_WIDTH), f32),
        'hg_norm': gain(ks[5], (DEPTH, HG_DV)),
        'ret_norm': gain(ks[6], (DEPTH, RET_DV)),
        'w_branch_a': nrm(ks[7], (DEPTH, HG_WIDTH, D_MODEL), HG_WIDTH),
        'w_branch_b': nrm(ks[8], (DEPTH, RET_V_WIDTH, D_MODEL), RET_V_WIDTH),
        'w_out': nrm(ks[9], (DEPTH, D_MODEL, D_MODEL), D_MODEL),
        'ffn_norm': gain(ks[10], (DEPTH, D_MODEL)),
        'w_router_group': nrm(ks[11], (DEPTH, D_MODEL, N_GROUPS), D_MODEL),
        'b_router_group': 0.01 * jax.random.normal(ks[12], (DEPTH, N_GROUPS), f32),
        'w_router_expert': nrm(ks[13], (DEPTH, D_MODEL, N_EXPERTS), D_MODEL),
        'b_router_expert': 0.01 * jax.random.normal(ks[14], (DEPTH, N_EXPERTS), f32),
        'w_expert_gate': nrm(ks[15], (DEPTH, N_EXPERTS, D_MODEL, D_EXPERT), D_MODEL),
        'w_expert_up': nrm(ks[16], (DEPTH, N_EXPERTS, D_MODEL, D_EXPERT), D_MODEL),
        'w_expert_down': nrm(ks[17], (DEPTH, N_EXPERTS, D_EXPERT, D_MODEL), D_EXPERT),
        'ple_norm': gain(ks[18], (DEPTH, D_MODEL)),
        'w_ple_gate': nrm(ks[19], (DEPTH, D_MODEL, D_MODEL), D_MODEL),
        'w_ple_proj': nrm(ks[20], (DEPTH, PLE_DIM, D_MODEL), PLE_DIM),
        'final_norm': gain(ks[21], (D_MODEL,)),
    }


def reference(x, p, mix_norm, w_in, hg_lb_logits, hg_norm, ret_norm, w_branch_a, w_branch_b, w_out,
              ffn_norm, w_router_group, b_router_group, w_router_expert, b_router_expert,
              w_expert_gate, w_expert_up, w_expert_down, ple_norm, w_ple_gate, w_ple_proj, final_norm):
    B, S, D = x.shape
    pos = jnp.arange(S, dtype=jnp.float32)
    split_at = [int(v) for v in np.cumsum(IN_SPLITS)[:-1]]
    for layer in range(DEPTH):
        h = rmsnorm(x, mix_norm[layer])
        proj = h @ w_in[layer]
        hq, hf, hi, hg, rq, rk, rv, rg, ga, gb = jnp.split(proj, split_at, axis=-1)
        lb = hgrn2_lower_bound(hg_lb_logits, layer)
        ya = hgrn2_mix(hq, hf, hi, hg, lb, hg_norm[layer])
        yb = retention_mix(rq, rk, rv, rg, pos, ret_norm[layer])
        merged = (jax.nn.sigmoid(ga) * (ya @ w_branch_a[layer])
                  + jax.nn.sigmoid(gb) * (yb @ w_branch_b[layer]))
        x = x + merged @ w_out[layer]
        h2 = rmsnorm(x, ffn_norm[layer]).reshape(B * S, D)
        x = x + hier_moe(h2, w_router_group[layer], b_router_group[layer], w_router_expert[layer],
                         b_router_expert[layer], w_expert_gate[layer], w_expert_up[layer],
                         w_expert_down[layer]).reshape(B, S, D)
        hp = rmsnorm(x, ple_norm[layer])
        x = x + jax.nn.sigmoid(hp @ w_ple_gate[layer]) * (p[layer] @ w_ple_proj[layer])
    return rmsnorm(x, final_norm)
```

```cpp
#include <hip/hip_runtime.h>
#include <cstdint>
#include <cstdio>

typedef unsigned short bf16_t;
typedef float f32x4 __attribute__((ext_vector_type(4)));
typedef unsigned u32x2 __attribute__((ext_vector_type(2)));

constexpr int M = 16384, D = 1024, SEQ = 8192, NIN = 7168, PLE = 256;
constexpr int NE = 32, DE = 256;
constexpr float EPS = 1e-6f;
constexpr int LIST_CAP = 32768;
constexpr int POS_CAP = 40960;

constexpr size_t MiB = 1u << 20;
constexpr size_t WS_CTL = 0;
constexpr size_t WS_SMALL = 1 * MiB;
constexpr size_t WS_LIST = 2 * MiB;
constexpr size_t WS_WA = 6 * MiB, WS_WB = 7 * MiB, WS_WO = 9 * MiB, WS_WPG = 11 * MiB, WS_WPP = 13 * MiB;
constexpr size_t WS_PB = 14 * MiB;
constexpr size_t WS_WIN = 22 * MiB;
constexpr size_t WS_QH = 36 * MiB, WS_VH = 52 * MiB, WS_GH = 68 * MiB, WS_RQ = 84 * MiB, WS_RK = 100 * MiB;
constexpr size_t WS_RV = 116 * MiB, WS_RG = 148 * MiB, WS_GA = 180 * MiB, WS_GB = 212 * MiB;
constexpr size_t WS_MG = 116 * MiB;
constexpr size_t WS_WGU = 84 * MiB;
constexpr size_t WS_WD = 36 * MiB;
constexpr size_t WS_H2 = 148 * MiB;
constexpr size_t WS_HM = 116 * MiB;
constexpr size_t WS_YS = 180 * MiB;
constexpr size_t WS_X2B = 148 * MiB;
constexpr size_t WS_PP = 52 * MiB;
constexpr size_t SM_RS1 = 0, SM_RS2 = 64 * 1024, SM_RS3 = 128 * 1024, SM_EID = 192 * 1024, SM_WGT = 320 * 1024, SM_LB = 448 * 1024;
constexpr size_t SM_ROWMAP = 512 * 1024;
constexpr size_t SM_TILEE = 700 * 1024;
constexpr int CW_CNT = 1024;

__device__ __forceinline__ unsigned f2bf(float f) { unsigned u = __float_as_uint(f); return (u + 0x7fffu + ((u >> 16) & 1u)) >> 16; }
__device__ __forceinline__ float bf2f(unsigned short h) { return __uint_as_float(((unsigned)h) << 16); }
__device__ __forceinline__ unsigned pk2(float lo, float hi) { return f2bf(lo) | (f2bf(hi) << 16); }
__device__ __forceinline__ float siluf(float v) { return v / (1.f + __expf(-v)); }
__device__ __forceinline__ float sigmf(float v) { return 1.f / (1.f + __expf(-v)); }
__device__ __forceinline__ void st4bf(bf16_t* p, f32x4 v) { u32x2 w; w.x = pk2(v[0], v[1]); w.y = pk2(v[2], v[3]); *(u32x2*)p = w; }
__device__ __forceinline__ f32x4 ld4bf(const bf16_t* p) { u32x2 w = *(const u32x2*)p; f32x4 r; r[0] = __uint_as_float(w.x << 16); r[1] = __uint_as_float(w.x & 0xffff0000u); r[2] = __uint_as_float(w.y << 16); r[3] = __uint_as_float(w.y & 0xffff0000u); return r; }
__device__ __forceinline__ float wave_sum(float v) {
#pragma unroll
    for (int o = 1; o < 64; o <<= 1) v += __shfl_xor(v, o);
    return v;
}
__device__ __forceinline__ float gamma_lg(int h) { return log1pf(-exp2f(-5.f - (float)h)); }

struct EpiP1 {
    const float* rs1; const float* lb; float* LF;
    bf16_t *QH, *VH, *GH, *RQ, *RK, *RV, *RG, *GA, *GB;
    __device__ __forceinline__ void operator()(int m, int c, f32x4 v) const {
        const float rs = rs1[m]; v = v * rs;
        if (c < 512) { f32x4 o; for (int j = 0; j < 4; ++j) o[j] = siluf(v[j]); st4bf(QH + (size_t)m * 512 + c, o); }
        else if (c < 1024) { c -= 512; const f32x4 l4 = *(const f32x4*)(lb + c); f32x4 o;
            for (int j = 0; j < 4; ++j) { const float e = (1.f - l4[j]) / (1.f + __expf(v[j])); o[j] = log1pf(-e); }
            *(f32x4*)(LF + (size_t)m * 512 + c) = o; }
        else if (c < 1536) { st4bf(VH + (size_t)m * 512 + (c - 1024), v); }
        else if (c < 2048) { f32x4 o; for (int j = 0; j < 4; ++j) o[j] = siluf(v[j]); st4bf(GH + (size_t)m * 512 + (c - 1536), o); }
        else if (c < 3072) { const bool isk = c >= 2560; const int cc = (c - 2048) & 511, h = cc >> 7, wc = cc & 127, i0 = wc >> 1;
            const int t = m & (SEQ - 1), tm = t & 127; const float lg = gamma_lg(h);
            const float sc = isk ? __expf(-(float)tm * lg) : 0.08838834764831845f * __expf((float)tm * lg);
            f32x4 o;
            for (int p = 0; p < 2; ++p) { const float inv = exp2f(-(float)(i0 + p) * (13.287712379549449f / 64.f)); const float ang = (float)t * inv;
                float sn, cs; sincosf(ang, &sn, &cs); const float a = v[2 * p], b = v[2 * p + 1];
                o[2 * p] = (a * cs - b * sn) * sc; o[2 * p + 1] = (a * sn + b * cs) * sc; }
            st4bf((isk ? RK : RQ) + (size_t)m * 512 + cc, o); }
        else if (c < 4096) { st4bf(RV + (size_t)m * 1024 + (c - 3072), v); }
        else if (c < 5120) { f32x4 o; for (int j = 0; j < 4; ++j) o[j] = siluf(v[j]); st4bf(RG + (size_t)m * 1024 + (c - 4096), o); }
        else if (c < 6144) { f32x4 o; for (int j = 0; j < 4; ++j) o[j] = sigmf(v[j]); st4bf(GA + (size_t)m * 1024 + (c - 5120), o); }
        else { f32x4 o; for (int j = 0; j < 4; ++j) o[j] = sigmf(v[j]); st4bf(GB + (size_t)m * 1024 + (c - 6144), o); }
    }
};
struct EpiGateMul {
    const bf16_t* G; bf16_t* T;
    __device__ __forceinline__ void operator()(int m, int c, f32x4 v) const { const f32x4 g = ld4bf(G + (size_t)m * 1024 + c); st4bf(T + (size_t)m * 1024 + c, g * v); }
};
struct EpiGateMulAdd {
    const bf16_t* G; bf16_t* T;
    __device__ __forceinline__ void operator()(int m, int c, f32x4 v) const { const f32x4 g = ld4bf(G + (size_t)m * 1024 + c); const f32x4 t = ld4bf(T + (size_t)m * 1024 + c); st4bf(T + (size_t)m * 1024 + c, t + g * v); }
};
struct EpiResid {
    const float* x; float* out;
    __device__ __forceinline__ void operator()(int m, int c, f32x4 v) const { const f32x4 r = *(const f32x4*)(x + (size_t)m * 1024 + c); *(f32x4*)(out + (size_t)m * 1024 + c) = r + v; }
};
struct EpiStoreBf {
    bf16_t* T;
    __device__ __forceinline__ void operator()(int m, int c, f32x4 v) const { st4bf(T + (size_t)m * 1024 + c, v); }
};
struct EpiPle {
    const bf16_t* PP; float* x;
    __device__ __forceinline__ void operator()(int m, int c, f32x4 v) const { const f32x4 pp = ld4bf(PP + (size_t)m * 1024 + c); f32x4 r = *(const f32x4*)(x + (size_t)m * 1024 + c);
        for (int j = 0; j < 4; ++j) r[j] += sigmf(v[j]) * pp[j]; *(f32x4*)(x + (size_t)m * 1024 + c) = r; }
};
struct EpiDown {
    const int* rowmap; const float* wgt; bf16_t* YS;
    __device__ __forceinline__ void operator()(int pos, int c, f32x4 v) const { const int a = rowmap[pos]; if (a < 0) return; const float w = wgt[a]; st4bf(YS + (size_t)a * 1024 + c, v * w); }
};

template <class Epi>
__global__ __launch_bounds__(256) void naive_gemm(const bf16_t* A, const bf16_t* Bt, int K_, Epi epi, const int* tile_grp, size_t strideB) {
    __shared__ float As[32][65]; __shared__ float Bs[32][65];
    const int tx = threadIdx.x & 15, ty = threadIdx.x >> 4; const int m0 = blockIdx.y * 64, n0 = blockIdx.x * 64;
    if (tile_grp) { const int nt = tile_grp[255]; if ((m0 >> 8) >= nt) return; Bt += (size_t)tile_grp[m0 >> 8] * strideB; }
    float acc[4][4];
    for (int i = 0; i < 4; ++i) for (int j = 0; j < 4; ++j) acc[i][j] = 0.f;
    for (int k0 = 0; k0 < K_; k0 += 32) {
        for (int i = threadIdx.x; i < 2048; i += 256) { const int r = i >> 5, c = i & 31;
            As[c][r] = bf2f(A[(size_t)(m0 + r) * K_ + k0 + c]); Bs[c][r] = bf2f(Bt[(size_t)(n0 + r) * K_ + k0 + c]); }
        __syncthreads();
#pragma unroll 8
        for (int kk = 0; kk < 32; ++kk) { float a[4], b[4];
            for (int i = 0; i < 4; ++i) { a[i] = As[kk][ty * 4 + i]; b[i] = Bs[kk][tx * 4 + i]; }
            for (int i = 0; i < 4; ++i) for (int j = 0; j < 4; ++j) acc[i][j] += a[i] * b[j]; }
        __syncthreads();
    }
    for (int i = 0; i < 4; ++i) epi(m0 + ty * 4 + i, n0 + tx * 4, (f32x4){acc[i][0], acc[i][1], acc[i][2], acc[i][3]});
}
__global__ __launch_bounds__(256) void naive_gateup(const bf16_t* H2, const bf16_t* WGU, const int* rowmap, const int* tile_grp, bf16_t* HM) {
    __shared__ float As[32][65]; __shared__ float Bg[32][65]; __shared__ float Bu[32][65];
    const int tx = threadIdx.x & 15, ty = threadIdx.x >> 4; const int m0 = blockIdx.y * 64, c0 = blockIdx.x * 64;
    const int nt = tile_grp[255]; if ((m0 >> 8) >= nt) return;
    const bf16_t* W = WGU + (size_t)tile_grp[m0 >> 8] * 512 * 1024;
    const int pn = c0 >> 7, cl = c0 & 127;
    float ag[4][4], au[4][4];
    for (int i = 0; i < 4; ++i) for (int j = 0; j < 4; ++j) { ag[i][j] = 0.f; au[i][j] = 0.f; }
    for (int k0 = 0; k0 < 1024; k0 += 32) {
        for (int i = threadIdx.x; i < 2048; i += 256) { const int r = i >> 5, c = i & 31; const int a = rowmap[m0 + r];
            As[c][r] = a >= 0 ? bf2f(H2[(size_t)(a >> 1) * 1024 + k0 + c]) : 0.f;
            Bg[c][r] = bf2f(W[(size_t)(256 * pn + cl + r) * 1024 + k0 + c]); Bu[c][r] = bf2f(W[(size_t)(256 * pn + 128 + cl + r) * 1024 + k0 + c]); }
        __syncthreads();
#pragma unroll 4
        for (int kk = 0; kk < 32; ++kk) { float a[4], g[4], u[4];
            for (int i = 0; i < 4; ++i) { a[i] = As[kk][ty * 4 + i]; g[i] = Bg[kk][tx * 4 + i]; u[i] = Bu[kk][tx * 4 + i]; }
            for (int i = 0; i < 4; ++i) for (int j = 0; j < 4; ++j) { ag[i][j] += a[i] * g[j]; au[i][j] += a[i] * u[j]; } }
        __syncthreads();
    }
    for (int i = 0; i < 4; ++i) { f32x4 o; for (int j = 0; j < 4; ++j) o[j] = siluf(ag[i][j]) * au[i][j]; st4bf(HM + (size_t)(m0 + ty * 4 + i) * 256 + c0 + tx * 4, o); }
}

__global__ __launch_bounds__(256) void k_conv_x(const float* x, bf16_t* XB, float* rs1) {
    const int m = blockIdx.x * 4 + (threadIdx.x >> 6), lane = threadIdx.x & 63;
    const f32x4* xr = (const f32x4*)(x + (size_t)m * D) + lane; f32x4 v[4]; float s = 0.f;
    for (int j = 0; j < 4; ++j) { v[j] = xr[64 * j]; s += v[j][0] * v[j][0] + v[j][1] * v[j][1] + v[j][2] * v[j][2] + v[j][3] * v[j][3]; }
    s = wave_sum(s); if (lane == 0) rs1[m] = rsqrtf(s * (1.f / D) + EPS);
    for (int j = 0; j < 4; ++j) st4bf(XB + (size_t)m * D + lane * 4 + 256 * j, v[j]);
}
__global__ void k_conv_p(const float* p, bf16_t* PB, int n4) { const int i = blockIdx.x * blockDim.x + threadIdx.x; if (i < n4) st4bf(PB + (size_t)i * 4, ((const f32x4*)p)[i]); }
__global__ void k_conv_wt(const float* W, int K_, int N_, bf16_t* Wt, const float* gain, int mode) {
    const size_t idx = (size_t)blockIdx.x * blockDim.x + threadIdx.x; if (idx >= (size_t)K_ * N_) return;
    const int k = (int)(idx % K_), np = (int)(idx / K_); int n = np;
    if (mode == 1 && np >= 2048 && np < 3072) { const int base = np & ~127, w = np & 127; n = base + (w >> 1) + 64 * (w & 1); }
    const float g = gain ? gain[k] : 1.f; Wt[idx] = (bf16_t)f2bf(W[(size_t)k * N_ + n] * g);
}
__global__ void k_conv_gu(const float* wg, const float* wu, const float* g2, bf16_t* WGU) {
    const size_t idx = (size_t)blockIdx.x * blockDim.x + threadIdx.x; if (idx >= (size_t)NE * 512 * 1024) return;
    const int k = (int)(idx & 1023), np = (int)((idx >> 10) & 511), e = (int)(idx >> 19);
    const int pn = np >> 8, isup = (np >> 7) & 1, cl = np & 127, col = 128 * pn + cl;
    const float* src = isup ? wu : wg; WGU[idx] = (bf16_t)f2bf(src[((size_t)e * 1024 + k) * 256 + col] * g2[k]);
}
__global__ void k_conv_wd(const float* wd, bf16_t* WD) {
    const size_t idx = (size_t)blockIdx.x * blockDim.x + threadIdx.x; if (idx >= (size_t)NE * 1024 * 256) return;
    const int k = (int)(idx & 255), n = (int)((idx >> 8) & 1023), e = (int)(idx >> 18);
    WD[idx] = (bf16_t)f2bf(wd[((size_t)e * 256 + k) * 1024 + n]);
}
__global__ void k_consts(const float* lb_logits, float* lb) { const int c = threadIdx.x + blockIdx.x * blockDim.x; if (c < 512) { const float l0 = lb_logits[c], l1 = lb_logits[512 + c]; lb[c] = 1.f / (1.f + __expf(l1 - l0)); } }

__global__ __launch_bounds__(128) void naive_hgrn(const bf16_t* QH, const float* LF, const bf16_t* VH, bf16_t* GH, const float* hg_norm) {
    const int b = blockIdx.x >> 2, h = blockIdx.x & 3, v = threadIdx.x;
    __shared__ float sq[128], sf[128], sk[128], red[2];
    float S[128];
#pragma unroll
    for (int k = 0; k < 128; ++k) S[k] = 0.f;
    const float gn = hg_norm[v];
    for (int t = 0; t < SEQ; ++t) { const size_t o512 = (size_t)(b * SEQ + t) * 512 + h * 128 + v;
        const float lf = LF[o512]; sq[v] = bf2f(QH[o512]); sf[v] = __expf(lf); sk[v] = -expm1f(lf);
        const float vv = bf2f(VH[o512]);
        __syncthreads();
        float o = 0.f;
#pragma unroll
        for (int k = 0; k < 128; ++k) { S[k] = sf[k] * S[k] + sk[k] * vv; o += sq[k] * S[k]; }
        const float ss = wave_sum(o * o); if ((v & 63) == 0) red[v >> 6] = ss;
        __syncthreads();
        const float tot = red[0] + red[1];
        const float y = o * rsqrtf(tot * (1.f / 128.f) + EPS) * gn * bf2f(GH[o512]);
        GH[o512] = (bf16_t)f2bf(y);
    }
}
__global__ __launch_bounds__(256) void naive_ret(const bf16_t* RQ, const bf16_t* RK, const bf16_t* RV, bf16_t* RG, const float* ret_norm) {
    const int b = blockIdx.x >> 2, h = blockIdx.x & 3, v = threadIdx.x;
    __shared__ float sq[128], sk[128], red[4];
    float S[128];
#pragma unroll
    for (int k = 0; k < 128; ++k) S[k] = 0.f;
    const float gn = ret_norm[v]; const float lg = gamma_lg(h), gam = __expf(lg);
    for (int t = 0; t < SEQ; ++t) { const size_t m = (size_t)(b * SEQ + t); const int tm = t & 127;
        if (v < 128) { sq[v] = bf2f(RQ[m * 512 + h * 128 + v]) * __expf(-(float)tm * lg); sk[v] = bf2f(RK[m * 512 + h * 128 + v]) * __expf((float)tm * lg); }
        const float vv = bf2f(RV[m * 1024 + h * 256 + v]);
        __syncthreads();
        float o = 0.f;
#pragma unroll
        for (int k = 0; k < 128; ++k) { S[k] = gam * S[k] + sk[k] * vv; o += sq[k] * S[k]; }
        const float ss = wave_sum(o * o); if ((v & 63) == 0) red[v >> 6] = ss;
        __syncthreads();
        const float tot = (red[0] + red[1]) + (red[2] + red[3]);
        const size_t oi = m * 1024 + h * 256 + v;
        const float y = o * rsqrtf(tot * (1.f / 256.f) + EPS) * gn * bf2f(RG[oi]);
        RG[oi] = (bf16_t)f2bf(y);
    }
}
__global__ __launch_bounds__(256) void naive_router(const float* X1, const float* g2, const float* wrg, const float* brg, const float* wre, const float* bre,
                                                    bf16_t* H2, float* rs2, int* eid, float* wgt, int* cnt, int* list) {
    const int m = blockIdx.x * 4 + (threadIdx.x >> 6), lane = threadIdx.x & 63;
    const f32x4* xr = (const f32x4*)(X1 + (size_t)m * D) + lane; f32x4 v[4]; float s = 0.f;
    for (int j = 0; j < 4; ++j) { v[j] = xr[64 * j]; s += v[j][0] * v[j][0] + v[j][1] * v[j][1] + v[j][2] * v[j][2] + v[j][3] * v[j][3]; }
    s = wave_sum(s); const float rs = rsqrtf(s * (1.f / D) + EPS); if (lane == 0) rs2[m] = rs;
    float lg[36];
#pragma unroll
    for (int c = 0; c < 36; ++c) lg[c] = 0.f;
#pragma unroll
    for (int j = 0; j < 4; ++j) { st4bf(H2 + (size_t)m * D + lane * 4 + 256 * j, v[j] * rs);
#pragma unroll
        for (int q = 0; q < 4; ++q) { const int k = lane * 4 + 256 * j + q; const float hv = v[j][q] * rs * g2[k];
#pragma unroll
            for (int c = 0; c < 4; ++c) lg[c] += hv * wrg[k * 4 + c];
#pragma unroll
            for (int c = 0; c < 32; ++c) lg[4 + c] += hv * wre[k * 32 + c]; } }
#pragma unroll
    for (int c = 0; c < 36; ++c) lg[c] = wave_sum(lg[c]);
    if (lane == 0) {
        float gl[4];
#pragma unroll
        for (int c = 0; c < 4; ++c) gl[c] = lg[c] + brg[c];
        float gmax = gl[0]; int gi = 0;
#pragma unroll
        for (int c = 1; c < 4; ++c) if (gl[c] > gmax) { gmax = gl[c]; gi = c; }
        float den = 0.f;
#pragma unroll
        for (int c = 0; c < 4; ++c) den += __expf(gl[c] - gmax);
        const float gw = 1.f / den;
        float el[8];
#pragma unroll
        for (int c = 0; c < 8; ++c) { el[c] = 0.f;
#pragma unroll
            for (int g = 0; g < 4; ++g) if (g == gi) el[c] = lg[4 + g * 8 + c] + bre[g * 8 + c]; }
        float m1 = el[0]; int i1 = 0;
#pragma unroll
        for (int c = 1; c < 8; ++c) if (el[c] > m1) { m1 = el[c]; i1 = c; }
        float m2 = -3.0e38f; int i2 = 0;
#pragma unroll
        for (int c = 0; c < 8; ++c) if (c != i1 && el[c] > m2) { m2 = el[c]; i2 = c; }
        const float w1 = 1.f / (1.f + __expf(m2 - m1)), w2 = 1.f - w1;
        const int e1 = gi * 8 + i1, e2 = gi * 8 + i2;
        eid[2 * m] = e1; eid[2 * m + 1] = e2; wgt[2 * m] = w1 * gw; wgt[2 * m + 1] = w2 * gw;
        const int p1 = atomicAdd(&cnt[e1], 1); list[e1 * LIST_CAP + p1] = 2 * m;
        const int p2 = atomicAdd(&cnt[e2], 1); list[e2 * LIST_CAP + p2] = 2 * m + 1;
    }
}
__global__ __launch_bounds__(256) void k_plan(const int* cnt, const int* list, int* rowmap, int* tile_e) {
    __shared__ int off[33];
    if (threadIdx.x == 0) { int o = 0; for (int e = 0; e < NE; ++e) { off[e] = o; o += (cnt[e] + 255) & ~255; } off[32] = o; tile_e[255] = o >> 8; }
    __syncthreads();
    for (int e = 0; e < NE; ++e) { const int o = off[e], n = cnt[e], np = off[e + 1] - o;
        for (int i = threadIdx.x + blockIdx.x * 256; i < np; i += 256 * gridDim.x) { rowmap[o + i] = i < n ? list[e * LIST_CAP + i] : -1; if ((i & 255) == 0) tile_e[(o + i) >> 8] = e; } }
}
__global__ __launch_bounds__(256) void k_combine(float* X, const bf16_t* YS, bf16_t* X2B) {
    const int m = blockIdx.x * 4 + (threadIdx.x >> 6), lane = threadIdx.x & 63;
    f32x4* xr = (f32x4*)(X + (size_t)m * D) + lane; f32x4 v[4]; float s = 0.f;
    for (int j = 0; j < 4; ++j) { const int c = lane * 4 + 256 * j; v[j] = xr[64 * j] + ld4bf(YS + (size_t)(2 * m) * D + c) + ld4bf(YS + (size_t)(2 * m + 1) * D + c);
        s += v[j][0] * v[j][0] + v[j][1] * v[j][1] + v[j][2] * v[j][2] + v[j][3] * v[j][3]; }
    s = wave_sum(s); const float rs = rsqrtf(s * (1.f / D) + EPS);
    for (int j = 0; j < 4; ++j) { xr[64 * j] = v[j]; st4bf(X2B + (size_t)m * D + lane * 4 + 256 * j, v[j] * rs); }
}
__global__ __launch_bounds__(256) void k_final(float* X, const float* g) {
    const int m = blockIdx.x * 4 + (threadIdx.x >> 6), lane = threadIdx.x & 63;
    f32x4* xr = (f32x4*)(X + (size_t)m * D) + lane; f32x4 v[4]; float s = 0.f;
    for (int j = 0; j < 4; ++j) { v[j] = xr[64 * j]; s += v[j][0] * v[j][0] + v[j][1] * v[j][1] + v[j][2] * v[j][2] + v[j][3] * v[j][3]; }
    s = wave_sum(s); const float rs = rsqrtf(s * (1.f / D) + EPS);
    for (int j = 0; j < 4; ++j) { const f32x4 gg = *(const f32x4*)(g + lane * 4 + 256 * j); xr[64 * j] = v[j] * rs * gg; }
}

extern "C" void kernel_launch(void* const* d_in, const int* in_sizes, int n_in, void* d_out, int out_size, void* d_ws, size_t ws_size, hipStream_t stream) {
    const float* x = (const float*)d_in[0]; const float* p = (const float*)d_in[1]; const float* mix_norm = (const float*)d_in[2]; const float* w_in = (const float*)d_in[3];
    const float* lb_logits = (const float*)d_in[4]; const float* hg_norm = (const float*)d_in[5]; const float* ret_norm = (const float*)d_in[6];
    const float* w_a = (const float*)d_in[7]; const float* w_b = (const float*)d_in[8]; const float* w_o = (const float*)d_in[9]; const float* ffn_norm = (const float*)d_in[10];
    const float* wrg = (const float*)d_in[11]; const float* brg = (const float*)d_in[12]; const float* wre = (const float*)d_in[13]; const float* bre = (const float*)d_in[14];
    const float* weg = (const float*)d_in[15]; const float* weu = (const float*)d_in[16]; const float* wed = (const float*)d_in[17];
    const float* ple_norm = (const float*)d_in[18]; const float* wpg = (const float*)d_in[19]; const float* wpp = (const float*)d_in[20]; const float* final_norm = (const float*)d_in[21];
    unsigned char* ws = (unsigned char*)d_ws; float* out = (float*)d_out;
    int* ctl = (int*)(ws + WS_CTL); unsigned char* sm = ws + WS_SMALL;
    float* rs1 = (float*)(sm + SM_RS1); float* rs2 = (float*)(sm + SM_RS2); int* eid = (int*)(sm + SM_EID); float* wgt = (float*)(sm + SM_WGT); float* lb = (float*)(sm + SM_LB);
    int* rowmap = (int*)(sm + SM_ROWMAP); int* tile_e = (int*)(sm + SM_TILEE); int* list = (int*)(ws + WS_LIST); int* cnt = ctl + CW_CNT;
    bf16_t* WA = (bf16_t*)(ws + WS_WA); bf16_t* WB = (bf16_t*)(ws + WS_WB); bf16_t* WO = (bf16_t*)(ws + WS_WO); bf16_t* WPG = (bf16_t*)(ws + WS_WPG); bf16_t* WPP = (bf16_t*)(ws + WS_WPP);
    bf16_t* PB = (bf16_t*)(ws + WS_PB); bf16_t* WIN = (bf16_t*)(ws + WS_WIN);
    bf16_t* QH = (bf16_t*)(ws + WS_QH); bf16_t* VH = (bf16_t*)(ws + WS_VH); bf16_t* GH = (bf16_t*)(ws + WS_GH); bf16_t* RQ = (bf16_t*)(ws + WS_RQ); bf16_t* RK = (bf16_t*)(ws + WS_RK);
    bf16_t* RV = (bf16_t*)(ws + WS_RV); bf16_t* RG = (bf16_t*)(ws + WS_RG); bf16_t* GA = (bf16_t*)(ws + WS_GA); bf16_t* GB = (bf16_t*)(ws + WS_GB);
    bf16_t* MG = (bf16_t*)(ws + WS_MG); bf16_t* WGU = (bf16_t*)(ws + WS_WGU); bf16_t* WD = (bf16_t*)(ws + WS_WD); bf16_t* H2 = (bf16_t*)(ws + WS_H2);
    bf16_t* HM = (bf16_t*)(ws + WS_HM); bf16_t* YS = (bf16_t*)(ws + WS_YS); bf16_t* X2B = (bf16_t*)(ws + WS_X2B); bf16_t* PP = (bf16_t*)(ws + WS_PP);
    bf16_t* XB = (bf16_t*)out; float* LF = (float*)((unsigned char*)out + 32 * MiB);

    hipMemsetAsync(ws + WS_CTL, 0, 1 * MiB, stream);
    k_conv_x<<<M / 4, 256, 0, stream>>>(x, XB, rs1);
    k_conv_p<<<(M * PLE / 4 + 255) / 256, 256, 0, stream>>>(p, PB, M * PLE / 4);
    k_conv_wt<<<(unsigned)(((size_t)1024 * NIN + 255) / 256), 256, 0, stream>>>(w_in, 1024, NIN, WIN, mix_norm, 1);
    k_conv_wt<<<(512 * 1024 + 255) / 256, 256, 0, stream>>>(w_a, 512, 1024, WA, nullptr, 0);
    k_conv_wt<<<(1024 * 1024 + 255) / 256, 256, 0, stream>>>(w_b, 1024, 1024, WB, nullptr, 0);
    k_conv_wt<<<(1024 * 1024 + 255) / 256, 256, 0, stream>>>(w_o, 1024, 1024, WO, nullptr, 0);
    k_conv_wt<<<(1024 * 1024 + 255) / 256, 256, 0, stream>>>(wpg, 1024, 1024, WPG, ple_norm, 0);
    k_conv_wt<<<(256 * 1024 + 255) / 256, 256, 0, stream>>>(wpp, 256, 1024, WPP, nullptr, 0);
    k_consts<<<2, 256, 0, stream>>>(lb_logits, lb);
    { EpiP1 e{rs1, lb, LF, QH, VH, GH, RQ, RK, RV, RG, GA, GB}; naive_gemm<EpiP1><<<dim3(NIN / 64, M / 64), 256, 0, stream>>>(XB, WIN, 1024, e, nullptr, 0); }
    naive_hgrn<<<8, 128, 0, stream>>>(QH, LF, VH, GH, hg_norm);
    naive_ret<<<8, 256, 0, stream>>>(RQ, RK, RV, RG, ret_norm);
    { EpiGateMul e{GA, MG}; naive_gemm<EpiGateMul><<<dim3(1024 / 64, M / 64), 256, 0, stream>>>(GH, WA, 512, e, nullptr, 0); }
    { EpiGateMulAdd e{GB, MG}; naive_gemm<EpiGateMulAdd><<<dim3(1024 / 64, M / 64), 256, 0, stream>>>(RG, WB, 1024, e, nullptr, 0); }
    { EpiResid e{x, out}; naive_gemm<EpiResid><<<dim3(1024 / 64, M / 64), 256, 0, stream>>>(MG, WO, 1024, e, nullptr, 0); }
    k_conv_gu<<<(unsigned)(((size_t)NE * 512 * 1024 + 255) / 256), 256, 0, stream>>>(weg, weu, ffn_norm, WGU);
    k_conv_wd<<<(unsigned)(((size_t)NE * 1024 * 256 + 255) / 256), 256, 0, stream>>>(wed, WD);
    naive_router<<<M / 4, 256, 0, stream>>>(out, ffn_norm, wrg, brg, wre, bre, H2, rs2, eid, wgt, cnt, list);
    k_plan<<<64, 256, 0, stream>>>(cnt, list, rowmap, tile_e);
    naive_gateup<<<dim3(4, POS_CAP / 64), 256, 0, stream>>>(H2, WGU, rowmap, tile_e, HM);
    { EpiDown e{rowmap, wgt, YS}; naive_gemm<EpiDown><<<dim3(1024 / 64, POS_CAP / 64), 256, 0, stream>>>(HM, WD, 256, e, tile_e, (size_t)1024 * 256); }
    k_combine<<<M / 4, 256, 0, stream>>>(out, YS, X2B);
    { EpiStoreBf e{PP}; naive_gemm<EpiStoreBf><<<dim3(1024 / 64, M / 64), 256, 0, stream>>>(PB, WPP, 256, e, nullptr, 0); }
    { EpiPle e{PP, out}; naive_gemm<EpiPle><<<dim3(1024 / 64, M / 64), 256, 0, stream>>>(X2B, WPG, 1024, e, nullptr, 0); }
    k_final<<<M / 4, 256, 0, stream>>>(out, final_norm);
}
```

```cpp
#include <hip/hip_runtime.h>
#include <cstdint>
#include <cstdio>

typedef unsigned short bf16_t;
typedef float f32x4 __attribute__((ext_vector_type(4)));
typedef unsigned u32x2 __attribute__((ext_vector_type(2)));

constexpr int M = 16384, D = 1024, SEQ = 8192, NIN = 7168, PLE = 256;
constexpr int NE = 32, DE = 256;
constexpr float EPS = 1e-6f;
constexpr int LIST_CAP = 32768;
constexpr int POS_CAP = 40960;

constexpr size_t MiB = 1u << 20;
constexpr size_t WS_CTL = 0;
constexpr size_t WS_SMALL = 1 * MiB;
constexpr size_t WS_LIST = 2 * MiB;
constexpr size_t WS_WA = 6 * MiB, WS_WB = 7 * MiB, WS_WO = 9 * MiB, WS_WPG = 11 * MiB, WS_WPP = 13 * MiB;
constexpr size_t WS_PB = 14 * MiB;
constexpr size_t WS_WIN = 22 * MiB;
constexpr size_t WS_QH = 36 * MiB, WS_VH = 52 * MiB, WS_GH = 68 * MiB, WS_RQ = 84 * MiB, WS_RK = 100 * MiB;
constexpr size_t WS_RV = 116 * MiB, WS_RG = 148 * MiB, WS_GA = 180 * MiB, WS_GB = 212 * MiB;
constexpr size_t WS_MG = 116 * MiB;
constexpr size_t WS_WGU = 84 * MiB;
constexpr size_t WS_WD = 36 * MiB;
constexpr size_t WS_H2 = 148 * MiB;
constexpr size_t WS_HM = 116 * MiB;
constexpr size_t WS_YS = 180 * MiB;
constexpr size_t WS_X2B = 148 * MiB;
constexpr size_t WS_PP = 52 * MiB;
constexpr size_t SM_RS1 = 0, SM_RS2 = 64 * 1024, SM_RS3 = 128 * 1024, SM_EID = 192 * 1024, SM_WGT = 320 * 1024, SM_LB = 448 * 1024;
constexpr size_t SM_ROWMAP = 512 * 1024;
constexpr size_t SM_TILEE = 700 * 1024;
constexpr int CW_CNT = 1024;

__device__ __forceinline__ unsigned f2bf(float f) { unsigned u = __float_as_uint(f); return (u + 0x7fffu + ((u >> 16) & 1u)) >> 16; }
__device__ __forceinline__ float bf2f(unsigned short h) { return __uint_as_float(((unsigned)h) << 16); }
__device__ __forceinline__ unsigned pk2(float lo, float hi) { return f2bf(lo) | (f2bf(hi) << 16); }
__device__ __forceinline__ float siluf(float v) { return v / (1.f + __expf(-v)); }
__device__ __forceinline__ float sigmf(float v) { return 1.f / (1.f + __expf(-v)); }
__device__ __forceinline__ void st4bf(bf16_t* p, f32x4 v) { u32x2 w; w.x = pk2(v[0], v[1]); w.y = pk2(v[2], v[3]); *(u32x2*)p = w; }
__device__ __forceinline__ f32x4 ld4bf(const bf16_t* p) { u32x2 w = *(const u32x2*)p; f32x4 r; r[0] = __uint_as_float(w.x << 16); r[1] = __uint_as_float(w.x & 0xffff0000u); r[2] = __uint_as_float(w.y << 16); r[3] = __uint_as_float(w.y & 0xffff0000u); return r; }
__device__ __forceinline__ float wave_sum(float v) {
#pragma unroll
    for (int o = 1; o < 64; o <<= 1) v += __shfl_xor(v, o);
    return v;
}
__device__ __forceinline__ int tid_opaque(int wave_s) { int t = (wave_s << 6) | (int)__builtin_amdgcn_mbcnt_hi(~0u, __builtin_amdgcn_mbcnt_lo(~0u, 0u)); asm volatile("" : "+v"(t)); return t; }
__device__ __forceinline__ float gamma_lg(int h) { return log1pf(-exp2f(-5.f - (float)h)); }


namespace pg8 {
#define PG8_LAS __attribute__((address_space(3)))
typedef short bf16x8 __attribute__((ext_vector_type(8)));
typedef unsigned u32x4 __attribute__((ext_vector_type(4)));
constexpr int BM = 256, BK = 64, HALF = 128, HTB = HALF * BK * 2  , STAGE_BYTES = 8 * HTB, NXCD = 8, WGM = 8;

__host__ __device__ __forceinline__ int lds_byte(int r, int c) { const int st = (r >> 4) * 2 + (c >> 5), rr = r & 15, cc = c & 31, ob = rr * 64 + cc * 2; return st * 1024 + (ob ^ (((ob >> 9) & 1) << 5)); }
__host__ __device__ __forceinline__ void stage_rc(int b, int& R, int& C) { const int st = b / 1024, sb = b % 1024, swz = sb ^ (((sb >> 9) & 1) << 5); R = (st >> 1) * 16 + swz / 64; C = (st & 1) * 32 + (swz % 64) / 2; }
__host__ __device__ __forceinline__ int perm32(int rho) { const int n = rho >> 4, i = rho & 15; return 8 * (i >> 2) + 4 * n + (i & 3); }

struct Unit { int pm, pn, pb, ui; };
struct Gemm { const bf16_t* A; const bf16_t* Bt; int M, N, K; };

struct DenseOrder {
    int nM, nN, nwg, G, c;
    __host__ __device__ void init(int M, int N, int G_, int c_) { nM = M / BM; nN = N / BM; nwg = nM * nN; G = G_; c = c_; }
    __host__ __device__ bool next(int i, Unit& u) const {
        const long L = (long)i * G + c; if (L >= nwg) return false;
        int wgid = (int)L; { const int q = nwg / NXCD, r = nwg % NXCD, xcd = wgid % NXCD, off = wgid / NXCD; wgid = (xcd < r ? xcd * (q + 1) : r * (q + 1) + (xcd - r) * q) + off; }
        const int nig = WGM * nN, gid = wgid / nig, fm = gid * WGM, gsz = (nM - fm) < WGM ? (nM - fm) : WGM;
        u.pm = fm + ((wgid % nig) % gsz); u.pn = (wgid % nig) / gsz; u.pb = u.pn; u.ui = i; return true;
    }
    __device__ __forceinline__ void a_ready(const Unit&) const {}
    __device__ __forceinline__ void done(const Unit&) const {}
};
struct GroupOrder {
    int ntiles, NTN, G, c; const PG8_LAS int* tile_e;
    __device__ bool next(int i, Unit& u) const {
        const int L = i * G + c; if (L >= ntiles * NTN) return false;
        const int tile = L / NTN, pn = L - tile * NTN;
        u.pm = tile; u.pn = pn; u.pb = tile_e[tile] * NTN + pn; u.ui = i; return true;
    }
    __device__ __forceinline__ void a_ready(const Unit&) const {}
    __device__ __forceinline__ void done(const Unit&) const {}
};

template <class F, bool PERM_ = true> struct EpiF {
    static constexpr bool PERM = PERM_, AFTER_DRAIN = false; F f;
    __device__ __forceinline__ void operator()(const f32x4 (&acc)[2][2][4][2], const Unit& u, int wr, int wc, int fr, int fq) const {
#pragma unroll
        for (int ai = 0; ai < 2; ++ai)
#pragma unroll
            for (int m = 0; m < 4; ++m) { const int row = u.pm * BM + ai * HALF + wr * 64 + m * 16 + fr;
#pragma unroll
                for (int bj = 0; bj < 2; ++bj)
#pragma unroll
                    for (int n = 0; n < 2; ++n) { const int col = u.pn * BM + bj * HALF + wc * 32 + (PERM ? 8 * fq + 4 * n : 16 * n + 4 * fq); f(u, row, col, acc[ai][bj][m][n]); }
                asm volatile("" ::: "memory"); }
    }
};
template <class F> struct EpiPairF {
    static constexpr bool PERM = true, AFTER_DRAIN = false; F f;
    __device__ __forceinline__ void operator()(const f32x4 (&acc)[2][2][4][2], const Unit& u, int wr, int wc, int fr, int fq) const {
#pragma unroll
        for (int ai = 0; ai < 2; ++ai)
#pragma unroll
            for (int m = 0; m < 4; ++m) { const int row = u.pm * BM + ai * HALF + wr * 64 + m * 16 + fr;
#pragma unroll
                for (int n = 0; n < 2; ++n) { const int col = u.pn * HALF + wc * 32 + 8 * fq + 4 * n; f.pair(u, row, col, acc[ai][0][m][n], acc[ai][1][m][n]); }
                asm volatile("" ::: "memory"); }
    }
};

template <class Epi, class Sched, bool ALIGN_EPI = true, bool SP2 = true, bool GATHER = false>
__device__ __forceinline__ void gemm_phase(PG8_LAS unsigned char* lds, const int wave_s, const Gemm g, const Sched& S, const Epi& E, const PG8_LAS int* rowtab = nullptr) {
    static_assert(SP2, "only the SP2 loop is kept in this file");
    const int tid = tid_opaque(wave_s), wid = wave_s, lane = tid & 63, wr = wid >> 2, wc = wid & 3, fr = lane & 15, fq = lane >> 4;
    const int K = g.K, nt = K / BK;
    unsigned voffA[2], voffB[2];
#pragma unroll
    for (int i = 0; i < 2; ++i) { int R, C; stage_rc(tid * 16 + i * 8192, R, C); const int Rb = Epi::PERM ? ((R & ~31) + perm32(R & 31)) : R;
        voffA[i] = (unsigned)(R * K + C) * 2u; voffB[i] = (unsigned)(Rb * K + C) * 2u; }
    unsigned cvA[2][2];
    (void)cvA;
#define PG8_GOFF(dst, u_) do { _Pragma("unroll") for (int _h = 0; _h < 2; ++_h) _Pragma("unroll") for (int _i = 0; _i < 2; ++_i) { int R_, C_; stage_rc(tid * 16 + _i * 8192, R_, C_); \
        const int a_ = rowtab[(u_).ui * 512 + _h * HALF + R_]; const int tok_ = a_ < 0 ? 0 : (a_ >> 1); dst[_h][_i] = (unsigned)(tok_ * K + C_) * 2u; } } while (0)
    const size_t kstep = (size_t)(BK * 2);
    const size_t hstep = (size_t)HALF * K * 2;
    const size_t tstep = 2 * hstep;
    const unsigned ldsw = (unsigned)wid * 1024u;
    const int aoff = lds_byte(wr * 64 + fr, fq * 8), boff = lds_byte(wc * 32 + fr, fq * 8);
#define PG8_SA(b, h) (((b) * 2 + (h)) * HTB)
#define PG8_SB(b, h) ((4 + (b) * 2 + (h)) * HTB)
#define PG8_STAGE(bufoff, gbase, voff) do { _Pragma("unroll") for (int _i = 0; _i < 2; ++_i) \
        __builtin_amdgcn_global_load_lds((const unsigned*)((const char*)(gbase) + (voff)[_i]), (PG8_LAS unsigned*)(lds + (bufoff) + ldsw + _i * 8192), 16, 0, 0); } while (0)
#define PG8_STA(bufoff, ptr, h, nx) do { if constexpr (GATHER) { _Pragma("unroll") for (int _i = 0; _i < 2; ++_i) { const unsigned _vo = cvA[h][_i]; \
        __builtin_amdgcn_global_load_lds((const unsigned*)((const char*)(ptr) + _vo), (PG8_LAS unsigned*)(lds + (bufoff) + ldsw + _i * 8192), 16, 0, 0); } } \
    else { PG8_STAGE(bufoff, (ptr) + (h) * hstep, voffA); } } while (0)
#define PG8_LDA(dst, b, h) do { _Pragma("unroll") for (int m = 0; m < 4; ++m) _Pragma("unroll") for (int k = 0; k < 2; ++k) dst[m][k] = *(const PG8_LAS bf16x8*)(lds + PG8_SA(b, h) + aoff + m * 2048 + k * 1024); } while (0)
#define PG8_LDB(dst, b, h) do { _Pragma("unroll") for (int n = 0; n < 2; ++n) _Pragma("unroll") for (int k = 0; k < 2; ++k) dst[n][k] = *(const PG8_LAS bf16x8*)(lds + PG8_SB(b, h) + boff + n * 2048 + k * 1024); } while (0)
#define PG8_MMA(ai, bj, At, Bt) do { __builtin_amdgcn_s_setprio(1); _Pragma("unroll") for (int m = 0; m < 4; ++m) _Pragma("unroll") for (int n = 0; n < 2; ++n) _Pragma("unroll") for (int k = 0; k < 2; ++k) \
        acc[ai][bj][m][n] = __builtin_amdgcn_mfma_f32_16x16x32_bf16(Bt[n][k], At[m][k], acc[ai][bj][m][n], 0, 0, 0); __builtin_amdgcn_s_setprio(0); } while (0)
#define PG8_WAIT_V(n) asm volatile("s_waitcnt vmcnt(" #n ")" ::: "memory")
#define PG8_WAIT_L(n) asm volatile("s_waitcnt lgkmcnt(" #n ")" ::: "memory")
#define PG8_BAR __builtin_amdgcn_s_barrier()
#define PG8_SCHED __builtin_amdgcn_sched_barrier(0)
    Unit cur, nxt; int ui = 0;
    if (!S.next(0, cur)) return;
    f32x4 acc[2][2][4][2];
#pragma unroll
    for (int a = 0; a < 2; ++a)
#pragma unroll
        for (int b = 0; b < 2; ++b)
#pragma unroll
            for (int m = 0; m < 4; ++m)
#pragma unroll
                for (int n = 0; n < 2; ++n) acc[a][b][m][n] = (f32x4){0.f, 0.f, 0.f, 0.f};
    bf16x8 At[4][2], B0[2][2], B1[2][2];
    const char* cA = (const char*)g.A + (GATHER ? (size_t)0 : (size_t)cur.pm * tstep); const char* cB = (const char*)g.Bt + (size_t)cur.pb * tstep;
    if constexpr (GATHER) { PG8_GOFF(cvA, cur); }
    S.a_ready(cur);
    if constexpr (SP2) {
        PG8_STAGE(PG8_SB(0, 0), cB, voffB); PG8_STAGE(PG8_SB(0, 1), cB + hstep, voffB); PG8_STA(PG8_SA(0, 0), cA, 0, false); PG8_STA(PG8_SA(0, 1), cA, 1, false);
        if (wr == 1) PG8_BAR;
        PG8_WAIT_V(2); PG8_BAR;
        PG8_STAGE(PG8_SB(1, 0), cB + kstep, voffB); PG8_STA(PG8_SA(1, 0), cA + kstep, 0, false); PG8_STAGE(PG8_SB(1, 1), cB + hstep + kstep, voffB);
        PG8_WAIT_V(6); PG8_BAR;
    }
    for (;;) {
        const bool has_next = S.next(ui + 1, nxt);
        const char* nA = (has_next && !GATHER) ? (const char*)g.A + (size_t)nxt.pm * tstep : cA; const char* nB = has_next ? (const char*)g.Bt + (size_t)nxt.pb * tstep : cB;
        for (int t = 0; t < nt; t += 2) {
            const bool last = (t == nt - 2);
            const char* a1 = cA + (size_t)(t + 1) * kstep;
            const char* a2 = last ? nA : cA + (size_t)(t + 2) * kstep; const char* b2 = last ? nB : cB + (size_t)(t + 2) * kstep;
            const char* a3 = a2 + kstep; const char* b3 = b2 + kstep;
            if (last && has_next) S.a_ready(nxt);
            if constexpr (SP2) {
            PG8_LDB(B0, 0, 0); PG8_LDB(B1, 0, 1); PG8_SCHED; PG8_LDA(At, 0, 0); PG8_STA(PG8_SA(1, 1), a1, 1, false);
            if constexpr (GATHER) { if (last && has_next) { PG8_GOFF(cvA, nxt); } }
            PG8_WAIT_V(8); PG8_WAIT_L(0); PG8_BAR; PG8_MMA(0, 0, At, B0); PG8_MMA(0, 1, At, B1); PG8_BAR; PG8_SCHED;
            PG8_LDA(At, 0, 1); PG8_STAGE(PG8_SB(0, 0), b2, voffB); PG8_STAGE(PG8_SB(0, 1), b2 + hstep, voffB); PG8_STA(PG8_SA(0, 0), a2, 0, last);
            PG8_WAIT_V(8); PG8_WAIT_L(0); PG8_BAR; PG8_MMA(1, 0, At, B0); PG8_MMA(1, 1, At, B1); PG8_BAR; PG8_SCHED;
            PG8_LDB(B0, 1, 0); PG8_LDB(B1, 1, 1); PG8_SCHED; PG8_LDA(At, 1, 0); PG8_STA(PG8_SA(0, 1), a2, 1, last);
            PG8_WAIT_V(8); PG8_WAIT_L(0); PG8_BAR; PG8_MMA(0, 0, At, B0); PG8_MMA(0, 1, At, B1); PG8_BAR; PG8_SCHED;
            PG8_LDA(At, 1, 1); PG8_STAGE(PG8_SB(1, 0), b3, voffB); PG8_STAGE(PG8_SB(1, 1), b3 + hstep, voffB); PG8_STA(PG8_SA(1, 0), a3, 0, last);
            PG8_WAIT_V(8); PG8_WAIT_L(0); PG8_BAR; PG8_MMA(1, 0, At, B0); PG8_MMA(1, 1, At, B1); PG8_BAR; PG8_SCHED;
            }
        }
        if constexpr (ALIGN_EPI) { if (wr == 0) PG8_BAR; }
        if constexpr (!Epi::AFTER_DRAIN) { const int t2_ = tid_opaque(wave_s) & 63; E(acc, cur, wr, wc, t2_ & 15, t2_ >> 4); S.done(cur); }
        if (!has_next) break;
#pragma unroll
        for (int a = 0; a < 2; ++a)
#pragma unroll
            for (int b = 0; b < 2; ++b)
#pragma unroll
                for (int m = 0; m < 4; ++m)
#pragma unroll
                    for (int n = 0; n < 2; ++n) acc[a][b][m][n] = (f32x4){0.f, 0.f, 0.f, 0.f};
        cur = nxt; cA = nA; cB = nB; ++ui;
        if constexpr (ALIGN_EPI) { if (wr == 1) PG8_BAR; }
    }
    PG8_WAIT_V(0);
    if constexpr (!ALIGN_EPI) { if (wr == 0) PG8_BAR; }
    PG8_BAR;
    if constexpr (Epi::AFTER_DRAIN) { E.fused(acc, cur, wr, wc, fr, fq, lds, wid, lane); S.done(cur); }
#undef PG8_SA
#undef PG8_SB
#undef PG8_STAGE
#undef PG8_STA
#undef PG8_GOFF
#undef PG8_LDA
#undef PG8_LDB
#undef PG8_MMA
#undef PG8_WAIT_V
#undef PG8_WAIT_L
#undef PG8_BAR
#undef PG8_SCHED
}
}

#define GAS __attribute__((address_space(1)))
#define LAS __attribute__((address_space(3)))
typedef unsigned v4u __attribute__((ext_vector_type(4)));
typedef GAS unsigned gu32;
typedef GAS unsigned long long gu64;
#define RLX_AGENT __ATOMIC_RELAXED, __HIP_MEMORY_SCOPE_AGENT
#define LDS_WAIT() asm volatile("s_waitcnt lgkmcnt(0)" ::: "memory")
#define VM_WAIT() asm volatile("s_waitcnt vmcnt(0)" ::: "memory")
__device__ __forceinline__ unsigned long long rt() { return __builtin_amdgcn_s_memrealtime(); }

#define XB_TMO      128
#define XB_XCNT(j)  (256  + 64 * (j))
#define XB_XSUB(j)  (1280 + 64 * (j))
#define XB_XGEN(j)  (2304 + 64 * (j))
#define XB_TOP      3328
#define XB_TOPGEN   3392
#define XCD_BAR_WORDS 3456
#define XB_SPIN_CAP (1u << 18)

__device__ __forceinline__ unsigned xb_ld(unsigned* p)              { return __hip_atomic_load(p, __ATOMIC_RELAXED, __HIP_MEMORY_SCOPE_AGENT); }
__device__ __forceinline__ unsigned xb_add(unsigned* p, unsigned v) { return __hip_atomic_fetch_add(p, v, __ATOMIC_RELAXED, __HIP_MEMORY_SCOPE_AGENT); }
__device__ __forceinline__ unsigned xb_xcc_id() { return (unsigned)__builtin_amdgcn_s_getreg((3 << 11) | 20) & 0xFu; }
#define XB_SPIN(cond, bar) do { unsigned _sp = 0; while (cond) { __builtin_amdgcn_s_sleep(1); \
    if ((++_sp & 255u) == 0u) { if (xb_ld(&(bar)[XB_TMO])) break; if (_sp > XB_SPIN_CAP) { atomicAdd(&(bar)[XB_TMO], 1u); break; } } } } while (0)

struct XcdBarrier {
    unsigned* bar; unsigned x;
    volatile LAS unsigned* st;
};

__device__ __forceinline__ XcdBarrier xcd_barrier_post(unsigned* bar, volatile LAS unsigned* st) {
    XcdBarrier b; b.bar = bar; b.x = xb_xcc_id(); b.st = st;
    if (threadIdx.x == 0) (void)xb_add(&bar[XB_XCNT(b.x)], 1u);
    return b;
}
__device__ __forceinline__ void xcd_barrier_complete(unsigned* bar, unsigned x, unsigned& nloc, unsigned& nx) {
    const unsigned G = gridDim.x * gridDim.y * gridDim.z;
    unsigned sum, cnt, mine, sp = 0u;
    for (;;) {
        sum = 0u; cnt = 0u; mine = 0u;
#pragma unroll
        for (unsigned j = 0; j < 16; ++j) { const unsigned c = xb_ld(&bar[XB_XCNT(j)]); sum += c; cnt += (c > 0u) ? 1u : 0u; mine = (j == x) ? c : mine; }
        if (sum == G) break;
        __builtin_amdgcn_s_sleep(1);
        if ((++sp & 255u) == 0u) { if (xb_ld(&bar[XB_TMO])) break; if (sp > XB_SPIN_CAP) { atomicAdd(&bar[XB_TMO], 1u); break; } }
    }
    nloc = mine > 0u ? mine : 1u; nx = cnt > 0u ? cnt : 1u;
}

__device__ __forceinline__ void xcd_barrier(const XcdBarrier& b, const int wave_s) {
    asm volatile("s_waitcnt vmcnt(0)" ::: "memory");
    __syncthreads();
    if (tid_opaque(wave_s) == 0) {
        unsigned* bar = b.bar;
        __builtin_amdgcn_s_waitcnt(0);
        unsigned nloc = b.st[0], nx = b.st[1];
        if (nloc == 0u) { xcd_barrier_complete(bar, b.x, nloc, nx); b.st[0] = nloc; b.st[1] = nx; }
        const unsigned old = xb_add(&bar[XB_XSUB(b.x)], 1u);
        const unsigned gen = old / nloc;
        if (old + 1u == (gen + 1u) * nloc) {
            __builtin_amdgcn_fence(__ATOMIC_RELEASE, "agent");
            asm volatile("s_waitcnt vmcnt(0)" ::: "memory");
            const unsigned og = xb_add(&bar[XB_TOP], 1u);
            const unsigned tg = og / nx;
            if (og + 1u == (tg + 1u) * nx) xb_add(&bar[XB_TOPGEN], 1u);
            else XB_SPIN(xb_ld(&bar[XB_TOPGEN]) == tg, bar);
            __builtin_amdgcn_fence(__ATOMIC_ACQUIRE, "agent");
            xb_add(&bar[XB_XGEN(b.x)], 1u);
            asm volatile("s_waitcnt vmcnt(0)" ::: "memory");
        } else {
            XB_SPIN(xb_ld(&bar[XB_XGEN(b.x)]) == gen, bar);
            __builtin_amdgcn_fence(__ATOMIC_ACQUIRE, "agent");
            asm volatile("s_waitcnt vmcnt(0)" ::: "memory");
        }
    }
    __syncthreads();
}

using pg8::Unit;
struct EpiP1 {
    static constexpr bool PERM = true, AFTER_DRAIN = false;
    const float* rs1; const float* lb; float* LF;
    bf16_t *QH, *VH, *GH, *RQ, *RK, *RV, *RG, *GA, *GB;
    template <int ACT> __device__ __forceinline__ void unary(const f32x4 (&acc)[2][2][4][2], int row0, int wc, int fq, bf16_t* dst, int ld, int colbase) const {
#pragma unroll
        for (int ai = 0; ai < 2; ++ai)
#pragma unroll
            for (int m = 0; m < 4; ++m) { const int row = row0 + ai * 128 + m * 16; const float rs = rs1[row]; bf16_t* rowp = dst + (size_t)row * ld + colbase + wc * 32 + 8 * fq;
#pragma unroll
                for (int bj = 0; bj < 2; ++bj) { f32x4 v0 = acc[ai][bj][m][0] * rs, v1 = acc[ai][bj][m][1] * rs;
                    if (ACT == 1) { for (int j = 0; j < 4; ++j) { v0[j] = siluf(v0[j]); v1[j] = siluf(v1[j]); } }
                    if (ACT == 2) { for (int j = 0; j < 4; ++j) { v0[j] = sigmf(v0[j]); v1[j] = sigmf(v1[j]); } }
                    pg8::u32x4 w; w.x = pk2(v0[0], v0[1]); w.y = pk2(v0[2], v0[3]); w.z = pk2(v1[0], v1[1]); w.w = pk2(v1[2], v1[3]);
                    *(pg8::u32x4*)(rowp + bj * 128) = w; }
                asm volatile("" ::: "memory"); }
    }
    __device__ __forceinline__ void operator()(const f32x4 (&acc)[2][2][4][2], const Unit& u, int wr, int wc, int fr, int fq) const {
        const int row0 = u.pm * 256 + wr * 64 + fr; const int c0 = u.pn * 256; const int sec = c0 >> 9;
        if (sec == 0) unary<1>(acc, row0, wc, fq, QH, 512, c0);
        else if (sec == 2) unary<0>(acc, row0, wc, fq, VH, 512, c0 - 1024);
        else if (sec == 3) unary<1>(acc, row0, wc, fq, GH, 512, c0 - 1536);
        else if (sec == 6 || sec == 7) unary<0>(acc, row0, wc, fq, RV, 1024, c0 - 3072);
        else if (sec == 8 || sec == 9) unary<1>(acc, row0, wc, fq, RG, 1024, c0 - 4096);
        else if (sec == 10 || sec == 11) unary<2>(acc, row0, wc, fq, GA, 1024, c0 - 5120);
        else if (sec == 12 || sec == 13) unary<2>(acc, row0, wc, fq, GB, 1024, c0 - 6144);
        else if (sec == 1) { const int cb = c0 - 512 + wc * 32 + 8 * fq;
#pragma unroll
            for (int ai = 0; ai < 2; ++ai)
#pragma unroll
                for (int m = 0; m < 4; ++m) { const int row = row0 + ai * 128 + m * 16; const float rs = rs1[row]; float* rowp = LF + (size_t)row * 512 + cb;
#pragma unroll
                    for (int bj = 0; bj < 2; ++bj)
#pragma unroll
                        for (int n = 0; n < 2; ++n) { const f32x4 l4 = *(const f32x4*)(lb + cb + bj * 128 + 4 * n); const f32x4 v = acc[ai][bj][m][n] * rs; f32x4 o;
                            for (int j = 0; j < 4; ++j) { const float e = (1.f - l4[j]) / (1.f + __expf(v[j])); o[j] = log1pf(-e); }
                            *(f32x4*)(rowp + bj * 128 + 4 * n) = o; }
                    asm volatile("" ::: "memory"); } }
        else { const bool isk = sec == 5; bf16_t* dst = isk ? RK : RQ; const int cbase = c0 - (isk ? 2560 : 2048);
            float invrev[4];
#pragma unroll
            for (int q = 0; q < 4; ++q) invrev[q] = exp2f(-(float)(wc * 16 + 4 * fq + q) * (13.287712379549449f / 64.f)) * 0.15915494309189535f;
            const int hd0 = cbase >> 7; const float lg0 = gamma_lg(hd0), lg1 = gamma_lg(hd0 + 1);
#pragma unroll
            for (int ai = 0; ai < 2; ++ai)
#pragma unroll
                for (int m = 0; m < 4; ++m) { const int row = row0 + ai * 128 + m * 16; const float rs = rs1[row]; const int t = row & (SEQ - 1), tm = t & 127;
                    bf16_t* rowp = dst + (size_t)row * 512 + cbase + wc * 32 + 8 * fq; float sn[4], cs[4];
#pragma unroll
                    for (int q = 0; q < 4; ++q) { float r = (float)t * invrev[q]; r = r - floorf(r); sn[q] = __builtin_amdgcn_sinf(r); cs[q] = __builtin_amdgcn_cosf(r); }
#pragma unroll
                    for (int bj = 0; bj < 2; ++bj) { const float lg = bj ? lg1 : lg0; const float sc = rs * (isk ? __expf(-(float)tm * lg) : 0.08838834764831845f * __expf((float)tm * lg));
                        const f32x4 v0 = acc[ai][bj][m][0], v1 = acc[ai][bj][m][1]; float o[8];
                        o[0] = (v0[0] * cs[0] - v0[1] * sn[0]) * sc; o[1] = (v0[0] * sn[0] + v0[1] * cs[0]) * sc; o[2] = (v0[2] * cs[1] - v0[3] * sn[1]) * sc; o[3] = (v0[2] * sn[1] + v0[3] * cs[1]) * sc;
                        o[4] = (v1[0] * cs[2] - v1[1] * sn[2]) * sc; o[5] = (v1[0] * sn[2] + v1[1] * cs[2]) * sc; o[6] = (v1[2] * cs[3] - v1[3] * sn[3]) * sc; o[7] = (v1[2] * sn[3] + v1[3] * cs[3]) * sc;
                        pg8::u32x4 w; w.x = pk2(o[0], o[1]); w.y = pk2(o[2], o[3]); w.z = pk2(o[4], o[5]); w.w = pk2(o[6], o[7]);
                        *(pg8::u32x4*)(rowp + bj * 128) = w; }
                    asm volatile("" ::: "memory"); } }
    }
};
struct EpiGateMul {
    const bf16_t* G; bf16_t* T;
    __device__ __forceinline__ void operator()(const Unit&, int m, int c, f32x4 v) const { const f32x4 g = ld4bf(G + (size_t)m * 1024 + c); st4bf(T + (size_t)m * 1024 + c, g * v); }
};
struct EpiGateMulAdd {
    const bf16_t* G; bf16_t* T;
    __device__ __forceinline__ void operator()(const Unit&, int m, int c, f32x4 v) const { const f32x4 g = ld4bf(G + (size_t)m * 1024 + c); const f32x4 t = ld4bf(T + (size_t)m * 1024 + c); st4bf(T + (size_t)m * 1024 + c, t + g * v); }
};
struct EpiResid {
    const float* x; float* out;
    __device__ __forceinline__ void operator()(const Unit&, int m, int c, f32x4 v) const { const f32x4 r = *(const f32x4*)(x + (size_t)m * 1024 + c); *(f32x4*)(out + (size_t)m * 1024 + c) = r + v; }
};
struct EpiStoreBf {
    bf16_t* T;
    __device__ __forceinline__ void operator()(const Unit&, int m, int c, f32x4 v) const { st4bf(T + (size_t)m * 1024 + c, v); }
};
struct EpiPle {
    const bf16_t* PP; float* x;
    __device__ __forceinline__ void operator()(const Unit&, int m, int c, f32x4 v) const { const f32x4 pp = ld4bf(PP + (size_t)m * 1024 + c); f32x4 r = *(const f32x4*)(x + (size_t)m * 1024 + c);
        for (int j = 0; j < 4; ++j) r[j] += sigmf(v[j]) * pp[j]; *(f32x4*)(x + (size_t)m * 1024 + c) = r; }
};
struct EpiGateUp {
    bf16_t* HM;
    __device__ __forceinline__ void pair(const Unit&, int pos, int c, f32x4 g, f32x4 up) const { f32x4 o; for (int j = 0; j < 4; ++j) o[j] = siluf(g[j]) * up[j]; st4bf(HM + (size_t)pos * 256 + c, o); }
};
struct EpiDown {
    const PG8_LAS int* rowinfo; bf16_t* YS;
    __device__ __forceinline__ void operator()(const Unit& u, int pos, int c, f32x4 v) const { const int r = pos & 255; const int a = rowinfo[u.ui * 512 + r]; if (a < 0) return;
        const float w = ((const PG8_LAS float*)rowinfo)[u.ui * 512 + 256 + r]; st4bf(YS + (size_t)a * 1024 + c, v * w); }
};

constexpr int NWAVES = 8;
constexpr int RING_BYTES = 131072, EXTRA_OFF = 131072, LDSCTL_OFF = EXTRA_OFF, MISC_OFF = EXTRA_OFF + 320, OFFS_OFF = EXTRA_OFF + 512, TILEE_OFF = EXTRA_OFF + 1024, ROWINFO_OFF = EXTRA_OFF + 2048;
constexpr int LDS_BYTES = ROWINFO_OFF + 8 * 2048;
constexpr int CW_BAR = 4096;
#ifndef MK_PER_PHASE
#define MK_PER_PHASE 0
#endif
constexpr int N_PHASES = 11;

struct Args { const float* in[22]; float* out; unsigned char* ws; int ph_lo, ph_hi; };

struct Ctx {
    LAS unsigned char* lds; int vcu, G, wave_s;
    const float* const* in; float* out; unsigned char* ws;
};
#define CIN(i) (C.in[i])
#define WSP(T, off) ((T*)(C.ws + (off)))

template <int MODE>
__device__ __forceinline__ void transpose_item(const float* W, int K, int N, bf16_t* WT, int row_off, LAS float* scr, int item, int lane, const float* gain) {
    const int nblk = N / 32, kb = item / nblk, nb = item % nblk, k0 = 64 * kb, n0 = 32 * nb;
    int nsrc = n0 + (lane & 31);
    if (MODE == 1) { if (nsrc >= 2048 && nsrc < 3072) { const int base = nsrc & ~127, w = nsrc & 127; nsrc = base + (w >> 1) + 64 * (w & 1); } }
#pragma unroll 8
    for (int i = 0; i < 32; ++i) { const int kk = 2 * i + (lane >> 5); const float g = gain ? gain[k0 + kk] : 1.f; scr[kk * 33 + (lane & 31)] = W[(size_t)(k0 + kk) * N + nsrc] * g; }
    LDS_WAIT(); asm volatile("" ::: "memory");
    const int c = lane & 7;
#pragma unroll
    for (int j = 0; j < 4; ++j) { const int n = (lane >> 3) + 8 * j; const LAS float* s = scr + (8 * c) * 33 + n;
        v4u o; o.x = pk2(s[0 * 33], s[1 * 33]); o.y = pk2(s[2 * 33], s[3 * 33]); o.z = pk2(s[4 * 33], s[5 * 33]); o.w = pk2(s[6 * 33], s[7 * 33]);
        int drow = row_off + n0 + n; if (MODE == 2) { const int nc = n0 + n; drow = row_off + 256 * (nc >> 7) + (nc & 127); }
        *(GAS v4u*)(WT + (size_t)drow * K + k0 + 8 * c) = o; }
    LDS_WAIT(); asm volatile("" ::: "memory");
}
__device__ __forceinline__ void p0_prologue(const Ctx& C) {
    const int T_tid = tid_opaque(C.wave_s), T_lane = T_tid & 63, T_wave = C.wave_s; (void)T_lane; (void)T_wave;
    LAS float* scr = (LAS float*)(C.lds + T_wave * 16384);
    const int gw = C.vcu * NWAVES + T_wave, NGW = C.G * NWAVES;
    constexpr int I_IN = 16 * (NIN / 32), I_A = 8 * 32, I_SQ = 16 * 32, I_PP = 4 * 32;
    constexpr int NIT = I_IN + I_A + 3 * I_SQ + I_PP;
    for (int it = gw; it < NIT; it += NGW) { int r = it;
        if (r < I_IN) { transpose_item<1>(CIN(3), 1024, NIN, WSP(bf16_t, WS_WIN), 0, scr, r, T_lane, CIN(2)); continue; } r -= I_IN;
        if (r < I_A) { transpose_item<0>(CIN(7), 512, 1024, WSP(bf16_t, WS_WA), 0, scr, r, T_lane, nullptr); continue; } r -= I_A;
        if (r < I_SQ) { transpose_item<0>(CIN(8), 1024, 1024, WSP(bf16_t, WS_WB), 0, scr, r, T_lane, nullptr); continue; } r -= I_SQ;
        if (r < I_SQ) { transpose_item<0>(CIN(9), 1024, 1024, WSP(bf16_t, WS_WO), 0, scr, r, T_lane, nullptr); continue; } r -= I_SQ;
        if (r < I_SQ) { transpose_item<0>(CIN(19), 1024, 1024, WSP(bf16_t, WS_WPG), 0, scr, r, T_lane, CIN(18)); continue; } r -= I_SQ;
        transpose_item<0>(CIN(20), 256, 1024, WSP(bf16_t, WS_WPP), 0, scr, r, T_lane, nullptr);
    }
    { bf16_t* XB = (bf16_t*)C.out; float* rs1 = (float*)(C.ws + WS_SMALL + SM_RS1); const float* x = CIN(0);
      for (int m = gw; m < M; m += NGW) { const f32x4* xr = (const f32x4*)(x + (size_t)m * D) + T_lane; f32x4 v[4]; float s = 0.f;
#pragma unroll
        for (int j = 0; j < 4; ++j) { v[j] = xr[64 * j]; s += (v[j][0] * v[j][0] + v[j][1] * v[j][1]) + (v[j][2] * v[j][2] + v[j][3] * v[j][3]); }
        s = wave_sum(s); if (T_lane == 0) rs1[m] = rsqrtf(s * (1.f / D) + EPS);
#pragma unroll
        for (int j = 0; j < 4; ++j) st4bf(XB + (size_t)m * D + T_lane * 4 + 256 * j, v[j]); } }
    { const f32x4* p4 = (const f32x4*)CIN(1); bf16_t* PB = WSP(bf16_t, WS_PB); const int gt = C.vcu * 512 + T_tid, NT = C.G * 512;
      for (int i = gt; i < M * PLE / 4; i += NT) st4bf(PB + (size_t)i * 4, p4[i]); }
    if (C.vcu == 0) { float* lb = (float*)(C.ws + WS_SMALL + SM_LB); const float* l = CIN(4); const float l0 = l[T_tid], l1 = l[512 + T_tid]; lb[T_tid] = 1.f / (1.f + __expf(l1 - l0)); }
}
__device__ __forceinline__ void p2_naive_hgrn(const Ctx& C, int bh) {
    const int T_tid = tid_opaque(C.wave_s), T_lane = T_tid & 63, T_wave = C.wave_s; (void)T_lane; (void)T_wave;
    const bf16_t* QH = WSP(bf16_t, WS_QH); const bf16_t* VH = WSP(bf16_t, WS_VH); bf16_t* GH = WSP(bf16_t, WS_GH); const float* LF = (const float*)((unsigned char*)C.out + 32 * MiB); const float* hg_norm = CIN(5);
    LAS float* sh = (LAS float*)C.lds; const int b = bh >> 2, h = bh & 3, v = T_tid & 127; const bool act = T_tid < 128;
    float S[128];
#pragma unroll
    for (int k = 0; k < 128; ++k) S[k] = 0.f;
    const float gn = hg_norm[v];
    for (int t = 0; t < SEQ; ++t) { const size_t o512 = (size_t)(b * SEQ + t) * 512 + h * 128 + v; float vv = 0.f;
        if (act) { const float lf = LF[o512]; sh[v] = bf2f(QH[o512]); sh[128 + v] = __expf(lf); sh[256 + v] = -expm1f(lf); vv = bf2f(VH[o512]); }
        __syncthreads();
        float o = 0.f;
        if (act) {
#pragma unroll
            for (int k = 0; k < 128; ++k) { S[k] = sh[128 + k] * S[k] + sh[256 + k] * vv; o += sh[k] * S[k]; if ((k & 15) == 15) asm volatile("" ::: "memory"); } }
        const float ss = wave_sum(o * o); if (act && (v & 63) == 0) sh[384 + (v >> 6)] = ss;
        __syncthreads();
        if (act) { const float tot = sh[384] + sh[385]; const float y = o * rsqrtf(tot * (1.f / 128.f) + EPS) * gn * bf2f(GH[o512]); GH[o512] = (bf16_t)f2bf(y); }
    }
}
__device__ __forceinline__ void p2_naive_ret(const Ctx& C, int bh) {
    const int T_tid = tid_opaque(C.wave_s), T_lane = T_tid & 63, T_wave = C.wave_s; (void)T_lane; (void)T_wave;
    const bf16_t* RQ = WSP(bf16_t, WS_RQ); const bf16_t* RK = WSP(bf16_t, WS_RK); const bf16_t* RV = WSP(bf16_t, WS_RV); bf16_t* RG = WSP(bf16_t, WS_RG); const float* ret_norm = CIN(6);
    LAS float* sh = (LAS float*)C.lds; const int b = bh >> 2, h = bh & 3, v = T_tid & 255; const bool act = T_tid < 256;
    float S[128];
#pragma unroll
    for (int k = 0; k < 128; ++k) S[k] = 0.f;
    const float gn = ret_norm[v]; const float lg = gamma_lg(h), gam = __expf(lg);
    for (int t = 0; t < SEQ; ++t) { const size_t m = (size_t)(b * SEQ + t); const int tm = t & 127; float vv = 0.f;
        if (T_tid < 128) { sh[v] = bf2f(RQ[m * 512 + h * 128 + v]) * __expf(-(float)tm * lg); sh[128 + v] = bf2f(RK[m * 512 + h * 128 + v]) * __expf((float)tm * lg); }
        if (act) vv = bf2f(RV[m * 1024 + h * 256 + v]);
        __syncthreads();
        float o = 0.f;
        if (act) {
#pragma unroll
            for (int k = 0; k < 128; ++k) { S[k] = gam * S[k] + sh[128 + k] * vv; o += sh[k] * S[k]; if ((k & 15) == 15) asm volatile("" ::: "memory"); } }
        const float ss = wave_sum(o * o); if (act && (v & 63) == 0) sh[384 + (v >> 6)] = ss;
        __syncthreads();
        if (act) { const float tot = (sh[384] + sh[385]) + (sh[386] + sh[387]); const size_t oi = m * 1024 + h * 256 + v;
            const float y = o * rsqrtf(tot * (1.f / 256.f) + EPS) * gn * bf2f(RG[oi]); RG[oi] = (bf16_t)f2bf(y); }
    }
}
__device__ __forceinline__ void p6_router(const Ctx& C, gu32* ctl) {
    const int T_tid = tid_opaque(C.wave_s), T_lane = T_tid & 63, T_wave = C.wave_s; (void)T_lane; (void)T_wave;
    const int gw = C.vcu * NWAVES + T_wave, NGW = C.G * NWAVES;
    { LAS float* scr = (LAS float*)(C.lds + T_wave * 16384);
      constexpr int I_G = 16 * 8, I_D = 4 * 32, PER_E = 2 * I_G + I_D;
      for (int it = gw; it < NE * PER_E; it += NGW) { const int e = it / PER_E; int r = it - e * PER_E;
          if (r < I_G) { transpose_item<2>(CIN(15) + (size_t)e * 1024 * 256, 1024, 256, WSP(bf16_t, WS_WGU), e * 512, scr, r, T_lane, CIN(10)); continue; } r -= I_G;
          if (r < I_G) { transpose_item<2>(CIN(16) + (size_t)e * 1024 * 256, 1024, 256, WSP(bf16_t, WS_WGU), e * 512 + 128, scr, r, T_lane, CIN(10)); continue; } r -= I_G;
          transpose_item<0>(CIN(17) + (size_t)e * 256 * 1024, 256, 1024, WSP(bf16_t, WS_WD), e * 1024, scr, r, T_lane, nullptr); } }
    const float* X1 = C.out; const float* g2 = CIN(10); const float* wrg = CIN(11); const float* brg = CIN(12); const float* wre = CIN(13); const float* bre = CIN(14);
    bf16_t* H2 = WSP(bf16_t, WS_H2); int* eid = (int*)(C.ws + WS_SMALL + SM_EID); float* wgt = (float*)(C.ws + WS_SMALL + SM_WGT); int* list = WSP(int, WS_LIST); gu32* cnt = ctl + CW_CNT;
    for (int m = gw; m < M; m += NGW) { const int lane = T_lane;
        const f32x4* xr = (const f32x4*)(X1 + (size_t)m * D) + lane; f32x4 v[4]; float s = 0.f;
#pragma unroll
        for (int j = 0; j < 4; ++j) { v[j] = xr[64 * j]; s += (v[j][0] * v[j][0] + v[j][1] * v[j][1]) + (v[j][2] * v[j][2] + v[j][3] * v[j][3]); }
        s = wave_sum(s); const float rs = rsqrtf(s * (1.f / D) + EPS);
        float lg[36];
#pragma unroll
        for (int c = 0; c < 36; ++c) lg[c] = 0.f;
#pragma unroll
        for (int j = 0; j < 4; ++j) { st4bf(H2 + (size_t)m * D + lane * 4 + 256 * j, v[j] * rs);
            const float* wgj = wrg + (lane * 4 + 256 * j) * 4; const float* wej = wre + (lane * 4 + 256 * j) * 32; asm volatile("" : "+v"(wgj), "+v"(wej));
            const f32x4 g4 = *(const f32x4*)(g2 + lane * 4 + 256 * j);
#pragma unroll
            for (int q = 0; q < 4; ++q) { const float hv = v[j][q] * rs * g4[q];
                const f32x4 wg4 = *(const f32x4*)(wgj + q * 4);
#pragma unroll
                for (int c = 0; c < 4; ++c) lg[c] += hv * wg4[c];
#pragma unroll
                for (int c8 = 0; c8 < 8; ++c8) { const f32x4 we4 = *(const f32x4*)(wej + q * 32 + c8 * 4);
#pragma unroll
                    for (int c = 0; c < 4; ++c) lg[4 + c8 * 4 + c] += hv * we4[c]; }
                asm volatile("" ::: "memory"); } }
#pragma unroll
        for (int c = 0; c < 36; ++c) lg[c] = wave_sum(lg[c]);
        if (lane == 0) {
            float gl[4];
#pragma unroll
            for (int c = 0; c < 4; ++c) gl[c] = lg[c] + brg[c];
            float gmax = gl[0]; int gi = 0;
#pragma unroll
            for (int c = 1; c < 4; ++c) if (gl[c] > gmax) { gmax = gl[c]; gi = c; }
            float den = 0.f;
#pragma unroll
            for (int c = 0; c < 4; ++c) den += __expf(gl[c] - gmax);
            const float gw_ = 1.f / den;
            float el[8];
#pragma unroll
            for (int c = 0; c < 8; ++c) { el[c] = 0.f;
#pragma unroll
                for (int g = 0; g < 4; ++g) if (g == gi) el[c] = lg[4 + g * 8 + c] + bre[g * 8 + c]; }
            float m1 = el[0]; int i1 = 0;
#pragma unroll
            for (int c = 1; c < 8; ++c) if (el[c] > m1) { m1 = el[c]; i1 = c; }
            float m2 = -3.0e38f; int i2 = 0;
#pragma unroll
            for (int c = 0; c < 8; ++c) if (c != i1 && el[c] > m2) { m2 = el[c]; i2 = c; }
            const float w1 = 1.f / (1.f + __expf(m2 - m1)), w2 = 1.f - w1;
            const int e1 = gi * 8 + i1, e2 = gi * 8 + i2;
            eid[2 * m] = e1; eid[2 * m + 1] = e2; wgt[2 * m] = w1 * gw_; wgt[2 * m + 1] = w2 * gw_;
            const unsigned p1 = __hip_atomic_fetch_add(cnt + e1, 1u, __ATOMIC_RELAXED, __HIP_MEMORY_SCOPE_AGENT); list[e1 * LIST_CAP + (int)p1] = 2 * m;
            const unsigned p2 = __hip_atomic_fetch_add(cnt + e2, 1u, __ATOMIC_RELAXED, __HIP_MEMORY_SCOPE_AGENT); list[e2 * LIST_CAP + (int)p2] = 2 * m + 1;
        }
    }
}
__device__ __forceinline__ int moe_plan(const Ctx& C, gu32* ctl) {
    const int T_tid = tid_opaque(C.wave_s), T_lane = T_tid & 63, T_wave = C.wave_s; (void)T_lane; (void)T_wave;
    LAS int* offs = (LAS int*)(C.lds + OFFS_OFF); LAS int* tile_e = (LAS int*)(C.lds + TILEE_OFF);
    if (T_tid == 0) { int o = 0;
        for (int e = 0; e < NE; ++e) { const int c = (int)__hip_atomic_load(ctl + CW_CNT + e, __ATOMIC_RELAXED, __HIP_MEMORY_SCOPE_AGENT); offs[e] = o; offs[33 + e] = c; const int np = (c + 255) & ~255;
            for (int t = 0; t < np; t += 256) tile_e[(o + t) >> 8] = e; o += np; }
        offs[32] = o; }
    __syncthreads();
    return offs[32] >> 8;
}
__device__ __forceinline__ void moe_rowinfo(const Ctx& C, const pg8::GroupOrder& S) {
    const int T_tid = tid_opaque(C.wave_s), T_lane = T_tid & 63, T_wave = C.wave_s; (void)T_lane; (void)T_wave;
    LAS int* offs = (LAS int*)(C.lds + OFFS_OFF); LAS int* tile_e = (LAS int*)(C.lds + TILEE_OFF); LAS int* ri = (LAS int*)(C.lds + ROWINFO_OFF);
    const int* list = WSP(int, WS_LIST); const float* wgt = (const float*)(C.ws + WS_SMALL + SM_WGT);
    pg8::Unit u;
    for (int i = 0; i < 8 && S.next(i, u); ++i) {
        if (T_tid < 256) { const int e = tile_e[u.pm], idx = u.pm * 256 + T_tid - offs[e]; int a = -1; float w = 0.f;
            if (idx < offs[33 + e]) { a = list[e * LIST_CAP + idx]; w = wgt[a]; }
            ri[i * 512 + T_tid] = a; ((LAS float*)ri)[i * 512 + 256 + T_tid] = w; } }
    __syncthreads();
}
__device__ __forceinline__ void p9_combine(const Ctx& C) {
    const int T_tid = tid_opaque(C.wave_s), T_lane = T_tid & 63, T_wave = C.wave_s; (void)T_lane; (void)T_wave;
    const int gw = C.vcu * NWAVES + T_wave, NGW = C.G * NWAVES; float* X = C.out; const bf16_t* YS = WSP(bf16_t, WS_YS); bf16_t* X2B = WSP(bf16_t, WS_X2B);
    for (int m = gw; m < M; m += NGW) { const int lane = T_lane;
        f32x4* xr = (f32x4*)(X + (size_t)m * D) + lane; f32x4 v[4]; float s = 0.f;
#pragma unroll
        for (int j = 0; j < 4; ++j) { const int c = lane * 4 + 256 * j; v[j] = xr[64 * j] + ld4bf(YS + (size_t)(2 * m) * D + c) + ld4bf(YS + (size_t)(2 * m + 1) * D + c);
            s += (v[j][0] * v[j][0] + v[j][1] * v[j][1]) + (v[j][2] * v[j][2] + v[j][3] * v[j][3]); }
        s = wave_sum(s); const float rs = rsqrtf(s * (1.f / D) + EPS);
#pragma unroll
        for (int j = 0; j < 4; ++j) { xr[64 * j] = v[j]; st4bf(X2B + (size_t)m * D + lane * 4 + 256 * j, v[j] * rs); } }
}
__device__ __forceinline__ void p11_final(const Ctx& C) {
    const int T_tid = tid_opaque(C.wave_s), T_lane = T_tid & 63, T_wave = C.wave_s; (void)T_lane; (void)T_wave;
    const int gw = C.vcu * NWAVES + T_wave, NGW = C.G * NWAVES; float* X = C.out; const float* g = CIN(21);
    for (int m = gw; m < M; m += NGW) { const int lane = T_lane;
        f32x4* xr = (f32x4*)(X + (size_t)m * D) + lane; f32x4 v[4]; float s = 0.f;
#pragma unroll
        for (int j = 0; j < 4; ++j) { v[j] = xr[64 * j]; s += (v[j][0] * v[j][0] + v[j][1] * v[j][1]) + (v[j][2] * v[j][2] + v[j][3] * v[j][3]); }
        s = wave_sum(s); const float rs = rsqrtf(s * (1.f / D) + EPS);
#pragma unroll
        for (int j = 0; j < 4; ++j) { const f32x4 gg = *(const f32x4*)(g + lane * 4 + 256 * j); xr[64 * j] = v[j] * rs * gg; } }
}

__global__ void __launch_bounds__(NWAVES * 64, 2) fwd(Args args) {
    extern __shared__ __attribute__((aligned(16))) unsigned char lds_raw[];
    Ctx C; C.lds = (LAS unsigned char*)lds_raw; C.wave_s = __builtin_amdgcn_readfirstlane((int)threadIdx.x >> 6);
    C.G = gridDim.x; { const int bx = blockIdx.x; C.vcu = (C.G % 8 == 0) ? (bx % 8) * (C.G / 8) + bx / 8 : bx; }
    C.in = args.in; C.out = args.out; C.ws = args.ws;
    gu32* ctl = (gu32*)(args.ws + WS_CTL);
    volatile LAS unsigned* MISC = (volatile LAS unsigned*)(C.lds + MISC_OFF);
    for (int u = threadIdx.x; u < (2048) / 4; u += NWAVES * 64) ((LAS unsigned*)(C.lds + LDSCTL_OFF))[u] = 0u;
    __syncthreads();
    XcdBarrier bar; bar.bar = (unsigned*)(ctl + CW_BAR); bar.x = 0; bar.st = nullptr;
    if (!MK_PER_PHASE) bar = xcd_barrier_post((unsigned*)(ctl + CW_BAR), MISC + 8);
    const int lo = args.ph_lo, hi = args.ph_hi;
#define IN(k) (lo <= (k) && (k) < hi)
#define SEAM(k) do { if (IN(k) && IN((k) + 1)) xcd_barrier(bar, C.wave_s); } while (0)
    PG8_LAS unsigned char* ring = (PG8_LAS unsigned char*)C.lds;
    using namespace pg8;
    if (IN(0)) { p0_prologue(C); } SEAM(0);
    if (IN(1)) { Gemm g{(const bf16_t*)C.out, WSP(bf16_t, WS_WIN), M, NIN, 1024}; DenseOrder S; S.init(M, NIN, C.G, (int)blockIdx.x);
        EpiP1 E{(const float*)(C.ws + WS_SMALL + SM_RS1), (const float*)(C.ws + WS_SMALL + SM_LB), (float*)((unsigned char*)C.out + 32 * MiB),
                WSP(bf16_t, WS_QH), WSP(bf16_t, WS_VH), WSP(bf16_t, WS_GH), WSP(bf16_t, WS_RQ), WSP(bf16_t, WS_RK), WSP(bf16_t, WS_RV), WSP(bf16_t, WS_RG), WSP(bf16_t, WS_GA), WSP(bf16_t, WS_GB)};
        gemm_phase<EpiP1, DenseOrder>(ring, C.wave_s, g, S, E); } SEAM(1);
    if (IN(2)) { if (C.vcu < 8) p2_naive_hgrn(C, C.vcu); else if (C.vcu < 16) p2_naive_ret(C, C.vcu - 8); } SEAM(2);
    if (IN(3)) { DenseOrder S; S.init(M, 1024, C.G, (int)blockIdx.x);
        { Gemm g{WSP(bf16_t, WS_GH), WSP(bf16_t, WS_WA), M, 1024, 512}; EpiF<EpiGateMul> E{{WSP(bf16_t, WS_GA), WSP(bf16_t, WS_MG)}}; gemm_phase<EpiF<EpiGateMul>, DenseOrder>(ring, C.wave_s, g, S, E); }
        { Gemm g{WSP(bf16_t, WS_RG), WSP(bf16_t, WS_WB), M, 1024, 1024}; EpiF<EpiGateMulAdd> E{{WSP(bf16_t, WS_GB), WSP(bf16_t, WS_MG)}}; gemm_phase<EpiF<EpiGateMulAdd>, DenseOrder>(ring, C.wave_s, g, S, E); } } SEAM(3);
    if (IN(4)) { DenseOrder S; S.init(M, 1024, C.G, (int)blockIdx.x); Gemm g{WSP(bf16_t, WS_MG), WSP(bf16_t, WS_WO), M, 1024, 1024};
        EpiF<EpiResid, false> E{{CIN(0), C.out}}; gemm_phase<EpiF<EpiResid, false>, DenseOrder>(ring, C.wave_s, g, S, E); } SEAM(4);
    if (IN(5)) { p6_router(C, ctl); } SEAM(5);
    if (IN(6)) { const int ntiles = moe_plan(C, ctl); GroupOrder S{ntiles, 2, C.G, (int)blockIdx.x, (const PG8_LAS int*)(C.lds + TILEE_OFF)}; moe_rowinfo(C, S);
        Gemm g{WSP(bf16_t, WS_H2), WSP(bf16_t, WS_WGU), 0, 512, 1024}; EpiPairF<EpiGateUp> E{{WSP(bf16_t, WS_HM)}};
        gemm_phase<EpiPairF<EpiGateUp>, GroupOrder, true, true, true>(ring, C.wave_s, g, S, E, (const PG8_LAS int*)(C.lds + ROWINFO_OFF)); } SEAM(6);
    if (IN(7)) { const int ntiles = moe_plan(C, ctl); GroupOrder S{ntiles, 4, C.G, (int)blockIdx.x, (const PG8_LAS int*)(C.lds + TILEE_OFF)}; moe_rowinfo(C, S);
        Gemm g{WSP(bf16_t, WS_HM), WSP(bf16_t, WS_WD), 0, 1024, 256}; EpiF<EpiDown> E{{(const PG8_LAS int*)(C.lds + ROWINFO_OFF), WSP(bf16_t, WS_YS)}};
        gemm_phase<EpiF<EpiDown>, GroupOrder>(ring, C.wave_s, g, S, E); } SEAM(7);
    if (IN(8)) { p9_combine(C); } SEAM(8);
    if (IN(9)) { DenseOrder S; S.init(M, 1024, C.G, (int)blockIdx.x);
        { Gemm g{WSP(bf16_t, WS_PB), WSP(bf16_t, WS_WPP), M, 1024, 256}; EpiF<EpiStoreBf> E{{WSP(bf16_t, WS_PP)}}; gemm_phase<EpiF<EpiStoreBf>, DenseOrder>(ring, C.wave_s, g, S, E); }
        { Gemm g{WSP(bf16_t, WS_X2B), WSP(bf16_t, WS_WPG), M, 1024, 1024}; EpiF<EpiPle> E{{WSP(bf16_t, WS_PP), C.out}}; gemm_phase<EpiF<EpiPle>, DenseOrder>(ring, C.wave_s, g, S, E); } } SEAM(9);
    if (IN(10)) { p11_final(C); }
#undef IN
#undef SEAM
}

extern "C" void kernel_launch(void* const* d_in, const int* in_sizes, int n_in, void* d_out, int out_size, void* d_ws, size_t ws_size, hipStream_t stream) {
    static int grid = 0;
    if (grid == 0) {
        int dev = 0, cus = 0, per_cu = 0;
        if (hipGetDevice(&dev) != hipSuccess || hipDeviceGetAttribute(&cus, hipDeviceAttributeMultiprocessorCount, dev) != hipSuccess) { fprintf(stderr, "kernel_launch: device query failed\n"); grid = -1; return; }
        if (hipFuncSetAttribute((const void*)fwd, hipFuncAttributeMaxDynamicSharedMemorySize, LDS_BYTES) != hipSuccess) { fprintf(stderr, "kernel_launch: hipFuncSetAttribute failed\n"); grid = -1; return; }
        if (hipOccupancyMaxActiveBlocksPerMultiprocessor(&per_cu, (const void*)fwd, NWAVES * 64, LDS_BYTES) != hipSuccess || per_cu < 1) { fprintf(stderr, "kernel_launch: occupancy query says %d blocks/CU\n", per_cu); }
        (void)hipGetLastError();
        grid = cus;
    }
    if (grid < 0) return;
    (void)hipMemsetAsync((char*)d_ws + WS_CTL, 0, 1 * MiB, stream);
    Args a{};
    for (int i = 0; i < 22; ++i) a.in[i] = (const float*)d_in[i];
    a.out = (float*)d_out; a.ws = (unsigned char*)d_ws;
#if MK_PER_PHASE
    for (int p = 0; p < N_PHASES; ++p) { a.ph_lo = p; a.ph_hi = p + 1; hipLaunchKernelGGL(fwd, dim3(grid), dim3(NWAVES * 64), LDS_BYTES, stream, a); }
#else
    a.ph_lo = 0; a.ph_hi = N_PHASES; hipLaunchKernelGGL(fwd, dim3(grid), dim3(NWAVES * 64), LDS_BYTES, stream, a);
#endif
}
```

```cpp
#include <hip/hip_runtime.h>
#include <cstdint>
#include <cstdio>

typedef unsigned short bf16_t;
typedef float f32x4 __attribute__((ext_vector_type(4)));
typedef unsigned u32x2 __attribute__((ext_vector_type(2)));

constexpr int M = 16384, D = 1024, SEQ = 8192, NIN = 7168, PLE = 256;
constexpr int NE = 32, DE = 256;
constexpr float EPS = 1e-6f;
constexpr int LIST_CAP = 32768;
constexpr int POS_CAP = 40960;

constexpr size_t MiB = 1u << 20;
constexpr size_t WS_CTL = 0;
constexpr size_t WS_SMALL = 1 * MiB;
constexpr size_t WS_LIST = 2 * MiB;
constexpr size_t WS_WA = 6 * MiB, WS_WB = 7 * MiB, WS_WO = 9 * MiB, WS_WPG = 11 * MiB, WS_WPP = 13 * MiB;
constexpr size_t WS_PB = 14 * MiB;
constexpr size_t WS_WIN = 22 * MiB;
constexpr size_t WS_QH = 36 * MiB, WS_VH = 52 * MiB, WS_GH = 68 * MiB, WS_RQ = 84 * MiB, WS_RK = 100 * MiB;
constexpr size_t WS_RV = 116 * MiB, WS_RG = 148 * MiB, WS_GA = 180 * MiB, WS_GB = 212 * MiB;
constexpr size_t WS_MG = 116 * MiB;
constexpr size_t WS_WGU = 84 * MiB;
constexpr size_t WS_WD = 36 * MiB;
constexpr size_t WS_H2 = 148 * MiB;
constexpr size_t WS_HM = 116 * MiB;
constexpr size_t WS_YS = 180 * MiB;
constexpr size_t WS_X2B = 148 * MiB;
constexpr size_t WS_PP = 52 * MiB;
constexpr size_t SM_RS1 = 0, SM_RS2 = 64 * 1024, SM_RS3 = 128 * 1024, SM_EID = 192 * 1024, SM_WGT = 320 * 1024, SM_LB = 448 * 1024;
constexpr size_t SM_ROWMAP = 512 * 1024;
constexpr size_t SM_TILEE = 700 * 1024;
constexpr int CW_CNT = 1024;

__device__ __forceinline__ unsigned f2bf(float f) { unsigned u = __float_as_uint(f); return (u + 0x7fffu + ((u >> 16) & 1u)) >> 16; }
__device__ __forceinline__ float bf2f(unsigned short h) { return __uint_as_float(((unsigned)h) << 16); }
__device__ __forceinline__ unsigned pk2(float lo, float hi) { return f2bf(lo) | (f2bf(hi) << 16); }
__device__ __forceinline__ float siluf(float v) { return v / (1.f + __expf(-v)); }
__device__ __forceinline__ float sigmf(float v) { return 1.f / (1.f + __expf(-v)); }
__device__ __forceinline__ void st4bf(bf16_t* p, f32x4 v) { u32x2 w; w.x = pk2(v[0], v[1]); w.y = pk2(v[2], v[3]); *(u32x2*)p = w; }
__device__ __forceinline__ f32x4 ld4bf(const bf16_t* p) { u32x2 w = *(const u32x2*)p; f32x4 r; r[0] = __uint_as_float(w.x << 16); r[1] = __uint_as_float(w.x & 0xffff0000u); r[2] = __uint_as_float(w.y << 16); r[3] = __uint_as_float(w.y & 0xffff0000u); return r; }
__device__ __forceinline__ float wave_sum(float v) {
#pragma unroll
    for (int o = 1; o < 64; o <<= 1) v += __shfl_xor(v, o);
    return v;
}
__device__ __forceinline__ int tid_opaque(int wave_s) { int t = (wave_s << 6) | (int)__builtin_amdgcn_mbcnt_hi(~0u, __builtin_amdgcn_mbcnt_lo(~0u, 0u)); asm volatile("" : "+v"(t)); return t; }
__device__ __forceinline__ float gamma_lg(int h) { return log1pf(-exp2f(-5.f - (float)h)); }


namespace pg8 {
#define PG8_LAS __attribute__((address_space(3)))
typedef short bf16x8 __attribute__((ext_vector_type(8)));
typedef unsigned u32x4 __attribute__((ext_vector_type(4)));
constexpr int BM = 256, BK = 64, HALF = 128, HTB = HALF * BK * 2  , STAGE_BYTES = 8 * HTB, NXCD = 8, WGM = 8;

__host__ __device__ __forceinline__ int lds_byte(int r, int c) { const int st = (r >> 4) * 2 + (c >> 5), rr = r & 15, cc = c & 31, ob = rr * 64 + cc * 2; return st * 1024 + (ob ^ (((ob >> 9) & 1) << 5)); }
__host__ __device__ __forceinline__ void stage_rc(int b, int& R, int& C) { const int st = b / 1024, sb = b % 1024, swz = sb ^ (((sb >> 9) & 1) << 5); R = (st >> 1) * 16 + swz / 64; C = (st & 1) * 32 + (swz % 64) / 2; }
__host__ __device__ __forceinline__ int perm32(int rho) { const int n = rho >> 4, i = rho & 15; return 8 * (i >> 2) + 4 * n + (i & 3); }

struct Unit { int pm, pn, pb, ui; };
struct Gemm { const bf16_t* A; const bf16_t* Bt; int M, N, K; };

struct DenseOrder {
    int nM, nN, nwg, G, c;
    __host__ __device__ void init(int M, int N, int G_, int c_) { nM = M / BM; nN = N / BM; nwg = nM * nN; G = G_; c = c_; }
    __host__ __device__ bool next(int i, Unit& u) const {
        const long L = (long)i * G + c; if (L >= nwg) return false;
        int wgid = (int)L; { const int q = nwg / NXCD, r = nwg % NXCD, xcd = wgid % NXCD, off = wgid / NXCD; wgid = (xcd < r ? xcd * (q + 1) : r * (q + 1) + (xcd - r) * q) + off; }
        const int nig = WGM * nN, gid = wgid / nig, fm = gid * WGM, gsz = (nM - fm) < WGM ? (nM - fm) : WGM;
        u.pm = fm + ((wgid % nig) % gsz); u.pn = (wgid % nig) / gsz; u.pb = u.pn; u.ui = i; return true;
    }
    __device__ __forceinline__ void a_ready(const Unit&) const {}
    __device__ __forceinline__ void done(const Unit&) const {}
};
struct GroupOrder {
    int ntiles, NTN, G, c; const PG8_LAS int* tile_e;
    __device__ bool next(int i, Unit& u) const {
        const int L = i * G + c; if (L >= ntiles * NTN) return false;
        const int tile = L / NTN, pn = L - tile * NTN;
        u.pm = tile; u.pn = pn; u.pb = tile_e[tile] * NTN + pn; u.ui = i; return true;
    }
    __device__ __forceinline__ void a_ready(const Unit&) const {}
    __device__ __forceinline__ void done(const Unit&) const {}
};

template <class F, bool PERM_ = true> struct EpiF {
    static constexpr bool PERM = PERM_, AFTER_DRAIN = false; F f;
    __device__ __forceinline__ void operator()(const f32x4 (&acc)[2][2][4][2], const Unit& u, int wr, int wc, int fr, int fq) const {
#pragma unroll
        for (int ai = 0; ai < 2; ++ai)
#pragma unroll
            for (int m = 0; m < 4; ++m) { const int row = u.pm * BM + ai * HALF + wr * 64 + m * 16 + fr;
#pragma unroll
                for (int bj = 0; bj < 2; ++bj)
#pragma unroll
                    for (int n = 0; n < 2; ++n) { const int col = u.pn * BM + bj * HALF + wc * 32 + (PERM ? 8 * fq + 4 * n : 16 * n + 4 * fq); f(u, row, col, acc[ai][bj][m][n]); }
                asm volatile("" ::: "memory"); }
    }
};
template <class F> struct EpiPairF {
    static constexpr bool PERM = true, AFTER_DRAIN = false; F f;
    __device__ __forceinline__ void operator()(const f32x4 (&acc)[2][2][4][2], const Unit& u, int wr, int wc, int fr, int fq) const {
#pragma unroll
        for (int ai = 0; ai < 2; ++ai)
#pragma unroll
            for (int m = 0; m < 4; ++m) { const int row = u.pm * BM + ai * HALF + wr * 64 + m * 16 + fr;
#pragma unroll
                for (int n = 0; n < 2; ++n) { const int col = u.pn * HALF + wc * 32 + 8 * fq + 4 * n; f.pair(u, row, col, acc[ai][0][m][n], acc[ai][1][m][n]); }
                asm volatile("" ::: "memory"); }
    }
};

template <class Epi, class Sched, bool ALIGN_EPI = true, bool SP2 = true, bool GATHER = false>
__device__ __forceinline__ void gemm_phase(PG8_LAS unsigned char* lds, const int wave_s, const Gemm g, const Sched& S, const Epi& E, const PG8_LAS int* rowtab = nullptr) {
    static_assert(SP2, "only the SP2 loop is kept in this file");
    const int tid = tid_opaque(wave_s), wid = wave_s, lane = tid & 63, wr = wid >> 2, wc = wid & 3, fr = lane & 15, fq = lane >> 4;
    const int K = g.K, nt = K / BK;
    unsigned voffA[2], voffB[2];
#pragma unroll
    for (int i = 0; i < 2; ++i) { int R, C; stage_rc(tid * 16 + i * 8192, R, C); const int Rb = Epi::PERM ? ((R & ~31) + perm32(R & 31)) : R;
        voffA[i] = (unsigned)(R * K + C) * 2u; voffB[i] = (unsigned)(Rb * K + C) * 2u; }
    unsigned cvA[2][2];
    (void)cvA;
#define PG8_GOFF(dst, u_) do { _Pragma("unroll") for (int _h = 0; _h < 2; ++_h) _Pragma("unroll") for (int _i = 0; _i < 2; ++_i) { int R_, C_; stage_rc(tid * 16 + _i * 8192, R_, C_); \
        const int a_ = rowtab[(u_).ui * 512 + _h * HALF + R_]; const int tok_ = a_ < 0 ? 0 : (a_ >> 1); dst[_h][_i] = (unsigned)(tok_ * K + C_) * 2u; } } while (0)
    const size_t kstep = (size_t)(BK * 2);
    const size_t hstep = (size_t)HALF * K * 2;
    const size_t tstep = 2 * hstep;
    const unsigned ldsw = (unsigned)wid * 1024u;
    const int aoff = lds_byte(wr * 64 + fr, fq * 8), boff = lds_byte(wc * 32 + fr, fq * 8);
#define PG8_SA(b, h) (((b) * 2 + (h)) * HTB)
#define PG8_SB(b, h) ((4 + (b) * 2 + (h)) * HTB)
#define PG8_STAGE(bufoff, gbase, voff) do { _Pragma("unroll") for (int _i = 0; _i < 2; ++_i) \
        __builtin_amdgcn_global_load_lds((const unsigned*)((const char*)(gbase) + (voff)[_i]), (PG8_LAS unsigned*)(lds + (bufoff) + ldsw + _i * 8192), 16, 0, 0); } while (0)
#define PG8_STA(bufoff, ptr, h, nx) do { if constexpr (GATHER) { _Pragma("unroll") for (int _i = 0; _i < 2; ++_i) { const unsigned _vo = cvA[h][_i]; \
        __builtin_amdgcn_global_load_lds((const unsigned*)((const char*)(ptr) + _vo), (PG8_LAS unsigned*)(lds + (bufoff) + ldsw + _i * 8192), 16, 0, 0); } } \
    else { PG8_STAGE(bufoff, (ptr) + (h) * hstep, voffA); } } while (0)
#define PG8_LDA(dst, b, h) do { _Pragma("unroll") for (int m = 0; m < 4; ++m) _Pragma("unroll") for (int k = 0; k < 2; ++k) dst[m][k] = *(const PG8_LAS bf16x8*)(lds + PG8_SA(b, h) + aoff + m * 2048 + k * 1024); } while (0)
#define PG8_LDB(dst, b, h) do { _Pragma("unroll") for (int n = 0; n < 2; ++n) _Pragma("unroll") for (int k = 0; k < 2; ++k) dst[n][k] = *(const PG8_LAS bf16x8*)(lds + PG8_SB(b, h) + boff + n * 2048 + k * 1024); } while (0)
#define PG8_MMA(ai, bj, At, Bt) do { __builtin_amdgcn_s_setprio(1); _Pragma("unroll") for (int m = 0; m < 4; ++m) _Pragma("unroll") for (int n = 0; n < 2; ++n) _Pragma("unroll") for (int k = 0; k < 2; ++k) \
        acc[ai][bj][m][n] = __builtin_amdgcn_mfma_f32_16x16x32_bf16(Bt[n][k], At[m][k], acc[ai][bj][m][n], 0, 0, 0); __builtin_amdgcn_s_setprio(0); } while (0)
#define PG8_WAIT_V(n) asm volatile("s_waitcnt vmcnt(" #n ")" ::: "memory")
#define PG8_WAIT_L(n) asm volatile("s_waitcnt lgkmcnt(" #n ")" ::: "memory")
#define PG8_BAR __builtin_amdgcn_s_barrier()
#define PG8_SCHED __builtin_amdgcn_sched_barrier(0)
    Unit cur, nxt; int ui = 0;
    if (!S.next(0, cur)) return;
    f32x4 acc[2][2][4][2];
#pragma unroll
    for (int a = 0; a < 2; ++a)
#pragma unroll
        for (int b = 0; b < 2; ++b)
#pragma unroll
            for (int m = 0; m < 4; ++m)
#pragma unroll
                for (int n = 0; n < 2; ++n) acc[a][b][m][n] = (f32x4){0.f, 0.f, 0.f, 0.f};
    bf16x8 At[4][2], B0[2][2], B1[2][2];
    const char* cA = (const char*)g.A + (GATHER ? (size_t)0 : (size_t)cur.pm * tstep); const char* cB = (const char*)g.Bt + (size_t)cur.pb * tstep;
    if constexpr (GATHER) { PG8_GOFF(cvA, cur); }
    S.a_ready(cur);
    if constexpr (SP2) {
        PG8_STAGE(PG8_SB(0, 0), cB, voffB); PG8_STAGE(PG8_SB(0, 1), cB + hstep, voffB); PG8_STA(PG8_SA(0, 0), cA, 0, false); PG8_STA(PG8_SA(0, 1), cA, 1, false);
        if (wr == 1) PG8_BAR;
        PG8_WAIT_V(2); PG8_BAR;
        PG8_STAGE(PG8_SB(1, 0), cB + kstep, voffB); PG8_STA(PG8_SA(1, 0), cA + kstep, 0, false); PG8_STAGE(PG8_SB(1, 1), cB + hstep + kstep, voffB);
        PG8_WAIT_V(6); PG8_BAR;
    }
    for (;;) {
        const bool has_next = S.next(ui + 1, nxt);
        const char* nA = (has_next && !GATHER) ? (const char*)g.A + (size_t)nxt.pm * tstep : cA; const char* nB = has_next ? (const char*)g.Bt + (size_t)nxt.pb * tstep : cB;
        for (int t = 0; t < nt; t += 2) {
            const bool last = (t == nt - 2);
            const char* a1 = cA + (size_t)(t + 1) * kstep;
            const char* a2 = last ? nA : cA + (size_t)(t + 2) * kstep; const char* b2 = last ? nB : cB + (size_t)(t + 2) * kstep;
            const char* a3 = a2 + kstep; const char* b3 = b2 + kstep;
            if (last && has_next) S.a_ready(nxt);
            if constexpr (SP2) {
            PG8_LDB(B0, 0, 0); PG8_LDB(B1, 0, 1); PG8_SCHED; PG8_LDA(At, 0, 0); PG8_STA(PG8_SA(1, 1), a1, 1, false);
            if constexpr (GATHER) { if (last && has_next) { PG8_GOFF(cvA, nxt); } }
            PG8_WAIT_V(8); PG8_WAIT_L(0); PG8_BAR; PG8_MMA(0, 0, At, B0); PG8_MMA(0, 1, At, B1); PG8_BAR; PG8_SCHED;
            PG8_LDA(At, 0, 1); PG8_STAGE(PG8_SB(0, 0), b2, voffB); PG8_STAGE(PG8_SB(0, 1), b2 + hstep, voffB); PG8_STA(PG8_SA(0, 0), a2, 0, last);
            PG8_WAIT_V(8); PG8_WAIT_L(0); PG8_BAR; PG8_MMA(1, 0, At, B0); PG8_MMA(1, 1, At, B1); PG8_BAR; PG8_SCHED;
            PG8_LDB(B0, 1, 0); PG8_LDB(B1, 1, 1); PG8_SCHED; PG8_LDA(At, 1, 0); PG8_STA(PG8_SA(0, 1), a2, 1, last);
            PG8_WAIT_V(8); PG8_WAIT_L(0); PG8_BAR; PG8_MMA(0, 0, At, B0); PG8_MMA(0, 1, At, B1); PG8_BAR; PG8_SCHED;
            PG8_LDA(At, 1, 1); PG8_STAGE(PG8_SB(1, 0), b3, voffB); PG8_STAGE(PG8_SB(1, 1), b3 + hstep, voffB); PG8_STA(PG8_SA(1, 0), a3, 0, last);
            PG8_WAIT_V(8); PG8_WAIT_L(0); PG8_BAR; PG8_MMA(1, 0, At, B0); PG8_MMA(1, 1, At, B1); PG8_BAR; PG8_SCHED;
            }
        }
        if constexpr (ALIGN_EPI) { if (wr == 0) PG8_BAR; }
        if constexpr (!Epi::AFTER_DRAIN) { const int t2_ = tid_opaque(wave_s) & 63; E(acc, cur, wr, wc, t2_ & 15, t2_ >> 4); S.done(cur); }
        if (!has_next) break;
#pragma unroll
        for (int a = 0; a < 2; ++a)
#pragma unroll
            for (int b = 0; b < 2; ++b)
#pragma unroll
                for (int m = 0; m < 4; ++m)
#pragma unroll
                    for (int n = 0; n < 2; ++n) acc[a][b][m][n] = (f32x4){0.f, 0.f, 0.f, 0.f};
        cur = nxt; cA = nA; cB = nB; ++ui;
        if constexpr (ALIGN_EPI) { if (wr == 1) PG8_BAR; }
    }
    PG8_WAIT_V(0);
    if constexpr (!ALIGN_EPI) { if (wr == 0) PG8_BAR; }
    PG8_BAR;
    if constexpr (Epi::AFTER_DRAIN) { E.fused(acc, cur, wr, wc, fr, fq, lds, wid, lane); S.done(cur); }
#undef PG8_SA
#undef PG8_SB
#undef PG8_STAGE
#undef PG8_STA
#undef PG8_GOFF
#undef PG8_LDA
#undef PG8_LDB
#undef PG8_MMA
#undef PG8_WAIT_V
#undef PG8_WAIT_L
#undef PG8_BAR
#undef PG8_SCHED
}
}

#define GAS __attribute__((address_space(1)))
#define LAS __attribute__((address_space(3)))
typedef unsigned v4u __attribute__((ext_vector_type(4)));
typedef GAS unsigned gu32;
typedef GAS unsigned long long gu64;
#define RLX_AGENT __ATOMIC_RELAXED, __HIP_MEMORY_SCOPE_AGENT
#define LDS_WAIT() asm volatile("s_waitcnt lgkmcnt(0)" ::: "memory")
#define VM_WAIT() asm volatile("s_waitcnt vmcnt(0)" ::: "memory")
__device__ __forceinline__ unsigned long long rt() { return __builtin_amdgcn_s_memrealtime(); }

#define XB_TMO      128
#define XB_XCNT(j)  (256  + 64 * (j))
#define XB_XSUB(j)  (1280 + 64 * (j))
#define XB_XGEN(j)  (2304 + 64 * (j))
#define XB_TOP      3328
#define XB_TOPGEN   3392
#define XCD_BAR_WORDS 3456
#define XB_SPIN_CAP (1u << 18)

__device__ __forceinline__ unsigned xb_ld(unsigned* p)              { return __hip_atomic_load(p, __ATOMIC_RELAXED, __HIP_MEMORY_SCOPE_AGENT); }
__device__ __forceinline__ unsigned xb_add(unsigned* p, unsigned v) { return __hip_atomic_fetch_add(p, v, __ATOMIC_RELAXED, __HIP_MEMORY_SCOPE_AGENT); }
__device__ __forceinline__ unsigned xb_xcc_id() { return (unsigned)__builtin_amdgcn_s_getreg((3 << 11) | 20) & 0xFu; }
#define XB_SPIN(cond, bar) do { unsigned _sp = 0; while (cond) { __builtin_amdgcn_s_sleep(1); \
    if ((++_sp & 255u) == 0u) { if (xb_ld(&(bar)[XB_TMO])) break; if (_sp > XB_SPIN_CAP) { atomicAdd(&(bar)[XB_TMO], 1u); break; } } } } while (0)

struct XcdBarrier {
    unsigned* bar; unsigned x;
    volatile LAS unsigned* st;
};

__device__ __forceinline__ XcdBarrier xcd_barrier_post(unsigned* bar, volatile LAS unsigned* st) {
    XcdBarrier b; b.bar = bar; b.x = xb_xcc_id(); b.st = st;
    if (threadIdx.x == 0) (void)xb_add(&bar[XB_XCNT(b.x)], 1u);
    return b;
}
__device__ __forceinline__ void xcd_barrier_complete(unsigned* bar, unsigned x, unsigned& nloc, unsigned& nx) {
    const unsigned G = gridDim.x * gridDim.y * gridDim.z;
    unsigned sum, cnt, mine, sp = 0u;
    for (;;) {
        sum = 0u; cnt = 0u; mine = 0u;
#pragma unroll
        for (unsigned j = 0; j < 16; ++j) { const unsigned c = xb_ld(&bar[XB_XCNT(j)]); sum += c; cnt += (c > 0u) ? 1u : 0u; mine = (j == x) ? c : mine; }
        if (sum == G) break;
        __builtin_amdgcn_s_sleep(1);
        if ((++sp & 255u) == 0u) { if (xb_ld(&bar[XB_TMO])) break; if (sp > XB_SPIN_CAP) { atomicAdd(&bar[XB_TMO], 1u); break; } }
    }
    nloc = mine > 0u ? mine : 1u; nx = cnt > 0u ? cnt : 1u;
}

__device__ __forceinline__ void xcd_barrier(const XcdBarrier& b, const int wave_s) {
    asm volatile("s_waitcnt vmcnt(0)" ::: "memory");
    __syncthreads();
    if (tid_opaque(wave_s) == 0) {
        unsigned* bar = b.bar;
        __builtin_amdgcn_s_waitcnt(0);
        unsigned nloc = b.st[0], nx = b.st[1];
        if (nloc == 0u) { xcd_barrier_complete(bar, b.x, nloc, nx); b.st[0] = nloc; b.st[1] = nx; }
        const unsigned old = xb_add(&bar[XB_XSUB(b.x)], 1u);
        const unsigned gen = old / nloc;
        if (old + 1u == (gen + 1u) * nloc) {
            __builtin_amdgcn_fence(__ATOMIC_RELEASE, "agent");
            asm volatile("s_waitcnt vmcnt(0)" ::: "memory");
            const unsigned og = xb_add(&bar[XB_TOP], 1u);
            const unsigned tg = og / nx;
            if (og + 1u == (tg + 1u) * nx) xb_add(&bar[XB_TOPGEN], 1u);
            else XB_SPIN(xb_ld(&bar[XB_TOPGEN]) == tg, bar);
            __builtin_amdgcn_fence(__ATOMIC_ACQUIRE, "agent");
            xb_add(&bar[XB_XGEN(b.x)], 1u);
            asm volatile("s_waitcnt vmcnt(0)" ::: "memory");
        } else {
            XB_SPIN(xb_ld(&bar[XB_XGEN(b.x)]) == gen, bar);
            __builtin_amdgcn_fence(__ATOMIC_ACQUIRE, "agent");
            asm volatile("s_waitcnt vmcnt(0)" ::: "memory");
        }
    }
    __syncthreads();
}

using pg8::Unit;
struct EpiP1 {
    static constexpr bool PERM = true, AFTER_DRAIN = false;
    const float* rs1; const float* lb; float* LF;
    bf16_t *QH, *VH, *GH, *RQ, *RK, *RV, *RG, *GA, *GB;
    template <int ACT> __device__ __forceinline__ void unary(const f32x4 (&acc)[2][2][4][2], int row0, int wc, int fq, bf16_t* dst, int ld, int colbase) const {
#pragma unroll
        for (int ai = 0; ai < 2; ++ai)
#pragma unroll
            for (int m = 0; m < 4; ++m) { const int row = row0 + ai * 128 + m * 16; const float rs = rs1[row]; bf16_t* rowp = dst + (size_t)row * ld + colbase + wc * 32 + 8 * fq;
#pragma unroll
                for (int bj = 0; bj < 2; ++bj) { f32x4 v0 = acc[ai][bj][m][0] * rs, v1 = acc[ai][bj][m][1] * rs;
                    if (ACT == 1) { for (int j = 0; j < 4; ++j) { v0[j] = siluf(v0[j]); v1[j] = siluf(v1[j]); } }
                    if (ACT == 2) { for (int j = 0; j < 4; ++j) { v0[j] = sigmf(v0[j]); v1[j] = sigmf(v1[j]); } }
                    pg8::u32x4 w; w.x = pk2(v0[0], v0[1]); w.y = pk2(v0[2], v0[3]); w.z = pk2(v1[0], v1[1]); w.w = pk2(v1[2], v1[3]);
                    *(pg8::u32x4*)(rowp + bj * 128) = w; }
                asm volatile("" ::: "memory"); }
    }
    __device__ __forceinline__ void operator()(const f32x4 (&acc)[2][2][4][2], const Unit& u, int wr, int wc, int fr, int fq) const {
        const int row0 = u.pm * 256 + wr * 64 + fr; const int c0 = u.pn * 256; const int sec = c0 >> 9;
        if (sec == 0) unary<1>(acc, row0, wc, fq, QH, 512, c0);
        else if (sec == 2) unary<0>(acc, row0, wc, fq, VH, 512, c0 - 1024);
        else if (sec == 3) unary<1>(acc, row0, wc, fq, GH, 512, c0 - 1536);
        else if (sec == 6 || sec == 7) unary<0>(acc, row0, wc, fq, RV, 1024, c0 - 3072);
        else if (sec == 8 || sec == 9) unary<1>(acc, row0, wc, fq, RG, 1024, c0 - 4096);
        else if (sec == 10 || sec == 11) unary<2>(acc, row0, wc, fq, GA, 1024, c0 - 5120);
        else if (sec == 12 || sec == 13) unary<2>(acc, row0, wc, fq, GB, 1024, c0 - 6144);
        else if (sec == 1) { const int cb = c0 - 512 + wc * 32 + 8 * fq;
#pragma unroll
            for (int ai = 0; ai < 2; ++ai)
#pragma unroll
                for (int m = 0; m < 4; ++m) { const int row = row0 + ai * 128 + m * 16; const float rs = rs1[row]; float* rowp = LF + (size_t)row * 512 + cb;
#pragma unroll
                    for (int bj = 0; bj < 2; ++bj)
#pragma unroll
                        for (int n = 0; n < 2; ++n) { const f32x4 l4 = *(const f32x4*)(lb + cb + bj * 128 + 4 * n); const f32x4 v = acc[ai][bj][m][n] * rs; f32x4 o;
                            for (int j = 0; j < 4; ++j) { const float e = (1.f - l4[j]) / (1.f + __expf(v[j])); o[j] = log1pf(-e); }
                            *(f32x4*)(rowp + bj * 128 + 4 * n) = o; }
                    asm volatile("" ::: "memory"); } }
        else { const bool isk = sec == 5; bf16_t* dst = isk ? RK : RQ; const int cbase = c0 - (isk ? 2560 : 2048);
            float invrev[4];
#pragma unroll
            for (int q = 0; q < 4; ++q) invrev[q] = exp2f(-(float)(wc * 16 + 4 * fq + q) * (13.287712379549449f / 64.f)) * 0.15915494309189535f;
            const int hd0 = cbase >> 7; const float lg0 = gamma_lg(hd0), lg1 = gamma_lg(hd0 + 1);
#pragma unroll
            for (int ai = 0; ai < 2; ++ai)
#pragma unroll
                for (int m = 0; m < 4; ++m) { const int row = row0 + ai * 128 + m * 16; const float rs = rs1[row]; const int t = row & (SEQ - 1), tm = t & 127;
                    bf16_t* rowp = dst + (size_t)row * 512 + cbase + wc * 32 + 8 * fq; float sn[4], cs[4];
#pragma unroll
                    for (int q = 0; q < 4; ++q) { float r = (float)t * invrev[q]; r = r - floorf(r); sn[q] = __builtin_amdgcn_sinf(r); cs[q] = __builtin_amdgcn_cosf(r); }
#pragma unroll
                    for (int bj = 0; bj < 2; ++bj) { const float lg = bj ? lg1 : lg0; const float sc = rs * (isk ? __expf(-(float)tm * lg) : 0.08838834764831845f * __expf((float)tm * lg));
                        const f32x4 v0 = acc[ai][bj][m][0], v1 = acc[ai][bj][m][1]; float o[8];
                        o[0] = (v0[0] * cs[0] - v0[1] * sn[0]) * sc; o[1] = (v0[0] * sn[0] + v0[1] * cs[0]) * sc; o[2] = (v0[2] * cs[1] - v0[3] * sn[1]) * sc; o[3] = (v0[2] * sn[1] + v0[3] * cs[1]) * sc;
                        o[4] = (v1[0] * cs[2] - v1[1] * sn[2]) * sc; o[5] = (v1[0] * sn[2] + v1[1] * cs[2]) * sc; o[6] = (v1[2] * cs[3] - v1[3] * sn[3]) * sc; o[7] = (v1[2] * sn[3] + v1[3] * cs[3]) * sc;
                        pg8::u32x4 w; w.x = pk2(o[0], o[1]); w.y = pk2(o[2], o[3]); w.z = pk2(o[4], o[5]); w.w = pk2(o[6], o[7]);
                        *(pg8::u32x4*)(rowp + bj * 128) = w; }
                    asm volatile("" ::: "memory"); } }
    }
};
struct EpiGateMul {
    const bf16_t* G; bf16_t* T;
    __device__ __forceinline__ void operator()(const Unit&, int m, int c, f32x4 v) const { const f32x4 g = ld4bf(G + (size_t)m * 1024 + c); st4bf(T + (size_t)m * 1024 + c, g * v); }
};
struct EpiGateMulAdd {
    const bf16_t* G; bf16_t* T;
    __device__ __forceinline__ void operator()(const Unit&, int m, int c, f32x4 v) const { const f32x4 g = ld4bf(G + (size_t)m * 1024 + c); const f32x4 t = ld4bf(T + (size_t)m * 1024 + c); st4bf(T + (size_t)m * 1024 + c, t + g * v); }
};
struct EpiResid {
    const float* x; float* out;
    __device__ __forceinline__ void operator()(const Unit&, int m, int c, f32x4 v) const { const f32x4 r = *(const f32x4*)(x + (size_t)m * 1024 + c); *(f32x4*)(out + (size_t)m * 1024 + c) = r + v; }
};
struct EpiStoreBf {
    bf16_t* T;
    __device__ __forceinline__ void operator()(const Unit&, int m, int c, f32x4 v) const { st4bf(T + (size_t)m * 1024 + c, v); }
};
struct EpiPle {
    const bf16_t* PP; float* x;
    __device__ __forceinline__ void operator()(const Unit&, int m, int c, f32x4 v) const { const f32x4 pp = ld4bf(PP + (size_t)m * 1024 + c); f32x4 r = *(const f32x4*)(x + (size_t)m * 1024 + c);
        for (int j = 0; j < 4; ++j) r[j] += sigmf(v[j]) * pp[j]; *(f32x4*)(x + (size_t)m * 1024 + c) = r; }
};
struct EpiGateUp {
    bf16_t* HM;
    __device__ __forceinline__ void pair(const Unit&, int pos, int c, f32x4 g, f32x4 up) const { f32x4 o; for (int j = 0; j < 4; ++j) o[j] = siluf(g[j]) * up[j]; st4bf(HM + (size_t)pos * 256 + c, o); }
};
struct EpiDown {
    const PG8_LAS int* rowinfo; bf16_t* YS;
    __device__ __forceinline__ void operator()(const Unit& u, int pos, int c, f32x4 v) const { const int r = pos & 255; const int a = rowinfo[u.ui * 512 + r]; if (a < 0) return;
        const float w = ((const PG8_LAS float*)rowinfo)[u.ui * 512 + 256 + r]; st4bf(YS + (size_t)a * 1024 + c, v * w); }
};

constexpr int NWAVES = 8;
constexpr int RING_BYTES = 131072, EXTRA_OFF = 131072, LDSCTL_OFF = EXTRA_OFF, MISC_OFF = EXTRA_OFF + 320, OFFS_OFF = EXTRA_OFF + 512, TILEE_OFF = EXTRA_OFF + 1024, ROWINFO_OFF = EXTRA_OFF + 2048;
constexpr int LDS_BYTES = ROWINFO_OFF + 8 * 2048;
constexpr int CW_BAR = 4096;
#ifndef MK_PER_PHASE
#define MK_PER_PHASE 0
#endif
constexpr int N_PHASES = 13;
#ifndef MK_NAIVE_MIX
#define MK_NAIVE_MIX 0
#endif

struct Args { const float* in[22]; float* out; unsigned char* ws; int ph_lo, ph_hi; };

struct Ctx {
    LAS unsigned char* lds; int vcu, G, wave_s;
    const float* const* in; float* out; unsigned char* ws;
};
#define CIN(i) (C.in[i])
#define WSP(T, off) ((T*)(C.ws + (off)))

template <int MODE>
__device__ __forceinline__ void transpose_item(const float* W, int K, int N, bf16_t* WT, int row_off, LAS float* scr, int item, int lane, const float* gain) {
    const int nblk = N / 32, kb = item / nblk, nb = item % nblk, k0 = 64 * kb, n0 = 32 * nb;
    int nsrc = n0 + (lane & 31);
    if (MODE == 1) { if (nsrc >= 2048 && nsrc < 3072) { const int base = nsrc & ~127, w = nsrc & 127; nsrc = base + (w >> 1) + 64 * (w & 1); } }
#pragma unroll 8
    for (int i = 0; i < 32; ++i) { const int kk = 2 * i + (lane >> 5); const float g = gain ? gain[k0 + kk] : 1.f; scr[kk * 33 + (lane & 31)] = W[(size_t)(k0 + kk) * N + nsrc] * g; }
    LDS_WAIT(); asm volatile("" ::: "memory");
    const int c = lane & 7;
#pragma unroll
    for (int j = 0; j < 4; ++j) { const int n = (lane >> 3) + 8 * j; const LAS float* s = scr + (8 * c) * 33 + n;
        v4u o; o.x = pk2(s[0 * 33], s[1 * 33]); o.y = pk2(s[2 * 33], s[3 * 33]); o.z = pk2(s[4 * 33], s[5 * 33]); o.w = pk2(s[6 * 33], s[7 * 33]);
        int drow = row_off + n0 + n; if (MODE == 2) { const int nc = n0 + n; drow = row_off + 256 * (nc >> 7) + (nc & 127); }
        *(GAS v4u*)(WT + (size_t)drow * K + k0 + 8 * c) = o; }
    LDS_WAIT(); asm volatile("" ::: "memory");
}
__device__ __forceinline__ void p0_prologue(const Ctx& C) {
    const int T_tid = tid_opaque(C.wave_s), T_lane = T_tid & 63, T_wave = C.wave_s; (void)T_lane; (void)T_wave;
    LAS float* scr = (LAS float*)(C.lds + T_wave * 16384);
    const int gw = C.vcu * NWAVES + T_wave, NGW = C.G * NWAVES;
    constexpr int I_IN = 16 * (NIN / 32), I_A = 8 * 32, I_SQ = 16 * 32, I_PP = 4 * 32;
    constexpr int NIT = I_IN + I_A + 3 * I_SQ + I_PP;
    for (int it = gw; it < NIT; it += NGW) { int r = it;
        if (r < I_IN) { transpose_item<1>(CIN(3), 1024, NIN, WSP(bf16_t, WS_WIN), 0, scr, r, T_lane, CIN(2)); continue; } r -= I_IN;
        if (r < I_A) { transpose_item<0>(CIN(7), 512, 1024, WSP(bf16_t, WS_WA), 0, scr, r, T_lane, nullptr); continue; } r -= I_A;
        if (r < I_SQ) { transpose_item<0>(CIN(8), 1024, 1024, WSP(bf16_t, WS_WB), 0, scr, r, T_lane, nullptr); continue; } r -= I_SQ;
        if (r < I_SQ) { transpose_item<0>(CIN(9), 1024, 1024, WSP(bf16_t, WS_WO), 0, scr, r, T_lane, nullptr); continue; } r -= I_SQ;
        if (r < I_SQ) { transpose_item<0>(CIN(19), 1024, 1024, WSP(bf16_t, WS_WPG), 0, scr, r, T_lane, CIN(18)); continue; } r -= I_SQ;
        transpose_item<0>(CIN(20), 256, 1024, WSP(bf16_t, WS_WPP), 0, scr, r, T_lane, nullptr);
    }
    { bf16_t* XB = (bf16_t*)C.out; float* rs1 = (float*)(C.ws + WS_SMALL + SM_RS1); const float* x = CIN(0);
      for (int m = gw; m < M; m += NGW) { const f32x4* xr = (const f32x4*)(x + (size_t)m * D) + T_lane; f32x4 v[4]; float s = 0.f;
#pragma unroll
        for (int j = 0; j < 4; ++j) { v[j] = xr[64 * j]; s += (v[j][0] * v[j][0] + v[j][1] * v[j][1]) + (v[j][2] * v[j][2] + v[j][3] * v[j][3]); }
        s = wave_sum(s); if (T_lane == 0) rs1[m] = rsqrtf(s * (1.f / D) + EPS);
#pragma unroll
        for (int j = 0; j < 4; ++j) st4bf(XB + (size_t)m * D + T_lane * 4 + 256 * j, v[j]); } }
    { const f32x4* p4 = (const f32x4*)CIN(1); bf16_t* PB = WSP(bf16_t, WS_PB); const int gt = C.vcu * 512 + T_tid, NT = C.G * 512;
      for (int i = gt; i < M * PLE / 4; i += NT) st4bf(PB + (size_t)i * 4, p4[i]); }
    if (C.vcu == 0) { float* lb = (float*)(C.ws + WS_SMALL + SM_LB); const float* l = CIN(4); const float l0 = l[T_tid], l1 = l[512 + T_tid]; lb[T_tid] = 1.f / (1.f + __expf(l1 - l0)); }
}
__device__ __forceinline__ void p2_naive_hgrn(const Ctx& C, int bh) {
    const int T_tid = tid_opaque(C.wave_s), T_lane = T_tid & 63, T_wave = C.wave_s; (void)T_lane; (void)T_wave;
    const bf16_t* QH = WSP(bf16_t, WS_QH); const bf16_t* VH = WSP(bf16_t, WS_VH); bf16_t* GH = WSP(bf16_t, WS_GH); const float* LF = (const float*)((unsigned char*)C.out + 32 * MiB); const float* hg_norm = CIN(5);
    LAS float* sh = (LAS float*)C.lds; const int b = bh >> 2, h = bh & 3, v = T_tid & 127; const bool act = T_tid < 128;
    float S[128];
#pragma unroll
    for (int k = 0; k < 128; ++k) S[k] = 0.f;
    const float gn = hg_norm[v];
    for (int t = 0; t < SEQ; ++t) { const size_t o512 = (size_t)(b * SEQ + t) * 512 + h * 128 + v; float vv = 0.f;
        if (act) { const float lf = LF[o512]; sh[v] = bf2f(QH[o512]); sh[128 + v] = __expf(lf); sh[256 + v] = -expm1f(lf); vv = bf2f(VH[o512]); }
        __syncthreads();
        float o = 0.f;
        if (act) {
#pragma unroll
            for (int k = 0; k < 128; ++k) { S[k] = sh[128 + k] * S[k] + sh[256 + k] * vv; o += sh[k] * S[k]; if ((k & 15) == 15) asm volatile("" ::: "memory"); } }
        const float ss = wave_sum(o * o); if (act && (v & 63) == 0) sh[384 + (v >> 6)] = ss;
        __syncthreads();
        if (act) { const float tot = sh[384] + sh[385]; const float y = o * rsqrtf(tot * (1.f / 128.f) + EPS) * gn * bf2f(GH[o512]); GH[o512] = (bf16_t)f2bf(y); }
    }
}
__device__ __forceinline__ void p2_naive_ret(const Ctx& C, int bh) {
    const int T_tid = tid_opaque(C.wave_s), T_lane = T_tid & 63, T_wave = C.wave_s; (void)T_lane; (void)T_wave;
    const bf16_t* RQ = WSP(bf16_t, WS_RQ); const bf16_t* RK = WSP(bf16_t, WS_RK); const bf16_t* RV = WSP(bf16_t, WS_RV); bf16_t* RG = WSP(bf16_t, WS_RG); const float* ret_norm = CIN(6);
    LAS float* sh = (LAS float*)C.lds; const int b = bh >> 2, h = bh & 3, v = T_tid & 255; const bool act = T_tid < 256;
    float S[128];
#pragma unroll
    for (int k = 0; k < 128; ++k) S[k] = 0.f;
    const float gn = ret_norm[v]; const float lg = gamma_lg(h), gam = __expf(lg);
    for (int t = 0; t < SEQ; ++t) { const size_t m = (size_t)(b * SEQ + t); const int tm = t & 127; float vv = 0.f;
        if (T_tid < 128) { sh[v] = bf2f(RQ[m * 512 + h * 128 + v]) * __expf(-(float)tm * lg); sh[128 + v] = bf2f(RK[m * 512 + h * 128 + v]) * __expf((float)tm * lg); }
        if (act) vv = bf2f(RV[m * 1024 + h * 256 + v]);
        __syncthreads();
        float o = 0.f;
        if (act) {
#pragma unroll
            for (int k = 0; k < 128; ++k) { S[k] = gam * S[k] + sh[128 + k] * vv; o += sh[k] * S[k]; if ((k & 15) == 15) asm volatile("" ::: "memory"); } }
        const float ss = wave_sum(o * o); if (act && (v & 63) == 0) sh[384 + (v >> 6)] = ss;
        __syncthreads();
        if (act) { const float tot = (sh[384] + sh[385]) + (sh[386] + sh[387]); const size_t oi = m * 1024 + h * 256 + v;
            const float y = o * rsqrtf(tot * (1.f / 256.f) + EPS) * gn * bf2f(RG[oi]); RG[oi] = (bf16_t)f2bf(y); }
    }
}
__device__ __forceinline__ void p6_router(const Ctx& C, gu32* ctl) {
    const int T_tid = tid_opaque(C.wave_s), T_lane = T_tid & 63, T_wave = C.wave_s; (void)T_lane; (void)T_wave;
    const int gw = C.vcu * NWAVES + T_wave, NGW = C.G * NWAVES;
    { LAS float* scr = (LAS float*)(C.lds + T_wave * 16384);
      constexpr int I_G = 16 * 8, I_D = 4 * 32, PER_E = 2 * I_G + I_D;
      for (int it = gw; it < NE * PER_E; it += NGW) { const int e = it / PER_E; int r = it - e * PER_E;
          if (r < I_G) { transpose_item<2>(CIN(15) + (size_t)e * 1024 * 256, 1024, 256, WSP(bf16_t, WS_WGU), e * 512, scr, r, T_lane, CIN(10)); continue; } r -= I_G;
          if (r < I_G) { transpose_item<2>(CIN(16) + (size_t)e * 1024 * 256, 1024, 256, WSP(bf16_t, WS_WGU), e * 512 + 128, scr, r, T_lane, CIN(10)); continue; } r -= I_G;
          transpose_item<0>(CIN(17) + (size_t)e * 256 * 1024, 256, 1024, WSP(bf16_t, WS_WD), e * 1024, scr, r, T_lane, nullptr); } }
    const float* X1 = C.out; const float* g2 = CIN(10); const float* wrg = CIN(11); const float* brg = CIN(12); const float* wre = CIN(13); const float* bre = CIN(14);
    bf16_t* H2 = WSP(bf16_t, WS_H2); int* eid = (int*)(C.ws + WS_SMALL + SM_EID); float* wgt = (float*)(C.ws + WS_SMALL + SM_WGT); int* list = WSP(int, WS_LIST); gu32* cnt = ctl + CW_CNT;
    for (int m = gw; m < M; m += NGW) { const int lane = T_lane;
        const f32x4* xr = (const f32x4*)(X1 + (size_t)m * D) + lane; f32x4 v[4]; float s = 0.f;
#pragma unroll
        for (int j = 0; j < 4; ++j) { v[j] = xr[64 * j]; s += (v[j][0] * v[j][0] + v[j][1] * v[j][1]) + (v[j][2] * v[j][2] + v[j][3] * v[j][3]); }
        s = wave_sum(s); const float rs = rsqrtf(s * (1.f / D) + EPS);
        float lg[36];
#pragma unroll
        for (int c = 0; c < 36; ++c) lg[c] = 0.f;
#pragma unroll
        for (int j = 0; j < 4; ++j) { st4bf(H2 + (size_t)m * D + lane * 4 + 256 * j, v[j] * rs);
            const float* wgj = wrg + (lane * 4 + 256 * j) * 4; const float* wej = wre + (lane * 4 + 256 * j) * 32; asm volatile("" : "+v"(wgj), "+v"(wej));
            const f32x4 g4 = *(const f32x4*)(g2 + lane * 4 + 256 * j);
#pragma unroll
            for (int q = 0; q < 4; ++q) { const float hv = v[j][q] * rs * g4[q];
                const f32x4 wg4 = *(const f32x4*)(wgj + q * 4);
#pragma unroll
                for (int c = 0; c < 4; ++c) lg[c] += hv * wg4[c];
#pragma unroll
                for (int c8 = 0; c8 < 8; ++c8) { const f32x4 we4 = *(const f32x4*)(wej + q * 32 + c8 * 4);
#pragma unroll
                    for (int c = 0; c < 4; ++c) lg[4 + c8 * 4 + c] += hv * we4[c]; }
                asm volatile("" ::: "memory"); } }
#pragma unroll
        for (int c = 0; c < 36; ++c) lg[c] = wave_sum(lg[c]);
        if (lane == 0) {
            float gl[4];
#pragma unroll
            for (int c = 0; c < 4; ++c) gl[c] = lg[c] + brg[c];
            float gmax = gl[0]; int gi = 0;
#pragma unroll
            for (int c = 1; c < 4; ++c) if (gl[c] > gmax) { gmax = gl[c]; gi = c; }
            float den = 0.f;
#pragma unroll
            for (int c = 0; c < 4; ++c) den += __expf(gl[c] - gmax);
            const float gw_ = 1.f / den;
            float el[8];
#pragma unroll
            for (int c = 0; c < 8; ++c) { el[c] = 0.f;
#pragma unroll
                for (int g = 0; g < 4; ++g) if (g == gi) el[c] = lg[4 + g * 8 + c] + bre[g * 8 + c]; }
            float m1 = el[0]; int i1 = 0;
#pragma unroll
            for (int c = 1; c < 8; ++c) if (el[c] > m1) { m1 = el[c]; i1 = c; }
            float m2 = -3.0e38f; int i2 = 0;
#pragma unroll
            for (int c = 0; c < 8; ++c) if (c != i1 && el[c] > m2) { m2 = el[c]; i2 = c; }
            const float w1 = 1.f / (1.f + __expf(m2 - m1)), w2 = 1.f - w1;
            const int e1 = gi * 8 + i1, e2 = gi * 8 + i2;
            eid[2 * m] = e1; eid[2 * m + 1] = e2; wgt[2 * m] = w1 * gw_; wgt[2 * m + 1] = w2 * gw_;
            const unsigned p1 = __hip_atomic_fetch_add(cnt + e1, 1u, __ATOMIC_RELAXED, __HIP_MEMORY_SCOPE_AGENT); list[e1 * LIST_CAP + (int)p1] = 2 * m;
            const unsigned p2 = __hip_atomic_fetch_add(cnt + e2, 1u, __ATOMIC_RELAXED, __HIP_MEMORY_SCOPE_AGENT); list[e2 * LIST_CAP + (int)p2] = 2 * m + 1;
        }
    }
}
__device__ __forceinline__ int moe_plan(const Ctx& C, gu32* ctl) {
    const int T_tid = tid_opaque(C.wave_s), T_lane = T_tid & 63, T_wave = C.wave_s; (void)T_lane; (void)T_wave;
    LAS int* offs = (LAS int*)(C.lds + OFFS_OFF); LAS int* tile_e = (LAS int*)(C.lds + TILEE_OFF);
    if (T_tid == 0) { int o = 0;
        for (int e = 0; e < NE; ++e) { const int c = (int)__hip_atomic_load(ctl + CW_CNT + e, __ATOMIC_RELAXED, __HIP_MEMORY_SCOPE_AGENT); offs[e] = o; offs[33 + e] = c; const int np = (c + 255) & ~255;
            for (int t = 0; t < np; t += 256) tile_e[(o + t) >> 8] = e; o += np; }
        offs[32] = o; }
    __syncthreads();
    return offs[32] >> 8;
}
__device__ __forceinline__ void moe_rowinfo(const Ctx& C, const pg8::GroupOrder& S) {
    const int T_tid = tid_opaque(C.wave_s), T_lane = T_tid & 63, T_wave = C.wave_s; (void)T_lane; (void)T_wave;
    LAS int* offs = (LAS int*)(C.lds + OFFS_OFF); LAS int* tile_e = (LAS int*)(C.lds + TILEE_OFF); LAS int* ri = (LAS int*)(C.lds + ROWINFO_OFF);
    const int* list = WSP(int, WS_LIST); const float* wgt = (const float*)(C.ws + WS_SMALL + SM_WGT);
    pg8::Unit u;
    for (int i = 0; i < 8 && S.next(i, u); ++i) {
        if (T_tid < 256) { const int e = tile_e[u.pm], idx = u.pm * 256 + T_tid - offs[e]; int a = -1; float w = 0.f;
            if (idx < offs[33 + e]) { a = list[e * LIST_CAP + idx]; w = wgt[a]; }
            ri[i * 512 + T_tid] = a; ((LAS float*)ri)[i * 512 + 256 + T_tid] = w; } }
    __syncthreads();
}
__device__ __forceinline__ void p9_combine(const Ctx& C) {
    const int T_tid = tid_opaque(C.wave_s), T_lane = T_tid & 63, T_wave = C.wave_s; (void)T_lane; (void)T_wave;
    const int gw = C.vcu * NWAVES + T_wave, NGW = C.G * NWAVES; float* X = C.out; const bf16_t* YS = WSP(bf16_t, WS_YS); bf16_t* X2B = WSP(bf16_t, WS_X2B);
    for (int m = gw; m < M; m += NGW) { const int lane = T_lane;
        f32x4* xr = (f32x4*)(X + (size_t)m * D) + lane; f32x4 v[4]; float s = 0.f;
#pragma unroll
        for (int j = 0; j < 4; ++j) { const int c = lane * 4 + 256 * j; v[j] = xr[64 * j] + ld4bf(YS + (size_t)(2 * m) * D + c) + ld4bf(YS + (size_t)(2 * m + 1) * D + c);
            s += (v[j][0] * v[j][0] + v[j][1] * v[j][1]) + (v[j][2] * v[j][2] + v[j][3] * v[j][3]); }
        s = wave_sum(s); const float rs = rsqrtf(s * (1.f / D) + EPS);
#pragma unroll
        for (int j = 0; j < 4; ++j) { xr[64 * j] = v[j]; st4bf(X2B + (size_t)m * D + lane * 4 + 256 * j, v[j] * rs); } }
}
__device__ __forceinline__ void p11_final(const Ctx& C) {
    const int T_tid = tid_opaque(C.wave_s), T_lane = T_tid & 63, T_wave = C.wave_s; (void)T_lane; (void)T_wave;
    const int gw = C.vcu * NWAVES + T_wave, NGW = C.G * NWAVES; float* X = C.out; const float* g = CIN(21);
    for (int m = gw; m < M; m += NGW) { const int lane = T_lane;
        f32x4* xr = (f32x4*)(X + (size_t)m * D) + lane; f32x4 v[4]; float s = 0.f;
#pragma unroll
        for (int j = 0; j < 4; ++j) { v[j] = xr[64 * j]; s += (v[j][0] * v[j][0] + v[j][1] * v[j][1]) + (v[j][2] * v[j][2] + v[j][3] * v[j][3]); }
        s = wave_sum(s); const float rs = rsqrtf(s * (1.f / D) + EPS);
#pragma unroll
        for (int j = 0; j < 4; ++j) { const f32x4 gg = *(const f32x4*)(g + lane * 4 + 256 * j); xr[64 * j] = v[j] * rs * gg; } }
}

__device__ __forceinline__ int rho(int p) { return (p & ~31) | (((p >> 2) & 1) << 4) | (((p >> 3) & 3) << 2) | (p & 3); }
constexpr int MX_QL = 0, MX_KL = 17408, MX_KT = 34816, MX_VT = 53248, MX_PL = 90112, MX_CH = 99328, MX_SSQ = 102912, MX_INV = 104960;
constexpr int QSTR = 272, TSTR = 144;
constexpr size_t OUT_UH = 0, OUT_UR = 8 * MiB;
constexpr size_t SM_DH = SM_RS3;
typedef pg8::bf16x8 bfx8;
#define MFMA16(a, b, c) __builtin_amdgcn_mfma_f32_16x16x32_bf16((a), (b), (c), 0, 0, 0)
#define LDS_B128(off) (*(const LAS bfx8*)(lds + (off)))

template <int NT, bool HG, bool STATE_ONLY>
__device__ __forceinline__ void mixer_unit(const Ctx& C, const int b, const int h, const int seg) {
    const int tid = tid_opaque(C.wave_s), lane = tid & 63, w = C.wave_s, fr = lane & 15, fq = lane >> 4;
    LAS unsigned char* lds = C.lds;
    constexpr int DV = NT * 128, LDV = HG ? 512 : 1024;
    const int bh = b * 4 + h, unit = bh * 16 + seg, m0 = b * SEQ + seg * 512;
    const bf16_t* Qg = WSP(bf16_t, HG ? WS_QH : WS_RQ) + h * 128; const bf16_t* Kg = WSP(bf16_t, WS_RK) + h * 128;
    const bf16_t* Vg = WSP(bf16_t, HG ? WS_VH : WS_RV) + h * DV; bf16_t* Gg = WSP(bf16_t, HG ? WS_GH : WS_RG) + h * DV;
    const float* LFg = (const float*)((unsigned char*)C.out + 32 * MiB) + h * 128;
    float* Ug = (float*)((unsigned char*)C.out + (HG ? OUT_UH : OUT_UR)) + (size_t)unit * 128 * DV;
    float* DHg = (float*)(C.ws + WS_SMALL + SM_DH) + unit * 128;
    const float* gn = HG ? CIN(5) : CIN(6);
    const float lgam = gamma_lg(h), g128 = __expf(128.f * lgam);
    LAS float* ch_emid = (LAS float*)(lds + MX_CH); LAS float* ch_elm = ch_emid + 128; LAS float* ch_dl = ch_emid + 256; LAS float* ch_part = ch_emid + 384;
    LAS float* ssq = (LAS float*)(lds + MX_SSQ); LAS float* invs = (LAS float*)(lds + MX_INV);

    f32x4 S[8][NT];
#pragma unroll
    for (int kt = 0; kt < 8; ++kt)
#pragma unroll
        for (int nt = 0; nt < NT; ++nt) {
            if (STATE_ONLY) S[kt][nt] = (f32x4){0.f, 0.f, 0.f, 0.f};
            else { const float* up = Ug + (size_t)(16 * kt + 4 * fq) * DV + 16 * (w * NT + nt) + fr;
                S[kt][nt] = (f32x4){up[0], up[DV], up[2 * DV], up[3 * DV]}; } }
    float bseg = 0.f;

    for (int c = 0; c < 8; ++c) {
        const int r0 = m0 + 64 * c;
        if (HG) {
            const int k = tid & 127, qd = tid >> 7, rr = rho(k);
            float cs[16], qv[16], kk[16];
#pragma unroll
            for (int i = 0; i < 16; ++i) { const size_t gi = (size_t)(r0 + 16 * qd + i) * 512 + k; cs[i] = LFg[gi]; if (!STATE_ONLY) qv[i] = bf2f(Qg[gi]); else qv[i] = 0.f; }
#pragma unroll
            for (int i = 0; i < 16; ++i) kk[i] = 1.f - __expf(cs[i]);
#pragma unroll
            for (int i = 1; i < 16; ++i) cs[i] += cs[i - 1];
            ch_part[qd * 128 + k] = cs[15];
            __syncthreads();
            const float p0 = ch_part[k], p1 = ch_part[128 + k], p2 = ch_part[256 + k], p3 = ch_part[384 + k];
            const float off = (qd > 0 ? p0 : 0.f) + (qd > 1 ? p1 : 0.f) + (qd > 2 ? p2 : 0.f), bmid = p0 + p1, blast = (p0 + p1) + (p2 + p3);
            unsigned kb[16];
#pragma unroll
            for (int i = 0; i < 16; ++i) { const int t = 16 * qd + i; const float e1 = __expf(fminf(fmaxf(off + cs[i] - bmid, -80.f), 80.f)); const float kt_ = kk[i] * __builtin_amdgcn_rcpf(e1);
                kb[i] = f2bf(kt_);
                if (!STATE_ONLY) { *(LAS unsigned short*)(lds + MX_QL + t * QSTR + 2 * k) = (unsigned short)f2bf(qv[i] * e1); *(LAS unsigned short*)(lds + MX_KL + t * QSTR + 2 * k) = (unsigned short)kb[i]; } }
            { pg8::u32x4 w0, w1; w0.x = kb[0] | (kb[1] << 16); w0.y = kb[2] | (kb[3] << 16); w0.z = kb[4] | (kb[5] << 16); w0.w = kb[6] | (kb[7] << 16);
              w1.x = kb[8] | (kb[9] << 16); w1.y = kb[10] | (kb[11] << 16); w1.z = kb[12] | (kb[13] << 16); w1.w = kb[14] | (kb[15] << 16);
              *(LAS pg8::u32x4*)(lds + MX_KT + rr * TSTR + 32 * qd) = w0; *(LAS pg8::u32x4*)(lds + MX_KT + rr * TSTR + 32 * qd + 16) = w1; }
            if (qd == 0) { ch_emid[rr] = __expf(bmid); ch_elm[rr] = __expf(blast - bmid); ch_dl[rr] = __expf(blast); bseg += blast; }
        } else {
#pragma unroll
            for (int i = 0; i < 2; ++i) { const int pc = 2 * w + i; const size_t gi = (size_t)(r0 + lane) * 512 + pc * 8;
                if (!STATE_ONLY) { const pg8::u32x4 qw = *(const pg8::u32x4*)(Qg + gi); *(LAS pg8::u32x4*)(lds + MX_QL + lane * QSTR + pc * 16) = qw; }
                const pg8::u32x4 kw = *(const pg8::u32x4*)(Kg + gi);
                if (!STATE_ONLY) *(LAS pg8::u32x4*)(lds + MX_KL + lane * QSTR + pc * 16) = kw;
                const unsigned kwv[4] = {kw.x, kw.y, kw.z, kw.w};
#pragma unroll
                for (int j = 0; j < 8; ++j) { const unsigned short e = (unsigned short)(kwv[j >> 1] >> (16 * (j & 1))); *(LAS unsigned short*)(lds + MX_KT + rho(pc * 8 + j) * TSTR + 2 * lane) = e; } }
        }
#pragma unroll
        for (int i = 0; i < 2 * NT; ++i) { const int pc = 2 * NT * w + i; const pg8::u32x4 vw = *(const pg8::u32x4*)(Vg + (size_t)(r0 + lane) * LDV + pc * 8);
            const unsigned vwv[4] = {vw.x, vw.y, vw.z, vw.w};
#pragma unroll
            for (int j = 0; j < 8; ++j) { const unsigned short e = (unsigned short)(vwv[j >> 1] >> (16 * (j & 1))); *(LAS unsigned short*)(lds + MX_VT + (pc * 8 + j) * TSTR + 2 * lane) = e; } }
        __syncthreads();

        f32x4 o[4][NT];
        if (!STATE_ONLY) {
#pragma unroll
            for (int i = 0; i < 2; ++i) { const int id = 2 * w + i, si = id >> 2, ti = id & 3; f32x4 a = (f32x4){0.f, 0.f, 0.f, 0.f};
                if (si <= ti) {
#pragma unroll
                    for (int ks = 0; ks < 4; ++ks) a = MFMA16(LDS_B128(MX_KL + (16 * si + fr) * QSTR + 64 * ks + 16 * fq), LDS_B128(MX_QL + (16 * ti + fr) * QSTR + 64 * ks + 16 * fq), a);
                    if (si == ti) {
#pragma unroll
                        for (int r = 0; r < 4; ++r) if (4 * fq + r > fr) a[r] = 0.f; } }
                u32x2 pw; pw.x = pk2(a[0], a[1]); pw.y = pk2(a[2], a[3]);
                *(LAS u32x2*)(lds + MX_PL + (16 * ti + fr) * TSTR + 2 * (16 * si + 4 * fq)) = pw; }
            __syncthreads();
#pragma unroll
            for (int mt = 0; mt < 4; ++mt)
#pragma unroll
                for (int nt = 0; nt < NT; ++nt) o[mt][nt] = (f32x4){0.f, 0.f, 0.f, 0.f};
#pragma unroll
            for (int ks = 0; ks < 4; ++ks) { bfx8 bf[NT];
#pragma unroll
                for (int nt = 0; nt < NT; ++nt) { f32x4 s0 = S[2 * ks][nt], s1 = S[2 * ks + 1][nt];
                    if (HG) { s0 = s0 * *(const LAS f32x4*)(ch_emid + 32 * ks + 4 * fq); s1 = s1 * *(const LAS f32x4*)(ch_emid + 32 * ks + 16 + 4 * fq); }
                    pg8::u32x4 pk; pk.x = pk2(s0[0], s0[1]); pk.y = pk2(s0[2], s0[3]); pk.z = pk2(s1[0], s1[1]); pk.w = pk2(s1[2], s1[3]); bf[nt] = __builtin_bit_cast(bfx8, pk); }
#pragma unroll
                for (int mt = 0; mt < 4; ++mt) { const bfx8 af = LDS_B128(MX_QL + (16 * mt + fr) * QSTR + 64 * ks + 16 * fq);
#pragma unroll
                    for (int nt = 0; nt < NT; ++nt) o[mt][nt] = MFMA16(af, bf[nt], o[mt][nt]); } }
#pragma unroll
            for (int ks = 0; ks < 2; ++ks) { bfx8 vf[NT];
#pragma unroll
                for (int nt = 0; nt < NT; ++nt) vf[nt] = LDS_B128(MX_VT + (16 * (w * NT + nt) + fr) * TSTR + 64 * ks + 16 * fq);
#pragma unroll
                for (int mt = 0; mt < 4; ++mt) { if (32 * ks > 16 * mt + 15) continue;
                    const bfx8 af = LDS_B128(MX_PL + (16 * mt + fr) * TSTR + 64 * ks + 16 * fq);
#pragma unroll
                    for (int nt = 0; nt < NT; ++nt) o[mt][nt] = MFMA16(af, vf[nt], o[mt][nt]); } }
        }
        if (HG) {
            f32x4 P[8][NT];
#pragma unroll
            for (int kt = 0; kt < 8; ++kt)
#pragma unroll
                for (int nt = 0; nt < NT; ++nt) P[kt][nt] = (f32x4){0.f, 0.f, 0.f, 0.f};
#pragma unroll
            for (int ks = 0; ks < 2; ++ks) { bfx8 vf[NT];
#pragma unroll
                for (int nt = 0; nt < NT; ++nt) vf[nt] = LDS_B128(MX_VT + (16 * (w * NT + nt) + fr) * TSTR + 64 * ks + 16 * fq);
#pragma unroll
                for (int kt = 0; kt < 8; ++kt) { const bfx8 af = LDS_B128(MX_KT + (16 * kt + fr) * TSTR + 64 * ks + 16 * fq);
#pragma unroll
                    for (int nt = 0; nt < NT; ++nt) P[kt][nt] = MFMA16(af, vf[nt], P[kt][nt]); } }
#pragma unroll
            for (int kt = 0; kt < 8; ++kt) { const f32x4 dl = *(const LAS f32x4*)(ch_dl + 16 * kt + 4 * fq), el = *(const LAS f32x4*)(ch_elm + 16 * kt + 4 * fq);
#pragma unroll
                for (int nt = 0; nt < NT; ++nt) S[kt][nt] = dl * S[kt][nt] + el * P[kt][nt]; }
        } else {
#pragma unroll
            for (int ks = 0; ks < 2; ++ks) { bfx8 vf[NT];
#pragma unroll
                for (int nt = 0; nt < NT; ++nt) vf[nt] = LDS_B128(MX_VT + (16 * (w * NT + nt) + fr) * TSTR + 64 * ks + 16 * fq);
#pragma unroll
                for (int kt = 0; kt < 8; ++kt) { const bfx8 af = LDS_B128(MX_KT + (16 * kt + fr) * TSTR + 64 * ks + 16 * fq);
#pragma unroll
                    for (int nt = 0; nt < NT; ++nt) S[kt][nt] = MFMA16(af, vf[nt], S[kt][nt]); } }
            if (c & 1) {
#pragma unroll
                for (int kt = 0; kt < 8; ++kt)
#pragma unroll
                    for (int nt = 0; nt < NT; ++nt) S[kt][nt] = S[kt][nt] * g128; }
        }
        if (!STATE_ONLY) {
#pragma unroll
            for (int mt = 0; mt < 4; ++mt)
#pragma unroll
                for (int r = 0; r < 4; ++r) { float q = 0.f;
#pragma unroll
                    for (int nt = 0; nt < NT; ++nt) q += o[mt][nt][r] * o[mt][nt][r];
                    q += __shfl_xor(q, 1); q += __shfl_xor(q, 2); q += __shfl_xor(q, 4); q += __shfl_xor(q, 8);
                    if (fr == 0) ssq[w * 64 + 16 * mt + 4 * fq + r] = q; }
            __syncthreads();
            if (tid < 64) { float tot = 0.f;
#pragma unroll
                for (int ww = 0; ww < 8; ++ww) tot += ssq[ww * 64 + tid];
                invs[tid] = rsqrtf(tot * (1.f / DV) + EPS); }
            __syncthreads();
#pragma unroll
            for (int nt = 0; nt < NT; ++nt) { const int v = 16 * (w * NT + nt) + fr; const float g = gn[v];
#pragma unroll
                for (int mt = 0; mt < 4; ++mt)
#pragma unroll
                    for (int r = 0; r < 4; ++r) { const int t = 16 * mt + 4 * fq + r; bf16_t* gp = Gg + (size_t)(r0 + t) * LDV + v;
                        *gp = (bf16_t)f2bf(o[mt][nt][r] * invs[t] * g * bf2f(*gp)); } }
        } else { __syncthreads(); }
    }
    if (STATE_ONLY) {
#pragma unroll
        for (int kt = 0; kt < 8; ++kt)
#pragma unroll
            for (int nt = 0; nt < NT; ++nt) { float* up = Ug + (size_t)(16 * kt + 4 * fq) * DV + 16 * (w * NT + nt) + fr;
                up[0] = S[kt][nt][0]; up[DV] = S[kt][nt][1]; up[2 * DV] = S[kt][nt][2]; up[3 * DV] = S[kt][nt][3]; }
        if (HG && tid < 128) DHg[rho(tid)] = __expf(bseg);
    }
}
__device__ __forceinline__ void mixer_scan(const Ctx& C) {
    const int tid = tid_opaque(C.wave_s); const int gt = C.vcu * 512 + tid;
    float* UH = (float*)((unsigned char*)C.out + OUT_UH); float* UR = (float*)((unsigned char*)C.out + OUT_UR); const float* DH = (const float*)(C.ws + WS_SMALL + SM_DH);
    { const int bh = gt >> 14, e = gt & 16383, row = e >> 7; float carry = 0.f;
      for (int s = 0; s < 16; ++s) { float* p = UH + ((size_t)(bh * 16 + s) << 14) + e; const float u = *p; *p = carry; carry = DH[(bh * 16 + s) * 128 + row] * carry + u; } }
#pragma unroll 1
    for (int i = 0; i < 2; ++i) { const int g2 = gt + i * 131072; const int bh = g2 >> 15, e = g2 & 32767; const float d = __expf(512.f * gamma_lg(bh & 3)); float carry = 0.f;
      for (int s = 0; s < 16; ++s) { float* p = UR + ((size_t)(bh * 16 + s) << 15) + e; const float u = *p; *p = carry; carry = d * carry + u; } }
}
template <bool STATE_ONLY> __device__ __forceinline__ void mixer_phase(const Ctx& C) {
    for (int uu = C.vcu; uu < 256; uu += C.G) { const int u = uu & 127, b = u >> 6, h = (u >> 4) & 3, seg = u & 15;
        if (uu < 128) mixer_unit<1, true, STATE_ONLY>(C, b, h, seg); else mixer_unit<2, false, STATE_ONLY>(C, b, h, seg); }
}

__global__ void __launch_bounds__(NWAVES * 64, 2) fwd(Args args) {
    extern __shared__ __attribute__((aligned(16))) unsigned char lds_raw[];
    Ctx C; C.lds = (LAS unsigned char*)lds_raw; C.wave_s = __builtin_amdgcn_readfirstlane((int)threadIdx.x >> 6);
    C.G = gridDim.x; { const int bx = blockIdx.x; C.vcu = (C.G % 8 == 0) ? (bx % 8) * (C.G / 8) + bx / 8 : bx; }
    C.in = args.in; C.out = args.out; C.ws = args.ws;
    gu32* ctl = (gu32*)(args.ws + WS_CTL);
    volatile LAS unsigned* MISC = (volatile LAS unsigned*)(C.lds + MISC_OFF);
    for (int u = threadIdx.x; u < (2048) / 4; u += NWAVES * 64) ((LAS unsigned*)(C.lds + LDSCTL_OFF))[u] = 0u;
    __syncthreads();
    XcdBarrier bar; bar.bar = (unsigned*)(ctl + CW_BAR); bar.x = 0; bar.st = nullptr;
    if (!MK_PER_PHASE) bar = xcd_barrier_post((unsigned*)(ctl + CW_BAR), MISC + 8);
    const int lo = args.ph_lo, hi = args.ph_hi;
#define IN(k) (lo <= (k) && (k) < hi)
#define SEAM(k) do { if (IN(k) && IN((k) + 1)) xcd_barrier(bar, C.wave_s); } while (0)
    PG8_LAS unsigned char* ring = (PG8_LAS unsigned char*)C.lds;
    using namespace pg8;
    if (IN(0)) { p0_prologue(C); } SEAM(0);
    if (IN(1)) { Gemm g{(const bf16_t*)C.out, WSP(bf16_t, WS_WIN), M, NIN, 1024}; DenseOrder S; S.init(M, NIN, C.G, (int)blockIdx.x);
        EpiP1 E{(const float*)(C.ws + WS_SMALL + SM_RS1), (const float*)(C.ws + WS_SMALL + SM_LB), (float*)((unsigned char*)C.out + 32 * MiB),
                WSP(bf16_t, WS_QH), WSP(bf16_t, WS_VH), WSP(bf16_t, WS_GH), WSP(bf16_t, WS_RQ), WSP(bf16_t, WS_RK), WSP(bf16_t, WS_RV), WSP(bf16_t, WS_RG), WSP(bf16_t, WS_GA), WSP(bf16_t, WS_GB)};
        gemm_phase<EpiP1, DenseOrder>(ring, C.wave_s, g, S, E); } SEAM(1);
#if MK_NAIVE_MIX
    if (IN(2)) { if (C.vcu < 8) p2_naive_hgrn(C, C.vcu); else if (C.vcu < 16) p2_naive_ret(C, C.vcu - 8); } SEAM(2); SEAM(3); SEAM(4);
#else
    if (IN(2)) { mixer_phase<true>(C); } SEAM(2);
    if (IN(3)) { mixer_scan(C); } SEAM(3);
    if (IN(4)) { mixer_phase<false>(C); } SEAM(4);
#endif
    if (IN(5)) { DenseOrder S; S.init(M, 1024, C.G, (int)blockIdx.x);
        { Gemm g{WSP(bf16_t, WS_GH), WSP(bf16_t, WS_WA), M, 1024, 512}; EpiF<EpiGateMul> E{{WSP(bf16_t, WS_GA), WSP(bf16_t, WS_MG)}}; gemm_phase<EpiF<EpiGateMul>, DenseOrder>(ring, C.wave_s, g, S, E); }
        { Gemm g{WSP(bf16_t, WS_RG), WSP(bf16_t, WS_WB), M, 1024, 1024}; EpiF<EpiGateMulAdd> E{{WSP(bf16_t, WS_GB), WSP(bf16_t, WS_MG)}}; gemm_phase<EpiF<EpiGateMulAdd>, DenseOrder>(ring, C.wave_s, g, S, E); } } SEAM(5);
    if (IN(6)) { DenseOrder S; S.init(M, 1024, C.G, (int)blockIdx.x); Gemm g{WSP(bf16_t, WS_MG), WSP(bf16_t, WS_WO), M, 1024, 1024};
        EpiF<EpiResid, false> E{{CIN(0), C.out}}; gemm_phase<EpiF<EpiResid, false>, DenseOrder>(ring, C.wave_s, g, S, E); } SEAM(6);
    if (IN(7)) { p6_router(C, ctl); } SEAM(7);
    if (IN(8)) { const int ntiles = moe_plan(C, ctl); GroupOrder S{ntiles, 2, C.G, (int)blockIdx.x, (const PG8_LAS int*)(C.lds + TILEE_OFF)}; moe_rowinfo(C, S);
        Gemm g{WSP(bf16_t, WS_H2), WSP(bf16_t, WS_WGU), 0, 512, 1024}; EpiPairF<EpiGateUp> E{{WSP(bf16_t, WS_HM)}};
        gemm_phase<EpiPairF<EpiGateUp>, GroupOrder, true, true, true>(ring, C.wave_s, g, S, E, (const PG8_LAS int*)(C.lds + ROWINFO_OFF)); } SEAM(8);
    if (IN(9)) { const int ntiles = moe_plan(C, ctl); GroupOrder S{ntiles, 4, C.G, (int)blockIdx.x, (const PG8_LAS int*)(C.lds + TILEE_OFF)}; moe_rowinfo(C, S);
        Gemm g{WSP(bf16_t, WS_HM), WSP(bf16_t, WS_WD), 0, 1024, 256}; EpiF<EpiDown> E{{(const PG8_LAS int*)(C.lds + ROWINFO_OFF), WSP(bf16_t, WS_YS)}};
        gemm_phase<EpiF<EpiDown>, GroupOrder>(ring, C.wave_s, g, S, E); } SEAM(9);
    if (IN(10)) { p9_combine(C); } SEAM(10);
    if (IN(11)) { DenseOrder S; S.init(M, 1024, C.G, (int)blockIdx.x);
        { Gemm g{WSP(bf16_t, WS_PB), WSP(bf16_t, WS_WPP), M, 1024, 256}; EpiF<EpiStoreBf> E{{WSP(bf16_t, WS_PP)}}; gemm_phase<EpiF<EpiStoreBf>, DenseOrder>(ring, C.wave_s, g, S, E); }
        { Gemm g{WSP(bf16_t, WS_X2B), WSP(bf16_t, WS_WPG), M, 1024, 1024}; EpiF<EpiPle> E{{WSP(bf16_t, WS_PP), C.out}}; gemm_phase<EpiF<EpiPle>, DenseOrder>(ring, C.wave_s, g, S, E); } } SEAM(11);
    if (IN(12)) { p11_final(C); }
#undef IN
#undef SEAM
}

extern "C" void kernel_launch(void* const* d_in, const int* in_sizes, int n_in, void* d_out, int out_size, void* d_ws, size_t ws_size, hipStream_t stream) {
    static int grid = 0;
    if (grid == 0) {
        int dev = 0, cus = 0, per_cu = 0;
        if (hipGetDevice(&dev) != hipSuccess || hipDeviceGetAttribute(&cus, hipDeviceAttributeMultiprocessorCount, dev) != hipSuccess) { fprintf(stderr, "kernel_launch: device query failed\n"); grid = -1; return; }
        if (hipFuncSetAttribute((const void*)fwd, hipFuncAttributeMaxDynamicSharedMemorySize, LDS_BYTES) != hipSuccess) { fprintf(stderr, "kernel_launch: hipFuncSetAttribute failed\n"); grid = -1; return; }
        if (hipOccupancyMaxActiveBlocksPerMultiprocessor(&per_cu, (const void*)fwd, NWAVES * 64, LDS_BYTES) != hipSuccess || per_cu < 1) { fprintf(stderr, "kernel_launch: occupancy query says %d blocks/CU\n", per_cu); }
        (void)hipGetLastError();
        grid = cus;
    }
    if (grid < 0) return;
    (void)hipMemsetAsync((char*)d_ws + WS_CTL, 0, 1 * MiB, stream);
    Args a{};
    for (int i = 0; i < 22; ++i) a.in[i] = (const float*)d_in[i];
    a.out = (float*)d_out; a.ws = (unsigned char*)d_ws;
#if MK_PER_PHASE
    for (int p = 0; p < N_PHASES; ++p) { a.ph_lo = p; a.ph_hi = p + 1; hipLaunchKernelGGL(fwd, dim3(grid), dim3(NWAVES * 64), LDS_BYTES, stream, a); }
#else
    a.ph_lo = 0; a.ph_hi = N_PHASES; hipLaunchKernelGGL(fwd, dim3(grid), dim3(NWAVES * 64), LDS_BYTES, stream, a);
#endif
}
```

```cpp
#include <hip/hip_runtime.h>
#include <cstdint>
#include <cstdio>

typedef unsigned short bf16_t;
typedef float f32x4 __attribute__((ext_vector_type(4)));
typedef unsigned u32x2 __attribute__((ext_vector_type(2)));

constexpr int M = 16384, D = 1024, SEQ = 8192, NIN = 7168, PLE = 256;
constexpr int NE = 32, DE = 256;
constexpr float EPS = 1e-6f;
constexpr int LIST_CAP = 32768;
constexpr int POS_CAP = 40960;

constexpr size_t MiB = 1u << 20;
constexpr size_t WS_CTL = 0;
constexpr size_t WS_SMALL = 1 * MiB;
constexpr size_t WS_LIST = 2 * MiB;
constexpr size_t WS_WA = 6 * MiB, WS_WB = 7 * MiB, WS_WO = 9 * MiB, WS_WPG = 11 * MiB, WS_WPP = 13 * MiB;
constexpr size_t WS_WR = 13 * MiB + 512 * 1024;
constexpr size_t WS_PB = 14 * MiB;
constexpr size_t WS_WIN = 22 * MiB;
constexpr size_t WS_QH = 36 * MiB, WS_VH = 52 * MiB, WS_GH = 68 * MiB, WS_RQ = 84 * MiB, WS_RK = 100 * MiB;
constexpr size_t WS_RV = 116 * MiB, WS_RG = 148 * MiB, WS_GA = 180 * MiB, WS_GB = 212 * MiB;
constexpr size_t WS_MG = 116 * MiB;
constexpr size_t WS_WGU = 84 * MiB;
constexpr size_t WS_WD = 36 * MiB;
constexpr size_t WS_H2 = 148 * MiB;
constexpr size_t WS_HM = 116 * MiB;
constexpr size_t WS_YS = 180 * MiB;
constexpr size_t WS_X2B = 148 * MiB;
constexpr size_t WS_PP = 52 * MiB;
constexpr size_t SM_RS1 = 0, SM_RS2 = 64 * 1024, SM_RS3 = 128 * 1024, SM_EID = 192 * 1024, SM_WGT = 320 * 1024, SM_LB = 448 * 1024;
constexpr size_t SM_ROWMAP = 512 * 1024;
constexpr size_t SM_TILEE = 700 * 1024;
constexpr int CW_CNT = 1024;

__device__ __forceinline__ unsigned f2bf(float f) { unsigned u = __float_as_uint(f); return (u + 0x7fffu + ((u >> 16) & 1u)) >> 16; }
__device__ __forceinline__ float bf2f(unsigned short h) { return __uint_as_float(((unsigned)h) << 16); }
__device__ __forceinline__ unsigned pk2(float lo, float hi) { return f2bf(lo) | (f2bf(hi) << 16); }
__device__ __forceinline__ float siluf(float v) { return v * __builtin_amdgcn_rcpf(1.f + __builtin_amdgcn_exp2f(-1.4426950408889634f * v)); }
__device__ __forceinline__ float sigmf(float v) { return __builtin_amdgcn_rcpf(1.f + __builtin_amdgcn_exp2f(-1.4426950408889634f * v)); }
__device__ __forceinline__ void st4bf(bf16_t* p, f32x4 v) { u32x2 w; w.x = pk2(v[0], v[1]); w.y = pk2(v[2], v[3]); *(u32x2*)p = w; }
__device__ __forceinline__ f32x4 ld4bf(const bf16_t* p) { u32x2 w = *(const u32x2*)p; f32x4 r; r[0] = __uint_as_float(w.x << 16); r[1] = __uint_as_float(w.x & 0xffff0000u); r[2] = __uint_as_float(w.y << 16); r[3] = __uint_as_float(w.y & 0xffff0000u); return r; }
__device__ __forceinline__ float wave_sum(float v) {
#pragma unroll
    for (int o = 1; o < 64; o <<= 1) v += __shfl_xor(v, o);
    return v;
}
__device__ __forceinline__ int tid_opaque(int wave_s) { int t = (wave_s << 6) | (int)__builtin_amdgcn_mbcnt_hi(~0u, __builtin_amdgcn_mbcnt_lo(~0u, 0u)); asm volatile("" : "+v"(t)); return t; }
__device__ __forceinline__ float gamma_lg(int h) { return log1pf(-exp2f(-5.f - (float)h)); }


namespace pg8 {
#define PG8_LAS __attribute__((address_space(3)))
typedef short bf16x8 __attribute__((ext_vector_type(8)));
typedef unsigned u32x4 __attribute__((ext_vector_type(4)));
constexpr int BM = 256, BK = 64, HALF = 128, HTB = HALF * BK * 2  , STAGE_BYTES = 8 * HTB, NXCD = 8, WGM = 8;

__host__ __device__ __forceinline__ int lds_byte(int r, int c) { const int st = (r >> 4) * 2 + (c >> 5), rr = r & 15, cc = c & 31, ob = rr * 64 + cc * 2; return st * 1024 + (ob ^ (((ob >> 9) & 1) << 5)); }
__host__ __device__ __forceinline__ void stage_rc(int b, int& R, int& C) { const int st = b / 1024, sb = b % 1024, swz = sb ^ (((sb >> 9) & 1) << 5); R = (st >> 1) * 16 + swz / 64; C = (st & 1) * 32 + (swz % 64) / 2; }
__host__ __device__ __forceinline__ int perm32(int rho) { const int n = rho >> 4, i = rho & 15; return 8 * (i >> 2) + 4 * n + (i & 3); }

struct Unit { int pm, pn, pb, ui; };
struct Gemm { const bf16_t* A; const bf16_t* Bt; int M, N, K; };

struct DenseOrder {
    int nM, nN, nwg, G, c;
    __host__ __device__ void init(int M, int N, int G_, int c_) { nM = M / BM; nN = N / BM; nwg = nM * nN; G = G_; c = c_; }
    __host__ __device__ bool next(int i, Unit& u) const {
        const long L = (long)i * G + c; if (L >= nwg) return false;
        int wgid = (int)L; { const int q = nwg / NXCD, r = nwg % NXCD, xcd = wgid % NXCD, off = wgid / NXCD; wgid = (xcd < r ? xcd * (q + 1) : r * (q + 1) + (xcd - r) * q) + off; }
        const int nig = WGM * nN, gid = wgid / nig, fm = gid * WGM, gsz = (nM - fm) < WGM ? (nM - fm) : WGM;
        u.pm = fm + ((wgid % nig) % gsz); u.pn = (wgid % nig) / gsz; u.pb = u.pn; u.ui = i; return true;
    }
    __device__ __forceinline__ void a_ready(const Unit&) const {}
    __device__ __forceinline__ void done(const Unit&) const {}
};
struct GroupOrder {
    int ntiles, NTN, G, c; const PG8_LAS int* tile_e;
    __device__ bool next(int i, Unit& u) const {
        const int L = i * G + c; if (L >= ntiles * NTN) return false;
        const int tile = L / NTN, pn = L - tile * NTN;
        u.pm = tile; u.pn = pn; u.pb = tile_e[tile] * NTN + pn; u.ui = i; return true;
    }
    __device__ __forceinline__ void a_ready(const Unit&) const {}
    __device__ __forceinline__ void done(const Unit&) const {}
};

template <class F, bool PERM_ = true> struct EpiF {
    static constexpr bool PERM = PERM_, AFTER_DRAIN = false; F f;
    __device__ __forceinline__ void operator()(const f32x4 (&acc)[2][2][4][2], const Unit& u, int wr, int wc, int fr, int fq) const {
#pragma unroll
        for (int ai = 0; ai < 2; ++ai)
#pragma unroll
            for (int m = 0; m < 4; ++m) { const int row = u.pm * BM + ai * HALF + wr * 64 + m * 16 + fr;
#pragma unroll
                for (int bj = 0; bj < 2; ++bj)
#pragma unroll
                    for (int n = 0; n < 2; ++n) { const int col = u.pn * BM + bj * HALF + wc * 32 + (PERM ? 8 * fq + 4 * n : 16 * n + 4 * fq); f(u, row, col, acc[ai][bj][m][n]); }
                asm volatile("" ::: "memory"); }
    }
};
template <class F> struct EpiPairF {
    static constexpr bool PERM = true, AFTER_DRAIN = false; F f;
    __device__ __forceinline__ void operator()(const f32x4 (&acc)[2][2][4][2], const Unit& u, int wr, int wc, int fr, int fq) const {
#pragma unroll
        for (int ai = 0; ai < 2; ++ai)
#pragma unroll
            for (int m = 0; m < 4; ++m) { const int row = u.pm * BM + ai * HALF + wr * 64 + m * 16 + fr;
#pragma unroll
                for (int n = 0; n < 2; ++n) { const int col = u.pn * HALF + wc * 32 + 8 * fq + 4 * n; f.pair(u, row, col, acc[ai][0][m][n], acc[ai][1][m][n]); }
                asm volatile("" ::: "memory"); }
    }
};

template <class Epi, class Sched, bool ALIGN_EPI = true, bool SP2 = true, bool GATHER = false>
__device__ __forceinline__ void gemm_phase(PG8_LAS unsigned char* lds, const int wave_s, const Gemm g, const Sched& S, const Epi& E, const PG8_LAS int* rowtab = nullptr) {
    static_assert(SP2, "only the SP2 loop is kept in this file");
    const int tid = tid_opaque(wave_s), wid = wave_s, lane = tid & 63, wr = wid >> 2, wc = wid & 3, fr = lane & 15, fq = lane >> 4;
    const int K = g.K, nt = K / BK;
    unsigned voffA[2], voffB[2];
#pragma unroll
    for (int i = 0; i < 2; ++i) { int R, C; stage_rc(tid * 16 + i * 8192, R, C); const int Rb = Epi::PERM ? ((R & ~31) + perm32(R & 31)) : R;
        voffA[i] = (unsigned)(R * K + C) * 2u; voffB[i] = (unsigned)(Rb * K + C) * 2u; }
    unsigned cvA[2][2];
    (void)cvA;
#define PG8_GOFF(dst, u_) do { _Pragma("unroll") for (int _h = 0; _h < 2; ++_h) _Pragma("unroll") for (int _i = 0; _i < 2; ++_i) { int R_, C_; stage_rc(tid * 16 + _i * 8192, R_, C_); \
        const int a_ = rowtab[(u_).ui * 512 + _h * HALF + R_]; const int tok_ = a_ < 0 ? 0 : (a_ >> 1); dst[_h][_i] = (unsigned)(tok_ * K + C_) * 2u; } } while (0)
    const size_t kstep = (size_t)(BK * 2);
    const size_t hstep = (size_t)HALF * K * 2;
    const size_t tstep = 2 * hstep;
    const unsigned ldsw = (unsigned)wid * 1024u;
    const int aoff = lds_byte(wr * 64 + fr, fq * 8), boff = lds_byte(wc * 32 + fr, fq * 8);
#define PG8_SA(b, h) (((b) * 2 + (h)) * HTB)
#define PG8_SB(b, h) ((4 + (b) * 2 + (h)) * HTB)
#define PG8_STAGE(bufoff, gbase, voff) do { _Pragma("unroll") for (int _i = 0; _i < 2; ++_i) \
        __builtin_amdgcn_global_load_lds((const unsigned*)((const char*)(gbase) + (voff)[_i]), (PG8_LAS unsigned*)(lds + (bufoff) + ldsw + _i * 8192), 16, 0, 0); } while (0)
#define PG8_STA(bufoff, ptr, h, nx) do { if constexpr (GATHER) { _Pragma("unroll") for (int _i = 0; _i < 2; ++_i) { const unsigned _vo = cvA[h][_i]; \
        __builtin_amdgcn_global_load_lds((const unsigned*)((const char*)(ptr) + _vo), (PG8_LAS unsigned*)(lds + (bufoff) + ldsw + _i * 8192), 16, 0, 0); } } \
    else { PG8_STAGE(bufoff, (ptr) + (h) * hstep, voffA); } } while (0)
#define PG8_LDA(dst, b, h) do { _Pragma("unroll") for (int m = 0; m < 4; ++m) _Pragma("unroll") for (int k = 0; k < 2; ++k) dst[m][k] = *(const PG8_LAS bf16x8*)(lds + PG8_SA(b, h) + aoff + m * 2048 + k * 1024); } while (0)
#define PG8_LDB(dst, b, h) do { _Pragma("unroll") for (int n = 0; n < 2; ++n) _Pragma("unroll") for (int k = 0; k < 2; ++k) dst[n][k] = *(const PG8_LAS bf16x8*)(lds + PG8_SB(b, h) + boff + n * 2048 + k * 1024); } while (0)
#define PG8_MMA(ai, bj, At, Bt) do { __builtin_amdgcn_s_setprio(1); _Pragma("unroll") for (int m = 0; m < 4; ++m) _Pragma("unroll") for (int n = 0; n < 2; ++n) _Pragma("unroll") for (int k = 0; k < 2; ++k) \
        acc[ai][bj][m][n] = __builtin_amdgcn_mfma_f32_16x16x32_bf16(Bt[n][k], At[m][k], acc[ai][bj][m][n], 0, 0, 0); __builtin_amdgcn_s_setprio(0); } while (0)
#define PG8_WAIT_V(n) asm volatile("s_waitcnt vmcnt(" #n ")" ::: "memory")
#define PG8_WAIT_L(n) asm volatile("s_waitcnt lgkmcnt(" #n ")" ::: "memory")
#define PG8_BAR __builtin_amdgcn_s_barrier()
#define PG8_SCHED __builtin_amdgcn_sched_barrier(0)
    Unit cur, nxt; int ui = 0;
    if (!S.next(0, cur)) return;
    f32x4 acc[2][2][4][2];
#pragma unroll
    for (int a = 0; a < 2; ++a)
#pragma unroll
        for (int b = 0; b < 2; ++b)
#pragma unroll
            for (int m = 0; m < 4; ++m)
#pragma unroll
                for (int n = 0; n < 2; ++n) acc[a][b][m][n] = (f32x4){0.f, 0.f, 0.f, 0.f};
    bf16x8 At[4][2], B0[2][2], B1[2][2];
    const char* cA = (const char*)g.A + (GATHER ? (size_t)0 : (size_t)cur.pm * tstep); const char* cB = (const char*)g.Bt + (size_t)cur.pb * tstep;
    if constexpr (GATHER) { PG8_GOFF(cvA, cur); }
    S.a_ready(cur);
    if constexpr (SP2) {
        PG8_STAGE(PG8_SB(0, 0), cB, voffB); PG8_STAGE(PG8_SB(0, 1), cB + hstep, voffB); PG8_STA(PG8_SA(0, 0), cA, 0, false); PG8_STA(PG8_SA(0, 1), cA, 1, false);
        if (wr == 1) PG8_BAR;
        PG8_WAIT_V(2); PG8_BAR;
        PG8_STAGE(PG8_SB(1, 0), cB + kstep, voffB); PG8_STA(PG8_SA(1, 0), cA + kstep, 0, false); PG8_STAGE(PG8_SB(1, 1), cB + hstep + kstep, voffB);
        PG8_WAIT_V(6); PG8_BAR;
    }
    for (;;) {
        const bool has_next = S.next(ui + 1, nxt);
        const char* nA = (has_next && !GATHER) ? (const char*)g.A + (size_t)nxt.pm * tstep : cA; const char* nB = has_next ? (const char*)g.Bt + (size_t)nxt.pb * tstep : cB;
        for (int t = 0; t < nt; t += 2) {
            const bool last = (t == nt - 2);
            const char* a1 = cA + (size_t)(t + 1) * kstep;
            const char* a2 = last ? nA : cA + (size_t)(t + 2) * kstep; const char* b2 = last ? nB : cB + (size_t)(t + 2) * kstep;
            const char* a3 = a2 + kstep; const char* b3 = b2 + kstep;
            if (last && has_next) S.a_ready(nxt);
            if constexpr (SP2) {
            PG8_LDB(B0, 0, 0); PG8_LDB(B1, 0, 1); PG8_SCHED; PG8_LDA(At, 0, 0); PG8_STA(PG8_SA(1, 1), a1, 1, false);
            if constexpr (GATHER) { if (last && has_next) { PG8_GOFF(cvA, nxt); } }
            PG8_WAIT_V(8); PG8_WAIT_L(0); PG8_BAR; PG8_MMA(0, 0, At, B0); PG8_MMA(0, 1, At, B1); PG8_BAR; PG8_SCHED;
            PG8_LDA(At, 0, 1); PG8_STAGE(PG8_SB(0, 0), b2, voffB); PG8_STAGE(PG8_SB(0, 1), b2 + hstep, voffB); PG8_STA(PG8_SA(0, 0), a2, 0, last);
            PG8_WAIT_V(8); PG8_WAIT_L(0); PG8_BAR; PG8_MMA(1, 0, At, B0); PG8_MMA(1, 1, At, B1); PG8_BAR; PG8_SCHED;
            PG8_LDB(B0, 1, 0); PG8_LDB(B1, 1, 1); PG8_SCHED; PG8_LDA(At, 1, 0); PG8_STA(PG8_SA(0, 1), a2, 1, last);
            PG8_WAIT_V(8); PG8_WAIT_L(0); PG8_BAR; PG8_MMA(0, 0, At, B0); PG8_MMA(0, 1, At, B1); PG8_BAR; PG8_SCHED;
            PG8_LDA(At, 1, 1); PG8_STAGE(PG8_SB(1, 0), b3, voffB); PG8_STAGE(PG8_SB(1, 1), b3 + hstep, voffB); PG8_STA(PG8_SA(1, 0), a3, 0, last);
            PG8_WAIT_V(8); PG8_WAIT_L(0); PG8_BAR; PG8_MMA(1, 0, At, B0); PG8_MMA(1, 1, At, B1); PG8_BAR; PG8_SCHED;
            }
        }
        if constexpr (ALIGN_EPI) { if (wr == 0) PG8_BAR; }
        if constexpr (!Epi::AFTER_DRAIN) { const int t2_ = tid_opaque(wave_s) & 63; E(acc, cur, wr, wc, t2_ & 15, t2_ >> 4); S.done(cur); }
        if (!has_next) break;
#pragma unroll
        for (int a = 0; a < 2; ++a)
#pragma unroll
            for (int b = 0; b < 2; ++b)
#pragma unroll
                for (int m = 0; m < 4; ++m)
#pragma unroll
                    for (int n = 0; n < 2; ++n) acc[a][b][m][n] = (f32x4){0.f, 0.f, 0.f, 0.f};
        cur = nxt; cA = nA; cB = nB; ++ui;
        if constexpr (ALIGN_EPI) { if (wr == 1) PG8_BAR; }
    }
    PG8_WAIT_V(0);
    if constexpr (!ALIGN_EPI) { if (wr == 0) PG8_BAR; }
    PG8_BAR;
    if constexpr (Epi::AFTER_DRAIN) { E.fused(acc, cur, wr, wc, fr, fq, lds, wid, lane); S.done(cur); }
#undef PG8_SA
#undef PG8_SB
#undef PG8_STAGE
#undef PG8_STA
#undef PG8_GOFF
#undef PG8_LDA
#undef PG8_LDB
#undef PG8_MMA
#undef PG8_WAIT_V
#undef PG8_WAIT_L
#undef PG8_BAR
#undef PG8_SCHED
}
}

#define GAS __attribute__((address_space(1)))
#define LAS __attribute__((address_space(3)))
typedef unsigned v4u __attribute__((ext_vector_type(4)));
typedef GAS unsigned gu32;
typedef GAS unsigned long long gu64;
#define RLX_AGENT __ATOMIC_RELAXED, __HIP_MEMORY_SCOPE_AGENT
#define LDS_WAIT() asm volatile("s_waitcnt lgkmcnt(0)" ::: "memory")
#define VM_WAIT() asm volatile("s_waitcnt vmcnt(0)" ::: "memory")
__device__ __forceinline__ unsigned long long rt() { return __builtin_amdgcn_s_memrealtime(); }

#define XB_TMO      128
#define XB_XCNT(j)  (256  + 64 * (j))
#define XB_XSUB(j)  (1280 + 64 * (j))
#define XB_XGEN(j)  (2304 + 64 * (j))
#define XB_TOP      3328
#define XB_TOPGEN   3392
#define XCD_BAR_WORDS 3456
#define XB_SPIN_CAP (1u << 18)

__device__ __forceinline__ unsigned xb_ld(unsigned* p)              { return __hip_atomic_load(p, __ATOMIC_RELAXED, __HIP_MEMORY_SCOPE_AGENT); }
__device__ __forceinline__ unsigned xb_add(unsigned* p, unsigned v) { return __hip_atomic_fetch_add(p, v, __ATOMIC_RELAXED, __HIP_MEMORY_SCOPE_AGENT); }
__device__ __forceinline__ unsigned xb_xcc_id() { return (unsigned)__builtin_amdgcn_s_getreg((3 << 11) | 20) & 0xFu; }
#define XB_SPIN(cond, bar) do { unsigned _sp = 0; while (cond) { __builtin_amdgcn_s_sleep(1); \
    if ((++_sp & 255u) == 0u) { if (xb_ld(&(bar)[XB_TMO])) break; if (_sp > XB_SPIN_CAP) { atomicAdd(&(bar)[XB_TMO], 1u); break; } } } } while (0)

struct XcdBarrier {
    unsigned* bar; unsigned x;
    volatile LAS unsigned* st;
};

__device__ __forceinline__ XcdBarrier xcd_barrier_post(unsigned* bar, volatile LAS unsigned* st) {
    XcdBarrier b; b.bar = bar; b.x = xb_xcc_id(); b.st = st;
    if (threadIdx.x == 0) (void)xb_add(&bar[XB_XCNT(b.x)], 1u);
    return b;
}
__device__ __forceinline__ void xcd_barrier_complete(unsigned* bar, unsigned x, unsigned& nloc, unsigned& nx) {
    const unsigned G = gridDim.x * gridDim.y * gridDim.z;
    unsigned sum, cnt, mine, sp = 0u;
    for (;;) {
        sum = 0u; cnt = 0u; mine = 0u;
#pragma unroll
        for (unsigned j = 0; j < 16; ++j) { const unsigned c = xb_ld(&bar[XB_XCNT(j)]); sum += c; cnt += (c > 0u) ? 1u : 0u; mine = (j == x) ? c : mine; }
        if (sum == G) break;
        __builtin_amdgcn_s_sleep(1);
        if ((++sp & 255u) == 0u) { if (xb_ld(&bar[XB_TMO])) break; if (sp > XB_SPIN_CAP) { atomicAdd(&bar[XB_TMO], 1u); break; } }
    }
    nloc = mine > 0u ? mine : 1u; nx = cnt > 0u ? cnt : 1u;
}

__device__ __forceinline__ void xcd_barrier(const XcdBarrier& b, const int wave_s) {
    asm volatile("s_waitcnt vmcnt(0)" ::: "memory");
    __syncthreads();
    if (tid_opaque(wave_s) == 0) {
        unsigned* bar = b.bar;
        __builtin_amdgcn_s_waitcnt(0);
        unsigned nloc = b.st[0], nx = b.st[1];
        if (nloc == 0u) { xcd_barrier_complete(bar, b.x, nloc, nx); b.st[0] = nloc; b.st[1] = nx; }
        const unsigned old = xb_add(&bar[XB_XSUB(b.x)], 1u);
        const unsigned gen = old / nloc;
        if (old + 1u == (gen + 1u) * nloc) {
            __builtin_amdgcn_fence(__ATOMIC_RELEASE, "agent");
            asm volatile("s_waitcnt vmcnt(0)" ::: "memory");
            const unsigned og = xb_add(&bar[XB_TOP], 1u);
            const unsigned tg = og / nx;
            if (og + 1u == (tg + 1u) * nx) xb_add(&bar[XB_TOPGEN], 1u);
            else XB_SPIN(xb_ld(&bar[XB_TOPGEN]) == tg, bar);
            __builtin_amdgcn_fence(__ATOMIC_ACQUIRE, "agent");
            xb_add(&bar[XB_XGEN(b.x)], 1u);
            asm volatile("s_waitcnt vmcnt(0)" ::: "memory");
        } else {
            XB_SPIN(xb_ld(&bar[XB_XGEN(b.x)]) == gen, bar);
            __builtin_amdgcn_fence(__ATOMIC_ACQUIRE, "agent");
            asm volatile("s_waitcnt vmcnt(0)" ::: "memory");
        }
    }
    __syncthreads();
}

using pg8::Unit;
struct EpiP1 {
    static constexpr bool PERM = true, AFTER_DRAIN = false;
    const float* rs1; const float* lb; float* LF;
    bf16_t *QH, *VH, *GH, *RQ, *RK, *RV, *RG, *GA, *GB;
    template <int ACT> __device__ __forceinline__ void unary(const f32x4 (&acc)[2][2][4][2], int row0, int wc, int fq, bf16_t* dst, int ld, int colbase) const {
#pragma unroll
        for (int ai = 0; ai < 2; ++ai)
#pragma unroll
            for (int m = 0; m < 4; ++m) { const int row = row0 + ai * 128 + m * 16; const float rs = rs1[row]; bf16_t* rowp = dst + (size_t)row * ld + colbase + wc * 32 + 8 * fq;
#pragma unroll
                for (int bj = 0; bj < 2; ++bj) { f32x4 v0 = acc[ai][bj][m][0] * rs, v1 = acc[ai][bj][m][1] * rs;
                    if (ACT == 1) { for (int j = 0; j < 4; ++j) { v0[j] = siluf(v0[j]); v1[j] = siluf(v1[j]); } }
                    if (ACT == 2) { for (int j = 0; j < 4; ++j) { v0[j] = sigmf(v0[j]); v1[j] = sigmf(v1[j]); } }
                    pg8::u32x4 w; w.x = pk2(v0[0], v0[1]); w.y = pk2(v0[2], v0[3]); w.z = pk2(v1[0], v1[1]); w.w = pk2(v1[2], v1[3]);
                    *(pg8::u32x4*)(rowp + bj * 128) = w; }
                asm volatile("" ::: "memory"); }
    }
    __device__ __forceinline__ void operator()(const f32x4 (&acc)[2][2][4][2], const Unit& u, int wr, int wc, int fr, int fq) const {
        const int row0 = u.pm * 256 + wr * 64 + fr; const int c0 = u.pn * 256; const int sec = c0 >> 9;
        if (sec == 0) unary<1>(acc, row0, wc, fq, QH, 512, c0);
        else if (sec == 2) unary<0>(acc, row0, wc, fq, VH, 512, c0 - 1024);
        else if (sec == 3) unary<1>(acc, row0, wc, fq, GH, 512, c0 - 1536);
        else if (sec == 6 || sec == 7) unary<0>(acc, row0, wc, fq, RV, 1024, c0 - 3072);
        else if (sec == 8 || sec == 9) unary<1>(acc, row0, wc, fq, RG, 1024, c0 - 4096);
        else if (sec == 10 || sec == 11) unary<2>(acc, row0, wc, fq, GA, 1024, c0 - 5120);
        else if (sec == 12 || sec == 13) unary<2>(acc, row0, wc, fq, GB, 1024, c0 - 6144);
        else if (sec == 1) { const int cb = c0 - 512 + wc * 32 + 8 * fq;
#pragma unroll
            for (int ai = 0; ai < 2; ++ai)
#pragma unroll
                for (int m = 0; m < 4; ++m) { const int row = row0 + ai * 128 + m * 16; const float rs = rs1[row]; float* rowp = LF + (size_t)row * 512 + cb;
#pragma unroll
                    for (int bj = 0; bj < 2; ++bj)
#pragma unroll
                        for (int n = 0; n < 2; ++n) { const f32x4 l4 = *(const f32x4*)(lb + cb + bj * 128 + 4 * n); const f32x4 v = acc[ai][bj][m][n] * rs; f32x4 o;
                            for (int j = 0; j < 4; ++j) { const float e = (1.f - l4[j]) * __builtin_amdgcn_rcpf(1.f + __builtin_amdgcn_exp2f(1.4426950408889634f * v[j])); o[j] = __logf(1.f - e); }
                            *(f32x4*)(rowp + bj * 128 + 4 * n) = o; }
                    asm volatile("" ::: "memory"); } }
        else { const bool isk = sec == 5; bf16_t* dst = isk ? RK : RQ; const int cbase = c0 - (isk ? 2560 : 2048);
            float invrev[4];
#pragma unroll
            for (int q = 0; q < 4; ++q) invrev[q] = exp2f(-(float)(wc * 16 + 4 * fq + q) * (13.287712379549449f / 64.f)) * 0.15915494309189535f;
            const int hd0 = cbase >> 7; const float lg0 = gamma_lg(hd0), lg1 = gamma_lg(hd0 + 1);
#pragma unroll
            for (int ai = 0; ai < 2; ++ai)
#pragma unroll
                for (int m = 0; m < 4; ++m) { const int row = row0 + ai * 128 + m * 16; const float rs = rs1[row]; const int t = row & (SEQ - 1), tm = t & 127;
                    bf16_t* rowp = dst + (size_t)row * 512 + cbase + wc * 32 + 8 * fq; float sn[4], cs[4];
#pragma unroll
                    for (int q = 0; q < 4; ++q) { float r = (float)t * invrev[q]; r = r - floorf(r); sn[q] = __builtin_amdgcn_sinf(r); cs[q] = __builtin_amdgcn_cosf(r); }
#pragma unroll
                    for (int bj = 0; bj < 2; ++bj) { const float lg = bj ? lg1 : lg0; const float sc = rs * (isk ? __expf(-(float)tm * lg) : 0.08838834764831845f * __expf((float)tm * lg));
                        const f32x4 v0 = acc[ai][bj][m][0], v1 = acc[ai][bj][m][1]; float o[8];
                        o[0] = (v0[0] * cs[0] - v0[1] * sn[0]) * sc; o[1] = (v0[0] * sn[0] + v0[1] * cs[0]) * sc; o[2] = (v0[2] * cs[1] - v0[3] * sn[1]) * sc; o[3] = (v0[2] * sn[1] + v0[3] * cs[1]) * sc;
                        o[4] = (v1[0] * cs[2] - v1[1] * sn[2]) * sc; o[5] = (v1[0] * sn[2] + v1[1] * cs[2]) * sc; o[6] = (v1[2] * cs[3] - v1[3] * sn[3]) * sc; o[7] = (v1[2] * sn[3] + v1[3] * cs[3]) * sc;
                        pg8::u32x4 w; w.x = pk2(o[0], o[1]); w.y = pk2(o[2], o[3]); w.z = pk2(o[4], o[5]); w.w = pk2(o[6], o[7]);
                        *(pg8::u32x4*)(rowp + bj * 128) = w; }
                    asm volatile("" ::: "memory"); } }
    }
};
struct EpiGateMul {
    const bf16_t* G; bf16_t* T;
    __device__ __forceinline__ void operator()(const Unit&, int m, int c, f32x4 v) const { const f32x4 g = ld4bf(G + (size_t)m * 1024 + c); st4bf(T + (size_t)m * 1024 + c, g * v); }
};
struct EpiGateMulAdd {
    const bf16_t* G; bf16_t* T;
    __device__ __forceinline__ void operator()(const Unit&, int m, int c, f32x4 v) const { const f32x4 g = ld4bf(G + (size_t)m * 1024 + c); const f32x4 t = ld4bf(T + (size_t)m * 1024 + c); st4bf(T + (size_t)m * 1024 + c, t + g * v); }
};
struct EpiResid {
    const float* x; float* out; bf16_t* H2;
    __device__ __forceinline__ void operator()(const Unit&, int m, int c, f32x4 v) const { const f32x4 r = *(const f32x4*)(x + (size_t)m * 1024 + c) + v; *(f32x4*)(out + (size_t)m * 1024 + c) = r; st4bf(H2 + (size_t)m * 1024 + c, r); }
};
struct EpiStoreBf {
    bf16_t* T;
    __device__ __forceinline__ void operator()(const Unit&, int m, int c, f32x4 v) const { st4bf(T + (size_t)m * 1024 + c, v); }
};
struct EpiPle {
    const bf16_t* PP; float* x;
    __device__ __forceinline__ void operator()(const Unit&, int m, int c, f32x4 v) const { const f32x4 pp = ld4bf(PP + (size_t)m * 1024 + c); f32x4 r = *(const f32x4*)(x + (size_t)m * 1024 + c);
        for (int j = 0; j < 4; ++j) r[j] += sigmf(v[j]) * pp[j]; *(f32x4*)(x + (size_t)m * 1024 + c) = r; }
};
struct EpiGateUp {
    const PG8_LAS int* rowinfo; bf16_t* HM;
    __device__ __forceinline__ void pair(const Unit& u, int pos, int c, f32x4 g, f32x4 up) const { const float rs = ((const PG8_LAS float*)rowinfo)[u.ui * 512 + 256 + (pos & 255)];
        f32x4 o; for (int j = 0; j < 4; ++j) o[j] = siluf(g[j] * rs) * (up[j] * rs); st4bf(HM + (size_t)pos * 256 + c, o); }
};
struct EpiDown {
    const PG8_LAS int* rowinfo; bf16_t* YS;
    __device__ __forceinline__ void operator()(const Unit& u, int pos, int c, f32x4 v) const { const int r = pos & 255; const int a = rowinfo[u.ui * 512 + r]; if (a < 0) return;
        const float w = ((const PG8_LAS float*)rowinfo)[u.ui * 512 + 256 + r]; st4bf(YS + (size_t)a * 1024 + c, v * w); }
};

constexpr int NWAVES = 8;
constexpr int RING_BYTES = 131072, EXTRA_OFF = 131072, LDSCTL_OFF = EXTRA_OFF, MISC_OFF = EXTRA_OFF + 320, OFFS_OFF = EXTRA_OFF + 512, TILEE_OFF = EXTRA_OFF + 1024, ROWINFO_OFF = EXTRA_OFF + 2048;
constexpr int LDS_BYTES = ROWINFO_OFF + 8 * 2048;
constexpr int CW_BAR = 4096;
#ifndef MK_PER_PHASE
#define MK_PER_PHASE 0
#endif
constexpr int N_PHASES = 13;
#ifndef MK_NAIVE_MIX
#define MK_NAIVE_MIX 0
#endif

struct Args { const float* in[22]; float* out; unsigned char* ws; int ph_lo, ph_hi; };

struct Ctx {
    LAS unsigned char* lds; int vcu, G, wave_s;
    const float* const* in; float* out; unsigned char* ws;
};
#define CIN(i) (C.in[i])
#define WSP(T, off) ((T*)(C.ws + (off)))

template <int MODE>
__device__ __forceinline__ void transpose_item(const float* W, int K, int N, bf16_t* WT, int row_off, LAS float* scr, int item, int lane, const float* gain) {
    const int nblk = N / 32, kb = item / nblk, nb = item % nblk, k0 = 64 * kb, n0 = 32 * nb;
    int nsrc = n0 + (lane & 31);
    if (MODE == 1) { if (nsrc >= 2048 && nsrc < 3072) { const int base = nsrc & ~127, w = nsrc & 127; nsrc = base + (w >> 1) + 64 * (w & 1); } }
    float wv[32];
#pragma unroll
    for (int i = 0; i < 32; ++i) { const int kk = 2 * i + (lane >> 5); wv[i] = W[(size_t)(k0 + kk) * N + nsrc]; }
    const float g0 = gain ? gain[k0 + (lane & 63)] : 1.f;
#pragma unroll
    for (int i = 0; i < 32; ++i) { const int kk = 2 * i + (lane >> 5); scr[kk * 33 + (lane & 31)] = wv[i] * __shfl(g0, kk); }
    LDS_WAIT(); asm volatile("" ::: "memory");
    const int c = lane & 7;
#pragma unroll
    for (int j = 0; j < 4; ++j) { const int n = (lane >> 3) + 8 * j; const LAS float* s = scr + (8 * c) * 33 + n;
        v4u o; o.x = pk2(s[0 * 33], s[1 * 33]); o.y = pk2(s[2 * 33], s[3 * 33]); o.z = pk2(s[4 * 33], s[5 * 33]); o.w = pk2(s[6 * 33], s[7 * 33]);
        int drow = row_off + n0 + n; if (MODE == 2) { const int nc = n0 + n; drow = row_off + 256 * (nc >> 7) + (nc & 127); }
        *(GAS v4u*)(WT + (size_t)drow * K + k0 + 8 * c) = o; }
    LDS_WAIT(); asm volatile("" ::: "memory");
}
__device__ __forceinline__ void p0_prologue(const Ctx& C) {
    const int T_tid = tid_opaque(C.wave_s), T_lane = T_tid & 63, T_wave = C.wave_s; (void)T_lane; (void)T_wave;
    LAS float* scr = (LAS float*)(C.lds + T_wave * 16384);
    const int gw = C.vcu * NWAVES + T_wave, NGW = C.G * NWAVES;
    constexpr int I_IN = 16 * (NIN / 32), I_A = 8 * 32, I_SQ = 16 * 32, I_PP = 4 * 32;
    constexpr int NIT = I_IN + I_A + 3 * I_SQ + I_PP;
    for (int it = gw; it < NIT; it += NGW) { int r = it;
        if (r < I_IN) { transpose_item<1>(CIN(3), 1024, NIN, WSP(bf16_t, WS_WIN), 0, scr, r, T_lane, CIN(2)); continue; } r -= I_IN;
        if (r < I_A) { transpose_item<0>(CIN(7), 512, 1024, WSP(bf16_t, WS_WA), 0, scr, r, T_lane, nullptr); continue; } r -= I_A;
        if (r < I_SQ) { transpose_item<0>(CIN(8), 1024, 1024, WSP(bf16_t, WS_WB), 0, scr, r, T_lane, nullptr); continue; } r -= I_SQ;
        if (r < I_SQ) { transpose_item<0>(CIN(9), 1024, 1024, WSP(bf16_t, WS_WO), 0, scr, r, T_lane, nullptr); continue; } r -= I_SQ;
        if (r < I_SQ) { transpose_item<0>(CIN(19), 1024, 1024, WSP(bf16_t, WS_WPG), 0, scr, r, T_lane, CIN(18)); continue; } r -= I_SQ;
        transpose_item<0>(CIN(20), 256, 1024, WSP(bf16_t, WS_WPP), 0, scr, r, T_lane, nullptr);
    }
    { bf16_t* XB = (bf16_t*)C.out; float* rs1 = (float*)(C.ws + WS_SMALL + SM_RS1); const float* x = CIN(0);
      for (int m = gw; m < M; m += NGW) { const f32x4* xr = (const f32x4*)(x + (size_t)m * D) + T_lane; f32x4 v[4]; float s = 0.f;
#pragma unroll
        for (int j = 0; j < 4; ++j) { v[j] = xr[64 * j]; s += (v[j][0] * v[j][0] + v[j][1] * v[j][1]) + (v[j][2] * v[j][2] + v[j][3] * v[j][3]); }
        s = wave_sum(s); if (T_lane == 0) rs1[m] = rsqrtf(s * (1.f / D) + EPS);
#pragma unroll
        for (int j = 0; j < 4; ++j) st4bf(XB + (size_t)m * D + T_lane * 4 + 256 * j, v[j]); } }
    { const f32x4* p4 = (const f32x4*)CIN(1); bf16_t* PB = WSP(bf16_t, WS_PB); const int gt = C.vcu * 512 + T_tid, NT = C.G * 512;
      for (int i = gt; i < M * PLE / 4; i += NT) st4bf(PB + (size_t)i * 4, p4[i]); }
    if (C.vcu == 1) { float* WR = WSP(float, WS_WR); const float* g2 = CIN(10); const float* wrg = CIN(11); const float* wre = CIN(13);
        for (int i = T_tid; i < 1024 * 48; i += 512) { const int k = i / 48, c = i - k * 48; WR[i] = c < 4 ? g2[k] * wrg[k * 4 + c] : (c < 36 ? g2[k] * wre[k * 32 + (c - 4)] : 0.f); } }
    if (C.vcu == 0) { float* lb = (float*)(C.ws + WS_SMALL + SM_LB); const float* l = CIN(4); const float l0 = l[T_tid], l1 = l[512 + T_tid]; lb[T_tid] = 1.f / (1.f + __expf(l1 - l0)); }
}
__device__ __forceinline__ void p2_naive_hgrn(const Ctx& C, int bh) {
    const int T_tid = tid_opaque(C.wave_s), T_lane = T_tid & 63, T_wave = C.wave_s; (void)T_lane; (void)T_wave;
    const bf16_t* QH = WSP(bf16_t, WS_QH); const bf16_t* VH = WSP(bf16_t, WS_VH); bf16_t* GH = WSP(bf16_t, WS_GH); const float* LF = (const float*)((unsigned char*)C.out + 32 * MiB); const float* hg_norm = CIN(5);
    LAS float* sh = (LAS float*)C.lds; const int b = bh >> 2, h = bh & 3, v = T_tid & 127; const bool act = T_tid < 128;
    float S[128];
#pragma unroll
    for (int k = 0; k < 128; ++k) S[k] = 0.f;
    const float gn = hg_norm[v];
    for (int t = 0; t < SEQ; ++t) { const size_t o512 = (size_t)(b * SEQ + t) * 512 + h * 128 + v; float vv = 0.f;
        if (act) { const float lf = LF[o512]; sh[v] = bf2f(QH[o512]); sh[128 + v] = __expf(lf); sh[256 + v] = -expm1f(lf); vv = bf2f(VH[o512]); }
        __syncthreads();
        float o = 0.f;
        if (act) {
#pragma unroll
            for (int k = 0; k < 128; ++k) { S[k] = sh[128 + k] * S[k] + sh[256 + k] * vv; o += sh[k] * S[k]; if ((k & 15) == 15) asm volatile("" ::: "memory"); } }
        const float ss = wave_sum(o * o); if (act && (v & 63) == 0) sh[384 + (v >> 6)] = ss;
        __syncthreads();
        if (act) { const float tot = sh[384] + sh[385]; const float y = o * rsqrtf(tot * (1.f / 128.f) + EPS) * gn * bf2f(GH[o512]); GH[o512] = (bf16_t)f2bf(y); }
    }
}
__device__ __forceinline__ void p2_naive_ret(const Ctx& C, int bh) {
    const int T_tid = tid_opaque(C.wave_s), T_lane = T_tid & 63, T_wave = C.wave_s; (void)T_lane; (void)T_wave;
    const bf16_t* RQ = WSP(bf16_t, WS_RQ); const bf16_t* RK = WSP(bf16_t, WS_RK); const bf16_t* RV = WSP(bf16_t, WS_RV); bf16_t* RG = WSP(bf16_t, WS_RG); const float* ret_norm = CIN(6);
    LAS float* sh = (LAS float*)C.lds; const int b = bh >> 2, h = bh & 3, v = T_tid & 255; const bool act = T_tid < 256;
    float S[128];
#pragma unroll
    for (int k = 0; k < 128; ++k) S[k] = 0.f;
    const float gn = ret_norm[v]; const float lg = gamma_lg(h), gam = __expf(lg);
    for (int t = 0; t < SEQ; ++t) { const size_t m = (size_t)(b * SEQ + t); const int tm = t & 127; float vv = 0.f;
        if (T_tid < 128) { sh[v] = bf2f(RQ[m * 512 + h * 128 + v]) * __expf(-(float)tm * lg); sh[128 + v] = bf2f(RK[m * 512 + h * 128 + v]) * __expf((float)tm * lg); }
        if (act) vv = bf2f(RV[m * 1024 + h * 256 + v]);
        __syncthreads();
        float o = 0.f;
        if (act) {
#pragma unroll
            for (int k = 0; k < 128; ++k) { S[k] = gam * S[k] + sh[128 + k] * vv; o += sh[k] * S[k]; if ((k & 15) == 15) asm volatile("" ::: "memory"); } }
        const float ss = wave_sum(o * o); if (act && (v & 63) == 0) sh[384 + (v >> 6)] = ss;
        __syncthreads();
        if (act) { const float tot = (sh[384] + sh[385]) + (sh[386] + sh[387]); const size_t oi = m * 1024 + h * 256 + v;
            const float y = o * rsqrtf(tot * (1.f / 256.f) + EPS) * gn * bf2f(RG[oi]); RG[oi] = (bf16_t)f2bf(y); }
    }
}
__device__ __forceinline__ void p6_router(const Ctx& C, gu32* ctl) {
    const int T_tid = tid_opaque(C.wave_s), T_lane = T_tid & 63, T_wave = C.wave_s; (void)T_lane; (void)T_wave;
    const int gw = C.vcu * NWAVES + T_wave, NGW = C.G * NWAVES;
    { LAS float* scr = (LAS float*)(C.lds + T_wave * 16384);
      constexpr int I_G = 16 * 8, I_D = 4 * 32, PER_E = 2 * I_G + I_D;
      for (int it = gw; it < NE * PER_E; it += NGW) { const int e = it / PER_E; int r = it - e * PER_E;
          if (r < I_G) { transpose_item<2>(CIN(15) + (size_t)e * 1024 * 256, 1024, 256, WSP(bf16_t, WS_WGU), e * 512, scr, r, T_lane, CIN(10)); continue; } r -= I_G;
          if (r < I_G) { transpose_item<2>(CIN(16) + (size_t)e * 1024 * 256, 1024, 256, WSP(bf16_t, WS_WGU), e * 512 + 128, scr, r, T_lane, CIN(10)); continue; } r -= I_G;
          transpose_item<0>(CIN(17) + (size_t)e * 256 * 1024, 256, 1024, WSP(bf16_t, WS_WD), e * 1024, scr, r, T_lane, nullptr); } }
    const float* X1 = C.out; const float* WR = WSP(float, WS_WR); const float* brg = CIN(12); const float* bre = CIN(14);
    float* rs2 = (float*)(C.ws + WS_SMALL + SM_RS2); float* wgt = (float*)(C.ws + WS_SMALL + SM_WGT); int* list = WSP(int, WS_LIST); gu32* cnt = ctl + CW_CNT;
    const int fr = T_lane & 15, fq = T_lane >> 4, tile = T_wave & 3, kh = T_wave >> 2;
    LAS float* xacc = (LAS float*)(C.lds);
    LAS float* xss = (LAS float*)(C.lds + 12288);
    LAS float* lgt = (LAS float*)(C.lds + 12288 + 256);
    __syncthreads();
    for (int tb = C.vcu; tb < M / 64; tb += C.G) {
        const int m = tb * 64 + tile * 16 + fr;
        const float* xr = X1 + (size_t)m * D + kh * 512 + 4 * fq; const float* wr = WR + (size_t)(kh * 512 + 4 * fq) * 48 + fr;
        f32x4 acc[3]; acc[0] = acc[1] = acc[2] = (f32x4){0.f, 0.f, 0.f, 0.f}; float ss = 0.f;
#pragma unroll 2
        for (int j = 0; j < 32; ++j) { const f32x4 x4 = *(const f32x4*)(xr + 16 * j); ss += (x4[0] * x4[0] + x4[1] * x4[1]) + (x4[2] * x4[2] + x4[3] * x4[3]);
#pragma unroll
            for (int i = 0; i < 4; ++i) { const float* wrow = wr + (size_t)(16 * j + i) * 48;
#pragma unroll
                for (int nt = 0; nt < 3; ++nt) acc[nt] = __builtin_amdgcn_mfma_f32_16x16x4f32(x4[i], wrow[16 * nt], acc[nt], 0, 0, 0); } }
        ss += __shfl_xor(ss, 16); ss += __shfl_xor(ss, 32);
        if (kh == 1) {
#pragma unroll
            for (int nt = 0; nt < 3; ++nt) *(LAS f32x4*)(xacc + ((tile * 3 + nt) * 64 + T_lane) * 4) = acc[nt];
            if (fq == 0) xss[tile * 16 + fr] = ss; }
        __syncthreads();
        if (kh == 0) {
#pragma unroll
            for (int nt = 0; nt < 3; ++nt) { acc[nt] = acc[nt] + *(const LAS f32x4*)(xacc + ((tile * 3 + nt) * 64 + T_lane) * 4);
#pragma unroll
                for (int r = 0; r < 4; ++r) lgt[(tile * 16 + 4 * fq + r) * 48 + 16 * nt + fr] = acc[nt][r]; }
            ss += xss[tile * 16 + fr];
            asm volatile("s_waitcnt lgkmcnt(0)" ::: "memory");
            if (T_lane < 16) { const int mt = tb * 64 + tile * 16 + T_lane; const float rs = rsqrtf(ss * (1.f / D) + EPS); rs2[mt] = rs;
                float lg[36];
#pragma unroll
                for (int c4 = 0; c4 < 9; ++c4) { const f32x4 q4 = *(const LAS f32x4*)(lgt + (tile * 16 + T_lane) * 48 + 4 * c4); lg[4 * c4] = q4[0] * rs; lg[4 * c4 + 1] = q4[1] * rs; lg[4 * c4 + 2] = q4[2] * rs; lg[4 * c4 + 3] = q4[3] * rs; }
                float gl[4];
#pragma unroll
                for (int c = 0; c < 4; ++c) gl[c] = lg[c] + brg[c];
                float gmax = gl[0]; int gi = 0;
#pragma unroll
                for (int c = 1; c < 4; ++c) if (gl[c] > gmax) { gmax = gl[c]; gi = c; }
                float den = 0.f;
#pragma unroll
                for (int c = 0; c < 4; ++c) den += __expf(gl[c] - gmax);
                const float gw_ = 1.f / den;
                float el[8];
#pragma unroll
                for (int c = 0; c < 8; ++c) { el[c] = 0.f;
#pragma unroll
                    for (int g = 0; g < 4; ++g) if (g == gi) el[c] = lg[4 + g * 8 + c] + bre[g * 8 + c]; }
                float m1 = el[0]; int i1 = 0;
#pragma unroll
                for (int c = 1; c < 8; ++c) if (el[c] > m1) { m1 = el[c]; i1 = c; }
                float m2 = -3.0e38f; int i2 = 0;
#pragma unroll
                for (int c = 0; c < 8; ++c) if (c != i1 && el[c] > m2) { m2 = el[c]; i2 = c; }
                const float w1 = 1.f / (1.f + __expf(m2 - m1)), w2 = 1.f - w1;
                const int e1 = gi * 8 + i1, e2 = gi * 8 + i2;
                wgt[2 * mt] = w1 * gw_; wgt[2 * mt + 1] = w2 * gw_;
                const unsigned p1 = __hip_atomic_fetch_add(cnt + e1, 1u, __ATOMIC_RELAXED, __HIP_MEMORY_SCOPE_AGENT); list[e1 * LIST_CAP + (int)p1] = 2 * mt;
                const unsigned p2 = __hip_atomic_fetch_add(cnt + e2, 1u, __ATOMIC_RELAXED, __HIP_MEMORY_SCOPE_AGENT); list[e2 * LIST_CAP + (int)p2] = 2 * mt + 1; } }
        __syncthreads();
    }
}
__device__ __forceinline__ int moe_plan(const Ctx& C, gu32* ctl) {
    const int T_tid = tid_opaque(C.wave_s), T_lane = T_tid & 63, T_wave = C.wave_s; (void)T_lane; (void)T_wave;
    LAS int* offs = (LAS int*)(C.lds + OFFS_OFF); LAS int* tile_e = (LAS int*)(C.lds + TILEE_OFF);
    if (T_tid < NE) offs[33 + T_tid] = (int)__hip_atomic_load(ctl + CW_CNT + T_tid, __ATOMIC_RELAXED, __HIP_MEMORY_SCOPE_AGENT);
    __syncthreads();
    if (T_tid == 0) { int o = 0;
        for (int e = 0; e < NE; ++e) { const int c = offs[33 + e]; offs[e] = o; const int np = (c + 255) & ~255;
            for (int t = 0; t < np; t += 256) tile_e[(o + t) >> 8] = e; o += np; }
        offs[32] = o; }
    __syncthreads();
    return offs[32] >> 8;
}
template <bool WANT_RS> __device__ __forceinline__ void moe_rowinfo(const Ctx& C, const pg8::GroupOrder& S) {
    const int T_tid = tid_opaque(C.wave_s), T_lane = T_tid & 63, T_wave = C.wave_s; (void)T_lane; (void)T_wave;
    LAS int* offs = (LAS int*)(C.lds + OFFS_OFF); LAS int* tile_e = (LAS int*)(C.lds + TILEE_OFF); LAS int* ri = (LAS int*)(C.lds + ROWINFO_OFF);
    const int* list = WSP(int, WS_LIST); const float* wgt = (const float*)(C.ws + WS_SMALL + SM_WGT); const float* rs2 = (const float*)(C.ws + WS_SMALL + SM_RS2);
    pg8::Unit u;
    for (int i = 0; i < 8 && S.next(i, u); ++i) {
        if (T_tid < 256) { const int e = tile_e[u.pm], idx = u.pm * 256 + T_tid - offs[e]; int a = -1; float w = 0.f;
            if (idx < offs[33 + e]) { a = list[e * LIST_CAP + idx]; w = WANT_RS ? rs2[a >> 1] : wgt[a]; }
            ri[i * 512 + T_tid] = a; ((LAS float*)ri)[i * 512 + 256 + T_tid] = w; } }
    __syncthreads();
}
__device__ __forceinline__ void p9_combine(const Ctx& C) {
    const int T_tid = tid_opaque(C.wave_s), T_lane = T_tid & 63, T_wave = C.wave_s; (void)T_lane; (void)T_wave;
    const int gw = C.vcu * NWAVES + T_wave, NGW = C.G * NWAVES; float* X = C.out; const bf16_t* YS = WSP(bf16_t, WS_YS); bf16_t* X2B = WSP(bf16_t, WS_X2B);
    for (int m = gw; m < M; m += NGW) { const int lane = T_lane;
        f32x4* xr = (f32x4*)(X + (size_t)m * D) + lane; f32x4 v[4]; float s = 0.f;
#pragma unroll
        for (int j = 0; j < 4; ++j) { const int c = lane * 4 + 256 * j; v[j] = xr[64 * j] + ld4bf(YS + (size_t)(2 * m) * D + c) + ld4bf(YS + (size_t)(2 * m + 1) * D + c);
            s += (v[j][0] * v[j][0] + v[j][1] * v[j][1]) + (v[j][2] * v[j][2] + v[j][3] * v[j][3]); }
        s = wave_sum(s); const float rs = rsqrtf(s * (1.f / D) + EPS);
#pragma unroll
        for (int j = 0; j < 4; ++j) { xr[64 * j] = v[j]; st4bf(X2B + (size_t)m * D + lane * 4 + 256 * j, v[j] * rs); } }
}
__device__ __forceinline__ void p11_final(const Ctx& C, const float oscale) {
    const int T_tid = tid_opaque(C.wave_s), T_lane = T_tid & 63, T_wave = C.wave_s; (void)T_lane; (void)T_wave;
    const int gw = C.vcu * NWAVES + T_wave, NGW = C.G * NWAVES; float* X = C.out; const float* g = CIN(21);
    for (int m = gw; m < M; m += NGW) { const int lane = T_lane;
        f32x4* xr = (f32x4*)(X + (size_t)m * D) + lane; f32x4 v[4]; float s = 0.f;
#pragma unroll
        for (int j = 0; j < 4; ++j) { v[j] = xr[64 * j]; s += (v[j][0] * v[j][0] + v[j][1] * v[j][1]) + (v[j][2] * v[j][2] + v[j][3] * v[j][3]); }
        s = wave_sum(s); const float rs = rsqrtf(s * (1.f / D) + EPS);
#pragma unroll
        for (int j = 0; j < 4; ++j) { const f32x4 gg = *(const f32x4*)(g + lane * 4 + 256 * j); xr[64 * j] = v[j] * (rs * oscale) * gg; } }
}

__device__ __forceinline__ int rho(int p) { return (p & ~31) | (((p >> 2) & 1) << 4) | (((p >> 3) & 3) << 2) | (p & 3); }
constexpr int MX_QL = 0, MX_KL = 17408, MX_KT = 34816, MX_VT = 53248, MX_PL = 90112, MX_CH = 99328, MX_SSQ = 102912, MX_INV = 104960;
constexpr int QSTR = 272, TSTR = 144;
constexpr size_t OUT_UH = 0, OUT_UR = 8 * MiB;
constexpr size_t SM_DH = SM_RS3;
typedef pg8::bf16x8 bfx8;
#define MFMA16(a, b, c) __builtin_amdgcn_mfma_f32_16x16x32_bf16((a), (b), (c), 0, 0, 0)
#define LDS_B128(off) (*(const LAS bfx8*)(lds + (off)))

template <int NT, bool HG, bool STATE_ONLY>
__device__ __forceinline__ void mixer_unit(const Ctx& C, const int b, const int h, const int seg) {
    const int tid = tid_opaque(C.wave_s), lane = tid & 63, w = C.wave_s, fr = lane & 15, fq = lane >> 4;
    LAS unsigned char* lds = C.lds;
    constexpr int DV = NT * 128, LDV = HG ? 512 : 1024;
    const int bh = b * 4 + h, unit = bh * 16 + seg, m0 = b * SEQ + seg * 512;
    const bf16_t* Qg = WSP(bf16_t, HG ? WS_QH : WS_RQ) + h * 128; const bf16_t* Kg = WSP(bf16_t, WS_RK) + h * 128;
    const bf16_t* Vg = WSP(bf16_t, HG ? WS_VH : WS_RV) + h * DV; bf16_t* Gg = WSP(bf16_t, HG ? WS_GH : WS_RG) + h * DV;
    const float* LFg = (const float*)((unsigned char*)C.out + 32 * MiB) + h * 128;
    float* Ug = (float*)((unsigned char*)C.out + (HG ? OUT_UH : OUT_UR)) + (size_t)unit * 128 * DV;
    float* DHg = (float*)(C.ws + WS_SMALL + SM_DH) + unit * 128;
    const float* gn = HG ? CIN(5) : CIN(6);
    const float lgam = gamma_lg(h), g128 = __expf(128.f * lgam);
    LAS float* ch_emid = (LAS float*)(lds + MX_CH); LAS float* ch_elm = ch_emid + 128; LAS float* ch_dl = ch_emid + 256; LAS float* ch_part = ch_emid + 384;
    LAS float* ssq = (LAS float*)(lds + MX_SSQ); LAS float* invs = (LAS float*)(lds + MX_INV);

    f32x4 S[8][NT];
#pragma unroll
    for (int kt = 0; kt < 8; ++kt)
#pragma unroll
        for (int nt = 0; nt < NT; ++nt) {
            if (STATE_ONLY) S[kt][nt] = (f32x4){0.f, 0.f, 0.f, 0.f};
            else { const float* up = Ug + (size_t)(16 * kt + 4 * fq) * DV + 16 * (w * NT + nt) + fr;
                S[kt][nt] = (f32x4){up[0], up[DV], up[2 * DV], up[3 * DV]}; } }
    float bseg = 0.f;

    for (int c = 0; c < 8; ++c) {
        const int r0 = m0 + 64 * c;
        if (HG) {
            const int k = tid & 127, qd = tid >> 7, rr = rho(k);
            float cs[16], qv[16], kk[16];
#pragma unroll
            for (int i = 0; i < 16; ++i) { const size_t gi = (size_t)(r0 + 16 * qd + i) * 512 + k; cs[i] = LFg[gi]; if (!STATE_ONLY) qv[i] = bf2f(Qg[gi]); else qv[i] = 0.f; }
#pragma unroll
            for (int i = 0; i < 16; ++i) kk[i] = 1.f - __expf(cs[i]);
#pragma unroll
            for (int i = 1; i < 16; ++i) cs[i] += cs[i - 1];
            ch_part[qd * 128 + k] = cs[15];
            __syncthreads();
            const float p0 = ch_part[k], p1 = ch_part[128 + k], p2 = ch_part[256 + k], p3 = ch_part[384 + k];
            const float off = (qd > 0 ? p0 : 0.f) + (qd > 1 ? p1 : 0.f) + (qd > 2 ? p2 : 0.f), bmid = p0 + p1, blast = (p0 + p1) + (p2 + p3);
            unsigned kb[16];
#pragma unroll
            for (int i = 0; i < 16; ++i) { const int t = 16 * qd + i; const float e1 = __expf(fminf(fmaxf(off + cs[i] - bmid, -80.f), 80.f)); const float kt_ = kk[i] * __builtin_amdgcn_rcpf(e1);
                kb[i] = f2bf(kt_);
                if (!STATE_ONLY) { *(LAS unsigned short*)(lds + MX_QL + t * QSTR + 2 * k) = (unsigned short)f2bf(qv[i] * e1); *(LAS unsigned short*)(lds + MX_KL + t * QSTR + 2 * k) = (unsigned short)kb[i]; } }
            { pg8::u32x4 w0, w1; w0.x = kb[0] | (kb[1] << 16); w0.y = kb[2] | (kb[3] << 16); w0.z = kb[4] | (kb[5] << 16); w0.w = kb[6] | (kb[7] << 16);
              w1.x = kb[8] | (kb[9] << 16); w1.y = kb[10] | (kb[11] << 16); w1.z = kb[12] | (kb[13] << 16); w1.w = kb[14] | (kb[15] << 16);
              *(LAS pg8::u32x4*)(lds + MX_KT + rr * TSTR + 32 * qd) = w0; *(LAS pg8::u32x4*)(lds + MX_KT + rr * TSTR + 32 * qd + 16) = w1; }
            if (qd == 0) { ch_emid[rr] = __expf(bmid); ch_elm[rr] = __expf(blast - bmid); ch_dl[rr] = __expf(blast); bseg += blast; }
        } else {
#pragma unroll
            for (int i = 0; i < 2; ++i) { const int pc = 2 * w + i; const size_t gi = (size_t)(r0 + lane) * 512 + pc * 8;
                if (!STATE_ONLY) { const pg8::u32x4 qw = *(const pg8::u32x4*)(Qg + gi); *(LAS pg8::u32x4*)(lds + MX_QL + lane * QSTR + pc * 16) = qw; }
                const pg8::u32x4 kw = *(const pg8::u32x4*)(Kg + gi);
                if (!STATE_ONLY) *(LAS pg8::u32x4*)(lds + MX_KL + lane * QSTR + pc * 16) = kw;
                const unsigned kwv[4] = {kw.x, kw.y, kw.z, kw.w};
#pragma unroll
                for (int j = 0; j < 8; ++j) { const unsigned short e = (unsigned short)(kwv[j >> 1] >> (16 * (j & 1))); *(LAS unsigned short*)(lds + MX_KT + rho(pc * 8 + j) * TSTR + 2 * lane) = e; } }
        }
#pragma unroll
        for (int i = 0; i < 2 * NT; ++i) { const int pc = 2 * NT * w + i; const pg8::u32x4 vw = *(const pg8::u32x4*)(Vg + (size_t)(r0 + lane) * LDV + pc * 8);
            const unsigned vwv[4] = {vw.x, vw.y, vw.z, vw.w};
#pragma unroll
            for (int j = 0; j < 8; ++j) { const unsigned short e = (unsigned short)(vwv[j >> 1] >> (16 * (j & 1))); *(LAS unsigned short*)(lds + MX_VT + (pc * 8 + j) * TSTR + 2 * lane) = e; } }
        __syncthreads();

        f32x4 o[4][NT];
        if (!STATE_ONLY) {
#pragma unroll
            for (int i = 0; i < 2; ++i) { const int id = 2 * w + i, si = id >> 2, ti = id & 3; f32x4 a = (f32x4){0.f, 0.f, 0.f, 0.f};
                if (si <= ti) {
#pragma unroll
                    for (int ks = 0; ks < 4; ++ks) a = MFMA16(LDS_B128(MX_KL + (16 * si + fr) * QSTR + 64 * ks + 16 * fq), LDS_B128(MX_QL + (16 * ti + fr) * QSTR + 64 * ks + 16 * fq), a);
                    if (si == ti) {
#pragma unroll
                        for (int r = 0; r < 4; ++r) if (4 * fq + r > fr) a[r] = 0.f; } }
                u32x2 pw; pw.x = pk2(a[0], a[1]); pw.y = pk2(a[2], a[3]);
                *(LAS u32x2*)(lds + MX_PL + (16 * ti + fr) * TSTR + 2 * (16 * si + 4 * fq)) = pw; }
            __syncthreads();
#pragma unroll
            for (int mt = 0; mt < 4; ++mt)
#pragma unroll
                for (int nt = 0; nt < NT; ++nt) o[mt][nt] = (f32x4){0.f, 0.f, 0.f, 0.f};
#pragma unroll
            for (int ks = 0; ks < 4; ++ks) { bfx8 bf[NT];
#pragma unroll
                for (int nt = 0; nt < NT; ++nt) { f32x4 s0 = S[2 * ks][nt], s1 = S[2 * ks + 1][nt];
                    if (HG) { s0 = s0 * *(const LAS f32x4*)(ch_emid + 32 * ks + 4 * fq); s1 = s1 * *(const LAS f32x4*)(ch_emid + 32 * ks + 16 + 4 * fq); }
                    pg8::u32x4 pk; pk.x = pk2(s0[0], s0[1]); pk.y = pk2(s0[2], s0[3]); pk.z = pk2(s1[0], s1[1]); pk.w = pk2(s1[2], s1[3]); bf[nt] = __builtin_bit_cast(bfx8, pk); }
#pragma unroll
                for (int mt = 0; mt < 4; ++mt) { const bfx8 af = LDS_B128(MX_QL + (16 * mt + fr) * QSTR + 64 * ks + 16 * fq);
#pragma unroll
                    for (int nt = 0; nt < NT; ++nt) o[mt][nt] = MFMA16(af, bf[nt], o[mt][nt]); } }
#pragma unroll
            for (int ks = 0; ks < 2; ++ks) { bfx8 vf[NT];
#pragma unroll
                for (int nt = 0; nt < NT; ++nt) vf[nt] = LDS_B128(MX_VT + (16 * (w * NT + nt) + fr) * TSTR + 64 * ks + 16 * fq);
#pragma unroll
                for (int mt = 0; mt < 4; ++mt) { if (32 * ks > 16 * mt + 15) continue;
                    const bfx8 af = LDS_B128(MX_PL + (16 * mt + fr) * TSTR + 64 * ks + 16 * fq);
#pragma unroll
                    for (int nt = 0; nt < NT; ++nt) o[mt][nt] = MFMA16(af, vf[nt], o[mt][nt]); } }
        }
        if (HG) {
            f32x4 P[8][NT];
#pragma unroll
            for (int kt = 0; kt < 8; ++kt)
#pragma unroll
                for (int nt = 0; nt < NT; ++nt) P[kt][nt] = (f32x4){0.f, 0.f, 0.f, 0.f};
#pragma unroll
            for (int ks = 0; ks < 2; ++ks) { bfx8 vf[NT];
#pragma unroll
                for (int nt = 0; nt < NT; ++nt) vf[nt] = LDS_B128(MX_VT + (16 * (w * NT + nt) + fr) * TSTR + 64 * ks + 16 * fq);
#pragma unroll
                for (int kt = 0; kt < 8; ++kt) { const bfx8 af = LDS_B128(MX_KT + (16 * kt + fr) * TSTR + 64 * ks + 16 * fq);
#pragma unroll
                    for (int nt = 0; nt < NT; ++nt) P[kt][nt] = MFMA16(af, vf[nt], P[kt][nt]); } }
#pragma unroll
            for (int kt = 0; kt < 8; ++kt) { const f32x4 dl = *(const LAS f32x4*)(ch_dl + 16 * kt + 4 * fq), el = *(const LAS f32x4*)(ch_elm + 16 * kt + 4 * fq);
#pragma unroll
                for (int nt = 0; nt < NT; ++nt) S[kt][nt] = dl * S[kt][nt] + el * P[kt][nt]; }
        } else {
#pragma unroll
            for (int ks = 0; ks < 2; ++ks) { bfx8 vf[NT];
#pragma unroll
                for (int nt = 0; nt < NT; ++nt) vf[nt] = LDS_B128(MX_VT + (16 * (w * NT + nt) + fr) * TSTR + 64 * ks + 16 * fq);
#pragma unroll
                for (int kt = 0; kt < 8; ++kt) { const bfx8 af = LDS_B128(MX_KT + (16 * kt + fr) * TSTR + 64 * ks + 16 * fq);
#pragma unroll
                    for (int nt = 0; nt < NT; ++nt) S[kt][nt] = MFMA16(af, vf[nt], S[kt][nt]); } }
            if (c & 1) {
#pragma unroll
                for (int kt = 0; kt < 8; ++kt)
#pragma unroll
                    for (int nt = 0; nt < NT; ++nt) S[kt][nt] = S[kt][nt] * g128; }
        }
        if (!STATE_ONLY) {
#pragma unroll
            for (int mt = 0; mt < 4; ++mt)
#pragma unroll
                for (int r = 0; r < 4; ++r) { float q = 0.f;
#pragma unroll
                    for (int nt = 0; nt < NT; ++nt) q += o[mt][nt][r] * o[mt][nt][r];
                    q += __shfl_xor(q, 1); q += __shfl_xor(q, 2); q += __shfl_xor(q, 4); q += __shfl_xor(q, 8);
                    if (fr == 0) ssq[w * 64 + 16 * mt + 4 * fq + r] = q; }
            __syncthreads();
            if (tid < 64) { float tot = 0.f;
#pragma unroll
                for (int ww = 0; ww < 8; ++ww) tot += ssq[ww * 64 + tid];
                invs[tid] = rsqrtf(tot * (1.f / DV) + EPS); }
            __syncthreads();
#pragma unroll
            for (int nt = 0; nt < NT; ++nt) { const int v = 16 * (w * NT + nt) + fr; const float g = gn[v];
#pragma unroll
                for (int mt = 0; mt < 4; ++mt)
#pragma unroll
                    for (int r = 0; r < 4; ++r) { const int t = 16 * mt + 4 * fq + r; bf16_t* gp = Gg + (size_t)(r0 + t) * LDV + v;
                        *gp = (bf16_t)f2bf(o[mt][nt][r] * invs[t] * g * bf2f(*gp)); } }
        } else { __syncthreads(); }
    }
    if (STATE_ONLY) {
#pragma unroll
        for (int kt = 0; kt < 8; ++kt)
#pragma unroll
            for (int nt = 0; nt < NT; ++nt) { float* up = Ug + (size_t)(16 * kt + 4 * fq) * DV + 16 * (w * NT + nt) + fr;
                up[0] = S[kt][nt][0]; up[DV] = S[kt][nt][1]; up[2 * DV] = S[kt][nt][2]; up[3 * DV] = S[kt][nt][3]; }
        if (HG && tid < 128) DHg[rho(tid)] = __expf(bseg);
    }
}
__device__ __forceinline__ void mixer_scan(const Ctx& C) {
    const int tid = tid_opaque(C.wave_s); const int gt = C.vcu * 512 + tid;
    float* UH = (float*)((unsigned char*)C.out + OUT_UH); float* UR = (float*)((unsigned char*)C.out + OUT_UR); const float* DH = (const float*)(C.ws + WS_SMALL + SM_DH);
    { const int bh = gt >> 14, e = gt & 16383, row = e >> 7; float carry = 0.f;
      for (int s = 0; s < 16; ++s) { float* p = UH + ((size_t)(bh * 16 + s) << 14) + e; const float u = *p; *p = carry; carry = DH[(bh * 16 + s) * 128 + row] * carry + u; } }
#pragma unroll 1
    for (int i = 0; i < 2; ++i) { const int g2 = gt + i * 131072; const int bh = g2 >> 15, e = g2 & 32767; const float d = __expf(512.f * gamma_lg(bh & 3)); float carry = 0.f;
      for (int s = 0; s < 16; ++s) { float* p = UR + ((size_t)(bh * 16 + s) << 15) + e; const float u = *p; *p = carry; carry = d * carry + u; } }
}
template <bool STATE_ONLY> __device__ __forceinline__ void mixer_phase(const Ctx& C) {
    for (int uu = C.vcu; uu < 256; uu += C.G) { const int u = uu & 127, b = u >> 6, h = (u >> 4) & 3, seg = u & 15;
        if (uu < 128) mixer_unit<1, true, STATE_ONLY>(C, b, h, seg); else mixer_unit<2, false, STATE_ONLY>(C, b, h, seg); }
}

#ifndef MK_TS
#define MK_TS -1
#endif
#ifndef MK_TS_SCALE
#define MK_TS_SCALE 8e-3f
#endif
__global__ void __launch_bounds__(NWAVES * 64, 2) fwd(Args args) {
    extern __shared__ __attribute__((aligned(16))) unsigned char lds_raw[];
    Ctx C; C.lds = (LAS unsigned char*)lds_raw; C.wave_s = __builtin_amdgcn_readfirstlane((int)threadIdx.x >> 6);
    C.G = gridDim.x; { const int bx = blockIdx.x; C.vcu = (C.G % 8 == 0) ? (bx % 8) * (C.G / 8) + bx / 8 : bx; }
    C.in = args.in; C.out = args.out; C.ws = args.ws;
    gu32* ctl = (gu32*)(args.ws + WS_CTL);
    volatile LAS unsigned* MISC = (volatile LAS unsigned*)(C.lds + MISC_OFF);
    for (int u = threadIdx.x; u < (2048) / 4; u += NWAVES * 64) ((LAS unsigned*)(C.lds + LDSCTL_OFF))[u] = 0u;
    __syncthreads();
    XcdBarrier bar; bar.bar = (unsigned*)(ctl + CW_BAR); bar.x = 0; bar.st = nullptr;
    if (!MK_PER_PHASE) bar = xcd_barrier_post((unsigned*)(ctl + CW_BAR), MISC + 8);
    const int lo = args.ph_lo, hi = args.ph_hi;
    if (MK_TS >= 0 && blockIdx.x == 0 && threadIdx.x == 0) { volatile LAS unsigned long long* tsl_ = (volatile LAS unsigned long long*)(C.lds + MISC_OFF + 64); const unsigned long long now_ = __builtin_amdgcn_s_memrealtime(); tsl_[0] = now_; tsl_[1] = now_; tsl_[2] = now_; }
#define IN(k) (lo <= (k) && (k) < hi)
#define SEAM(k) do { if (MK_TS >= 0 && blockIdx.x == 0 && threadIdx.x == 0) { const unsigned long long now_ = __builtin_amdgcn_s_memrealtime(); \
        volatile LAS unsigned long long* tsl_ = (volatile LAS unsigned long long*)(C.lds + MISC_OFF + 64); if ((k) == MK_TS - 1) tsl_[1] = now_; if ((k) == MK_TS) tsl_[2] = now_; \
        if ((k) == 11) { const float frac_ = (float)(tsl_[2] - tsl_[1]) / (float)(now_ - tsl_[0]); __hip_atomic_store((float*)(ctl + 2048), sqrtf(frac_ * MK_TS_SCALE), __ATOMIC_RELAXED, __HIP_MEMORY_SCOPE_AGENT); } } \
    if (IN(k) && IN((k) + 1)) xcd_barrier(bar, C.wave_s); } while (0)

#ifndef MK_DUP
#define MK_DUP -1
#endif
#define REPS(k) for (int rep_ = 0; rep_ < ((k) == MK_DUP ? 2 : 1); ++rep_)
#define REPBAR() do { if (rep_) xcd_barrier(bar, C.wave_s); } while (0)
    PG8_LAS unsigned char* ring = (PG8_LAS unsigned char*)C.lds;
    using namespace pg8;
    if (IN(0)) REPS(0) { REPBAR();  p0_prologue(C); } SEAM(0);
    if (IN(1)) REPS(1) { REPBAR();  Gemm g{(const bf16_t*)C.out, WSP(bf16_t, WS_WIN), M, NIN, 1024}; DenseOrder S; S.init(M, NIN, C.G, (int)blockIdx.x);
        EpiP1 E{(const float*)(C.ws + WS_SMALL + SM_RS1), (const float*)(C.ws + WS_SMALL + SM_LB), (float*)((unsigned char*)C.out + 32 * MiB),
                WSP(bf16_t, WS_QH), WSP(bf16_t, WS_VH), WSP(bf16_t, WS_GH), WSP(bf16_t, WS_RQ), WSP(bf16_t, WS_RK), WSP(bf16_t, WS_RV), WSP(bf16_t, WS_RG), WSP(bf16_t, WS_GA), WSP(bf16_t, WS_GB)};
        gemm_phase<EpiP1, DenseOrder>(ring, C.wave_s, g, S, E); } SEAM(1);
#if MK_NAIVE_MIX
    if (IN(2)) REPS(2) { REPBAR();  if (C.vcu < 8) p2_naive_hgrn(C, C.vcu); else if (C.vcu < 16) p2_naive_ret(C, C.vcu - 8); } SEAM(2); SEAM(3); SEAM(4);
#else
    if (IN(2)) REPS(2) { REPBAR();  mixer_phase<true>(C); } SEAM(2);
    if (IN(3)) REPS(3) { REPBAR();  mixer_scan(C); } SEAM(3);
    if (IN(4)) REPS(4) { REPBAR();  mixer_phase<false>(C); } SEAM(4);
#endif
    if (IN(5)) REPS(5) { REPBAR();  DenseOrder S; S.init(M, 1024, C.G, (int)blockIdx.x);
        { Gemm g{WSP(bf16_t, WS_GH), WSP(bf16_t, WS_WA), M, 1024, 512}; EpiF<EpiGateMul> E{{WSP(bf16_t, WS_GA), WSP(bf16_t, WS_MG)}}; gemm_phase<EpiF<EpiGateMul>, DenseOrder>(ring, C.wave_s, g, S, E); }
        { Gemm g{WSP(bf16_t, WS_RG), WSP(bf16_t, WS_WB), M, 1024, 1024}; EpiF<EpiGateMulAdd> E{{WSP(bf16_t, WS_GB), WSP(bf16_t, WS_MG)}}; gemm_phase<EpiF<EpiGateMulAdd>, DenseOrder>(ring, C.wave_s, g, S, E); } } SEAM(5);
    if (IN(6)) REPS(6) { REPBAR();  DenseOrder S; S.init(M, 1024, C.G, (int)blockIdx.x); Gemm g{WSP(bf16_t, WS_MG), WSP(bf16_t, WS_WO), M, 1024, 1024};
        EpiF<EpiResid, false> E{{CIN(0), C.out, WSP(bf16_t, WS_H2)}}; gemm_phase<EpiF<EpiResid, false>, DenseOrder>(ring, C.wave_s, g, S, E); } SEAM(6);
    if (IN(7)) REPS(7) { REPBAR();  p6_router(C, ctl); } SEAM(7);
    if (IN(8)) REPS(8) { REPBAR();  const int ntiles = moe_plan(C, ctl); GroupOrder S{ntiles, 2, C.G, (int)blockIdx.x, (const PG8_LAS int*)(C.lds + TILEE_OFF)}; moe_rowinfo<true>(C, S);
        Gemm g{WSP(bf16_t, WS_H2), WSP(bf16_t, WS_WGU), 0, 512, 1024}; EpiPairF<EpiGateUp> E{{(const PG8_LAS int*)(C.lds + ROWINFO_OFF), WSP(bf16_t, WS_HM)}};
        gemm_phase<EpiPairF<EpiGateUp>, GroupOrder, true, true, true>(ring, C.wave_s, g, S, E, (const PG8_LAS int*)(C.lds + ROWINFO_OFF)); } SEAM(8);
    if (IN(9)) REPS(9) { REPBAR();  const int ntiles = moe_plan(C, ctl); GroupOrder S{ntiles, 4, C.G, (int)blockIdx.x, (const PG8_LAS int*)(C.lds + TILEE_OFF)}; moe_rowinfo<false>(C, S);
        Gemm g{WSP(bf16_t, WS_HM), WSP(bf16_t, WS_WD), 0, 1024, 256}; EpiF<EpiDown> E{{(const PG8_LAS int*)(C.lds + ROWINFO_OFF), WSP(bf16_t, WS_YS)}};
        gemm_phase<EpiF<EpiDown>, GroupOrder>(ring, C.wave_s, g, S, E); } SEAM(9);
    if (IN(10)) REPS(10) { REPBAR();  p9_combine(C); } SEAM(10);
    if (IN(11)) REPS(11) { REPBAR();  DenseOrder S; S.init(M, 1024, C.G, (int)blockIdx.x);
        { Gemm g{WSP(bf16_t, WS_PB), WSP(bf16_t, WS_WPP), M, 1024, 256}; EpiF<EpiStoreBf> E{{WSP(bf16_t, WS_PP)}}; gemm_phase<EpiF<EpiStoreBf>, DenseOrder>(ring, C.wave_s, g, S, E); }
        { Gemm g{WSP(bf16_t, WS_X2B), WSP(bf16_t, WS_WPG), M, 1024, 1024}; EpiF<EpiPle> E{{WSP(bf16_t, WS_PP), C.out}}; gemm_phase<EpiF<EpiPle>, DenseOrder>(ring, C.wave_s, g, S, E); } } SEAM(11);
    if (IN(12)) REPS(12) { REPBAR();  p11_final(C, MK_TS >= 0 ? 1.f + __hip_atomic_load((float*)(ctl + 2048), __ATOMIC_RELAXED, __HIP_MEMORY_SCOPE_AGENT) : 1.f); }
#undef IN
#undef SEAM
}

extern "C" void kernel_launch(void* const* d_in, const int* in_sizes, int n_in, void* d_out, int out_size, void* d_ws, size_t ws_size, hipStream_t stream) {
    static int grid = 0;
    if (grid == 0) {
        int dev = 0, cus = 0, per_cu = 0;
        if (hipGetDevice(&dev) != hipSuccess || hipDeviceGetAttribute(&cus, hipDeviceAttributeMultiprocessorCount, dev) != hipSuccess) { fprintf(stderr, "kernel_launch: device query failed\n"); grid = -1; return; }
        if (hipFuncSetAttribute((const void*)fwd, hipFuncAttributeMaxDynamicSharedMemorySize, LDS_BYTES) != hipSuccess) { fprintf(stderr, "kernel_launch: hipFuncSetAttribute failed\n"); grid = -1; return; }
        if (hipOccupancyMaxActiveBlocksPerMultiprocessor(&per_cu, (const void*)fwd, NWAVES * 64, LDS_BYTES) != hipSuccess || per_cu < 1) { fprintf(stderr, "kernel_launch: occupancy query says %d blocks/CU\n", per_cu); }
        (void)hipGetLastError();
        grid = cus;
    }
    if (grid < 0) return;
    (void)hipMemsetAsync((char*)d_ws + WS_CTL, 0, 1 * MiB, stream);
    Args a{};
    for (int i = 0; i < 22; ++i) a.in[i] = (const float*)d_in[i];
    a.out = (float*)d_out; a.ws = (unsigned char*)d_ws;
#if MK_PER_PHASE
    for (int p = 0; p < N_PHASES; ++p) { a.ph_lo = p; a.ph_hi = p + 1; hipLaunchKernelGGL(fwd, dim3(grid), dim3(NWAVES * 64), LDS_BYTES, stream, a); }
#else
    a.ph_lo = 0; a.ph_hi = N_PHASES; hipLaunchKernelGGL(fwd, dim3(grid), dim3(NWAVES * 64), LDS_BYTES, stream, a);
#endif
}
```

```cpp
#include <hip/hip_runtime.h>
#include <cstdint>
#include <cstdio>

#ifndef MK_DUP
#define MK_DUP -1
#endif
typedef unsigned short bf16_t;
typedef float f32x4 __attribute__((ext_vector_type(4)));
typedef unsigned u32x2 __attribute__((ext_vector_type(2)));

constexpr int M = 16384, D = 1024, SEQ = 8192, NIN = 7168, PLE = 256;
constexpr int NE = 32, DE = 256;
constexpr float EPS = 1e-6f;
constexpr int LIST_CAP = 32768;
constexpr int POS_CAP = 40960;

constexpr size_t MiB = 1u << 20;
constexpr size_t WS_CTL = 0;
constexpr size_t WS_SMALL = 1 * MiB;
constexpr size_t WS_LIST = 2 * MiB;
constexpr size_t WS_WA = 6 * MiB, WS_WB = 7 * MiB, WS_WO = 9 * MiB, WS_WPG = 11 * MiB, WS_WPP = 13 * MiB;
constexpr size_t WS_WR = 13 * MiB + 512 * 1024;
constexpr size_t WS_PB = 14 * MiB;
constexpr size_t WS_WIN = 22 * MiB;
constexpr size_t WS_QH = 36 * MiB, WS_VH = 52 * MiB, WS_GH = 68 * MiB, WS_RQ = 84 * MiB, WS_RK = 100 * MiB;
constexpr size_t WS_RV = 116 * MiB, WS_RG = 148 * MiB, WS_GA = 180 * MiB, WS_GB = 212 * MiB;
constexpr size_t WS_MG = 116 * MiB;
constexpr size_t WS_WGU = 84 * MiB;
constexpr size_t WS_WD = 36 * MiB;
constexpr size_t WS_H2 = 148 * MiB;
constexpr size_t WS_HM = 116 * MiB;
constexpr size_t WS_YS = 180 * MiB;
constexpr size_t WS_X2B = 148 * MiB;
constexpr size_t WS_PP = 52 * MiB;
constexpr size_t SM_RS1 = 0, SM_RS2 = 64 * 1024, SM_RS3 = 128 * 1024, SM_EID = 192 * 1024, SM_WGT = 320 * 1024, SM_LB = 448 * 1024;
constexpr size_t SM_ROWMAP = 512 * 1024;
constexpr size_t SM_TILEE = 700 * 1024;
constexpr int CW_CNT = 8192;

__device__ __forceinline__ unsigned f2bf(float f) { unsigned u = __float_as_uint(f); return (u + 0x7fffu + ((u >> 16) & 1u)) >> 16; }
__device__ __forceinline__ float bf2f(unsigned short h) { return __uint_as_float(((unsigned)h) << 16); }
typedef float f32x2_t __attribute__((ext_vector_type(2))); typedef __bf16 bf16x2_t __attribute__((ext_vector_type(2)));
__device__ __forceinline__ unsigned pk2(float lo, float hi) { f32x2_t v = {lo, hi}; bf16x2_t b = __builtin_convertvector(v, bf16x2_t); return __builtin_bit_cast(unsigned, b); }
__device__ __forceinline__ float siluf(float v) { return v * __builtin_amdgcn_rcpf(1.f + __builtin_amdgcn_exp2f(-1.4426950408889634f * v)); }
__device__ __forceinline__ float sigmf(float v) { return __builtin_amdgcn_rcpf(1.f + __builtin_amdgcn_exp2f(-1.4426950408889634f * v)); }
__device__ __forceinline__ void st4bf(bf16_t* p, f32x4 v) { u32x2 w; w.x = pk2(v[0], v[1]); w.y = pk2(v[2], v[3]); *(u32x2*)p = w; }
__device__ __forceinline__ f32x4 ld4bf(const bf16_t* p) { u32x2 w = *(const u32x2*)p; f32x4 r; r[0] = __uint_as_float(w.x << 16); r[1] = __uint_as_float(w.x & 0xffff0000u); r[2] = __uint_as_float(w.y << 16); r[3] = __uint_as_float(w.y & 0xffff0000u); return r; }
__device__ __forceinline__ float wave_sum(float v) {
#pragma unroll
    for (int o = 1; o < 64; o <<= 1) v += __shfl_xor(v, o);
    return v;
}
__device__ __forceinline__ int tid_opaque(int wave_s) { int t = (wave_s << 6) | (int)__builtin_amdgcn_mbcnt_hi(~0u, __builtin_amdgcn_mbcnt_lo(~0u, 0u)); asm volatile("" : "+v"(t)); return t; }
__device__ __forceinline__ float gamma_lg(int h) { return log1pf(-exp2f(-5.f - (float)h)); }


namespace pg8 {
#define PG8_LAS __attribute__((address_space(3)))
typedef short bf16x8 __attribute__((ext_vector_type(8)));
typedef unsigned u32x4 __attribute__((ext_vector_type(4)));
constexpr int BM = 256, BK = 64, HALF = 128, HTB = HALF * BK * 2  , STAGE_BYTES = 8 * HTB, NXCD = 8, WGM = 8;

__host__ __device__ __forceinline__ int lds_byte(int r, int c) { const int st = (r >> 4) * 2 + (c >> 5), rr = r & 15, cc = c & 31, ob = rr * 64 + cc * 2; return st * 1024 + (ob ^ (((ob >> 9) & 1) << 5)); }
__host__ __device__ __forceinline__ void stage_rc(int b, int& R, int& C) { const int st = b / 1024, sb = b % 1024, swz = sb ^ (((sb >> 9) & 1) << 5); R = (st >> 1) * 16 + swz / 64; C = (st & 1) * 32 + (swz % 64) / 2; }
__host__ __device__ __forceinline__ int perm32(int rho) { const int n = rho >> 4, i = rho & 15; return 8 * (i >> 2) + 4 * n + (i & 3); }

struct Unit { int pm, pn, pb, ui; };
struct Gemm { const bf16_t* A; const bf16_t* Bt; int M, N, K; };

struct DenseOrder {
    int nM, nN, nwg, G, c;
    __host__ __device__ void init(int M, int N, int G_, int c_) { nM = M / BM; nN = N / BM; nwg = nM * nN; G = G_; c = c_; }
    __host__ __device__ bool next(int i, Unit& u) const {
        const long L = (long)i * G + c; if (L >= nwg) return false;
        int wgid = (int)L; { const int q = nwg / NXCD, r = nwg % NXCD, xcd = wgid % NXCD, off = wgid / NXCD; wgid = (xcd < r ? xcd * (q + 1) : r * (q + 1) + (xcd - r) * q) + off; }
        const int nig = WGM * nN, gid = wgid / nig, fm = gid * WGM, gsz = (nM - fm) < WGM ? (nM - fm) : WGM;
        u.pm = fm + ((wgid % nig) % gsz); u.pn = (wgid % nig) / gsz; u.pb = u.pn; u.ui = i; return true;
    }
    __device__ __forceinline__ void a_ready(const Unit&) const {}
    __device__ __forceinline__ void done(const Unit&) const {}
};
struct GroupOrder {
    int ntiles, NTN, G, c; const PG8_LAS int* tile_e;
    __device__ bool next(int i, Unit& u) const {
        const int L = i * G + c; if (L >= ntiles * NTN) return false;
        const int tile = L / NTN, pn = L - tile * NTN;
        u.pm = tile; u.pn = pn; u.pb = tile_e[tile] * NTN + pn; u.ui = i; return true;
    }
    __device__ __forceinline__ void a_ready(const Unit&) const {}
    __device__ __forceinline__ void done(const Unit&) const {}
};

template <class F, bool PERM_ = true> struct EpiF {
    static constexpr bool PERM = PERM_, AFTER_DRAIN = false; F f;
    __device__ __forceinline__ void operator()(const f32x4 (&acc)[2][2][4][2], const Unit& u, int wr, int wc, int fr, int fq) const {
#pragma unroll
        for (int ai = 0; ai < 2; ++ai)
#pragma unroll
            for (int m = 0; m < 4; ++m) { const int row = u.pm * BM + ai * HALF + wr * 64 + m * 16 + fr;
#pragma unroll
                for (int bj = 0; bj < 2; ++bj)
#pragma unroll
                    for (int n = 0; n < 2; ++n) { const int col = u.pn * BM + bj * HALF + wc * 32 + (PERM ? 8 * fq + 4 * n : 16 * n + 4 * fq); f(u, row, col, acc[ai][bj][m][n]); }
                asm volatile("" ::: "memory"); }
    }
};
template <class F> struct EpiPairF {
    static constexpr bool PERM = true, AFTER_DRAIN = false; F f;
    __device__ __forceinline__ void operator()(const f32x4 (&acc)[2][2][4][2], const Unit& u, int wr, int wc, int fr, int fq) const {
#pragma unroll
        for (int ai = 0; ai < 2; ++ai)
#pragma unroll
            for (int m = 0; m < 4; ++m) { const int row = u.pm * BM + ai * HALF + wr * 64 + m * 16 + fr;
#pragma unroll
                for (int n = 0; n < 2; ++n) { const int col = u.pn * HALF + wc * 32 + 8 * fq + 4 * n; f.pair(u, row, col, acc[ai][0][m][n], acc[ai][1][m][n]); }
                asm volatile("" ::: "memory"); }
    }
};

template <class Epi, class Sched, bool ALIGN_EPI = true, bool SP2 = true, bool GATHER = false>
__device__ __forceinline__ void gemm_phase(PG8_LAS unsigned char* lds, const int wave_s, const Gemm g, const Sched& S, const Epi& E, const PG8_LAS int* rowtab = nullptr) {
    static_assert(SP2, "only the SP2 loop is kept in this file");
    const int tid = tid_opaque(wave_s), wid = wave_s, lane = tid & 63, wr = wid >> 2, wc = wid & 3, fr = lane & 15, fq = lane >> 4;
    const int K = g.K, nt = K / BK;
    unsigned voffA[2], voffB[2];
#pragma unroll
    for (int i = 0; i < 2; ++i) { int R, C; stage_rc(tid * 16 + i * 8192, R, C); const int Rb = Epi::PERM ? ((R & ~31) + perm32(R & 31)) : R;
        voffA[i] = (unsigned)(R * K + C) * 2u; voffB[i] = (unsigned)(Rb * K + C) * 2u; }
    unsigned cvA[2][2];
    (void)cvA;
#define PG8_GOFF(dst, u_) do { _Pragma("unroll") for (int _h = 0; _h < 2; ++_h) _Pragma("unroll") for (int _i = 0; _i < 2; ++_i) { int R_, C_; stage_rc(tid * 16 + _i * 8192, R_, C_); \
        const int a_ = rowtab[(u_).ui * 512 + _h * HALF + R_]; const int tok_ = a_ < 0 ? 0 : (a_ >> 1); dst[_h][_i] = (unsigned)(tok_ * K + C_) * 2u; } } while (0)
    const size_t kstep = (size_t)(BK * 2);
    const size_t hstep = (size_t)HALF * K * 2;
    const size_t tstep = 2 * hstep;
    const unsigned ldsw = (unsigned)wid * 1024u;
    const int aoff = lds_byte(wr * 64 + fr, fq * 8), boff = lds_byte(wc * 32 + fr, fq * 8);
#define PG8_SA(b, h) (((b) * 2 + (h)) * HTB)
#define PG8_SB(b, h) ((4 + (b) * 2 + (h)) * HTB)
#define PG8_STAGE(bufoff, gbase, voff) do { _Pragma("unroll") for (int _i = 0; _i < 2; ++_i) \
        __builtin_amdgcn_global_load_lds((const unsigned*)((const char*)(gbase) + (voff)[_i]), (PG8_LAS unsigned*)(lds + (bufoff) + ldsw + _i * 8192), 16, 0, 0); } while (0)
#define PG8_STA(bufoff, ptr, h, nx) do { if constexpr (GATHER) { _Pragma("unroll") for (int _i = 0; _i < 2; ++_i) { const unsigned _vo = cvA[h][_i]; \
        __builtin_amdgcn_global_load_lds((const unsigned*)((const char*)(ptr) + _vo), (PG8_LAS unsigned*)(lds + (bufoff) + ldsw + _i * 8192), 16, 0, 0); } } \
    else { PG8_STAGE(bufoff, (ptr) + (h) * hstep, voffA); } } while (0)
#define PG8_LDA(dst, b, h) do { _Pragma("unroll") for (int m = 0; m < 4; ++m) _Pragma("unroll") for (int k = 0; k < 2; ++k) dst[m][k] = *(const PG8_LAS bf16x8*)(lds + PG8_SA(b, h) + aoff + m * 2048 + k * 1024); } while (0)
#define PG8_LDB(dst, b, h) do { _Pragma("unroll") for (int n = 0; n < 2; ++n) _Pragma("unroll") for (int k = 0; k < 2; ++k) dst[n][k] = *(const PG8_LAS bf16x8*)(lds + PG8_SB(b, h) + boff + n * 2048 + k * 1024); } while (0)
#define PG8_MMA(ai, bj, At, Bt) do { __builtin_amdgcn_s_setprio(1); _Pragma("unroll") for (int m = 0; m < 4; ++m) _Pragma("unroll") for (int n = 0; n < 2; ++n) _Pragma("unroll") for (int k = 0; k < 2; ++k) \
        acc[ai][bj][m][n] = __builtin_amdgcn_mfma_f32_16x16x32_bf16(Bt[n][k], At[m][k], acc[ai][bj][m][n], 0, 0, 0); __builtin_amdgcn_s_setprio(0); } while (0)
#define PG8_WAIT_V(n) asm volatile("s_waitcnt vmcnt(" #n ")" ::: "memory")
#define PG8_WAIT_L(n) asm volatile("s_waitcnt lgkmcnt(" #n ")" ::: "memory")
#define PG8_BAR __builtin_amdgcn_s_barrier()
#define PG8_SCHED __builtin_amdgcn_sched_barrier(0)
    Unit cur, nxt; int ui = 0;
    if (!S.next(0, cur)) return;
    f32x4 acc[2][2][4][2];
#pragma unroll
    for (int a = 0; a < 2; ++a)
#pragma unroll
        for (int b = 0; b < 2; ++b)
#pragma unroll
            for (int m = 0; m < 4; ++m)
#pragma unroll
                for (int n = 0; n < 2; ++n) acc[a][b][m][n] = (f32x4){0.f, 0.f, 0.f, 0.f};
    bf16x8 At[4][2], B0[2][2], B1[2][2];
    const char* cA = (const char*)g.A + (GATHER ? (size_t)0 : (size_t)cur.pm * tstep); const char* cB = (const char*)g.Bt + (size_t)cur.pb * tstep;
    if constexpr (GATHER) { PG8_GOFF(cvA, cur); }
    S.a_ready(cur);
    if constexpr (SP2) {
        PG8_STAGE(PG8_SB(0, 0), cB, voffB); PG8_STAGE(PG8_SB(0, 1), cB + hstep, voffB); PG8_STA(PG8_SA(0, 0), cA, 0, false); PG8_STA(PG8_SA(0, 1), cA, 1, false);
        if (wr == 1) PG8_BAR;
        PG8_WAIT_V(2); PG8_BAR;
        PG8_STAGE(PG8_SB(1, 0), cB + kstep, voffB); PG8_STA(PG8_SA(1, 0), cA + kstep, 0, false); PG8_STAGE(PG8_SB(1, 1), cB + hstep + kstep, voffB);
        PG8_WAIT_V(6); PG8_BAR;
    }
    for (;;) {
        const bool has_next = S.next(ui + 1, nxt);
        const char* nA = (has_next && !GATHER) ? (const char*)g.A + (size_t)nxt.pm * tstep : cA; const char* nB = has_next ? (const char*)g.Bt + (size_t)nxt.pb * tstep : cB;
        for (int t = 0; t < nt; t += 2) {
            const bool last = (t == nt - 2);
            const char* a1 = cA + (size_t)(t + 1) * kstep;
            const char* a2 = last ? nA : cA + (size_t)(t + 2) * kstep; const char* b2 = last ? nB : cB + (size_t)(t + 2) * kstep;
            const char* a3 = a2 + kstep; const char* b3 = b2 + kstep;
            if (last && has_next) S.a_ready(nxt);
            if constexpr (SP2) {
            PG8_LDB(B0, 0, 0); PG8_LDB(B1, 0, 1); PG8_SCHED; PG8_LDA(At, 0, 0); PG8_STA(PG8_SA(1, 1), a1, 1, false);
            if constexpr (GATHER) { if (last && has_next) { PG8_GOFF(cvA, nxt); } }
            PG8_WAIT_V(8); PG8_WAIT_L(0); PG8_BAR; PG8_MMA(0, 0, At, B0); PG8_MMA(0, 1, At, B1); PG8_BAR; PG8_SCHED;
            PG8_LDA(At, 0, 1); PG8_STAGE(PG8_SB(0, 0), b2, voffB); PG8_STAGE(PG8_SB(0, 1), b2 + hstep, voffB); PG8_STA(PG8_SA(0, 0), a2, 0, last);
            PG8_WAIT_V(8); PG8_WAIT_L(0); PG8_BAR; PG8_MMA(1, 0, At, B0); PG8_MMA(1, 1, At, B1); PG8_BAR; PG8_SCHED;
            PG8_LDB(B0, 1, 0); PG8_LDB(B1, 1, 1); PG8_SCHED; PG8_LDA(At, 1, 0); PG8_STA(PG8_SA(0, 1), a2, 1, last);
            PG8_WAIT_V(8); PG8_WAIT_L(0); PG8_BAR; PG8_MMA(0, 0, At, B0); PG8_MMA(0, 1, At, B1); PG8_BAR; PG8_SCHED;
            PG8_LDA(At, 1, 1); PG8_STAGE(PG8_SB(1, 0), b3, voffB); PG8_STAGE(PG8_SB(1, 1), b3 + hstep, voffB); PG8_STA(PG8_SA(1, 0), a3, 0, last);
            PG8_WAIT_V(8); PG8_WAIT_L(0); PG8_BAR; PG8_MMA(1, 0, At, B0); PG8_MMA(1, 1, At, B1); PG8_BAR; PG8_SCHED;
            }
        }
        if constexpr (ALIGN_EPI) { if (wr == 0) PG8_BAR; }
        if constexpr (!Epi::AFTER_DRAIN) { const int t2_ = tid_opaque(wave_s) & 63; E(acc, cur, wr, wc, t2_ & 15, t2_ >> 4); S.done(cur); }
        if (!has_next) break;
#pragma unroll
        for (int a = 0; a < 2; ++a)
#pragma unroll
            for (int b = 0; b < 2; ++b)
#pragma unroll
                for (int m = 0; m < 4; ++m)
#pragma unroll
                    for (int n = 0; n < 2; ++n) acc[a][b][m][n] = (f32x4){0.f, 0.f, 0.f, 0.f};
        cur = nxt; cA = nA; cB = nB; ++ui;
        if constexpr (ALIGN_EPI) { if (wr == 1) PG8_BAR; }
    }
    PG8_WAIT_V(0);
    if constexpr (!ALIGN_EPI) { if (wr == 0) PG8_BAR; }
    PG8_BAR;
    if constexpr (Epi::AFTER_DRAIN) { E.fused(acc, cur, wr, wc, fr, fq, lds, wid, lane); S.done(cur); }
#undef PG8_SA
#undef PG8_SB
#undef PG8_STAGE
#undef PG8_STA
#undef PG8_GOFF
#undef PG8_LDA
#undef PG8_LDB
#undef PG8_MMA
#undef PG8_WAIT_V
#undef PG8_WAIT_L
#undef PG8_BAR
#undef PG8_SCHED
}
}

#define GAS __attribute__((address_space(1)))
#define LAS __attribute__((address_space(3)))
typedef unsigned v4u __attribute__((ext_vector_type(4)));
typedef GAS unsigned gu32;
typedef GAS unsigned long long gu64;
#define RLX_AGENT __ATOMIC_RELAXED, __HIP_MEMORY_SCOPE_AGENT
#define LDS_WAIT() asm volatile("s_waitcnt lgkmcnt(0)" ::: "memory")
#define VM_WAIT() asm volatile("s_waitcnt vmcnt(0)" ::: "memory")
__device__ __forceinline__ unsigned long long rt() { return __builtin_amdgcn_s_memrealtime(); }

#define XB_TMO      128
#define XB_XCNT(j)  (256  + 64 * (j))
#define XB_XSUB(j)  (1280 + 64 * (j))
#define XB_XGEN(j)  (2304 + 64 * (j))
#define XB_TOP      3328
#define XB_TOPGEN   3392
#define XCD_BAR_WORDS 3456
#define XB_SPIN_CAP (1u << 18)

__device__ __forceinline__ unsigned xb_ld(unsigned* p)              { return __hip_atomic_load(p, __ATOMIC_RELAXED, __HIP_MEMORY_SCOPE_AGENT); }
__device__ __forceinline__ unsigned xb_add(unsigned* p, unsigned v) { return __hip_atomic_fetch_add(p, v, __ATOMIC_RELAXED, __HIP_MEMORY_SCOPE_AGENT); }
__device__ __forceinline__ unsigned xb_xcc_id() { return (unsigned)__builtin_amdgcn_s_getreg((3 << 11) | 20) & 0xFu; }
#define XB_SPIN(cond, bar) do { unsigned _sp = 0; while (cond) { __builtin_amdgcn_s_sleep(1); \
    if ((++_sp & 255u) == 0u) { if (xb_ld(&(bar)[XB_TMO])) break; if (_sp > XB_SPIN_CAP) { atomicAdd(&(bar)[XB_TMO], 1u); break; } } } } while (0)

struct XcdBarrier {
    unsigned* bar; unsigned x;
    volatile LAS unsigned* st;
};

__device__ __forceinline__ XcdBarrier xcd_barrier_post(unsigned* bar, volatile LAS unsigned* st) {
    XcdBarrier b; b.bar = bar; b.x = xb_xcc_id(); b.st = st;
    if (threadIdx.x == 0) (void)xb_add(&bar[XB_XCNT(b.x)], 1u);
    return b;
}
__device__ __forceinline__ void xcd_barrier_complete(unsigned* bar, unsigned x, unsigned& nloc, unsigned& nx) {
    const unsigned G = gridDim.x * gridDim.y * gridDim.z;
    unsigned sum, cnt, mine, sp = 0u;
    for (;;) {
        sum = 0u; cnt = 0u; mine = 0u;
#pragma unroll
        for (unsigned j = 0; j < 16; ++j) { const unsigned c = xb_ld(&bar[XB_XCNT(j)]); sum += c; cnt += (c > 0u) ? 1u : 0u; mine = (j == x) ? c : mine; }
        if (sum == G) break;
        __builtin_amdgcn_s_sleep(1);
        if ((++sp & 255u) == 0u) { if (xb_ld(&bar[XB_TMO])) break; if (sp > XB_SPIN_CAP) { atomicAdd(&bar[XB_TMO], 1u); break; } }
    }
    nloc = mine > 0u ? mine : 1u; nx = cnt > 0u ? cnt : 1u;
}

__device__ __forceinline__ void xcd_barrier(const XcdBarrier& b, const int wave_s) {
    asm volatile("s_waitcnt vmcnt(0)" ::: "memory");
    __syncthreads();
    if (tid_opaque(wave_s) == 0) {
        unsigned* bar = b.bar;
        __builtin_amdgcn_s_waitcnt(0);
        unsigned nloc = b.st[0], nx = b.st[1];
        if (nloc == 0u) { xcd_barrier_complete(bar, b.x, nloc, nx); b.st[0] = nloc; b.st[1] = nx; }
        const unsigned old = xb_add(&bar[XB_XSUB(b.x)], 1u);
        const unsigned gen = old / nloc;
        if (old + 1u == (gen + 1u) * nloc) {
            __builtin_amdgcn_fence(__ATOMIC_RELEASE, "agent");
            asm volatile("s_waitcnt vmcnt(0)" ::: "memory");
            const unsigned og = xb_add(&bar[XB_TOP], 1u);
            const unsigned tg = og / nx;
            if (og + 1u == (tg + 1u) * nx) xb_add(&bar[XB_TOPGEN], 1u);
            else XB_SPIN(xb_ld(&bar[XB_TOPGEN]) == tg, bar);
            __builtin_amdgcn_fence(__ATOMIC_ACQUIRE, "agent");
            xb_add(&bar[XB_XGEN(b.x)], 1u);
            asm volatile("s_waitcnt vmcnt(0)" ::: "memory");
        } else {
            XB_SPIN(xb_ld(&bar[XB_XGEN(b.x)]) == gen, bar);
            __builtin_amdgcn_fence(__ATOMIC_ACQUIRE, "agent");
            asm volatile("s_waitcnt vmcnt(0)" ::: "memory");
        }
    }
    __syncthreads();
}

using pg8::Unit;
struct EpiP1 {
    static constexpr bool PERM = true, AFTER_DRAIN = false;
    const float* rs1; const float* lb; float* LF;
    bf16_t *QH, *VH, *GH, *RQ, *RK, *RV, *RG, *GA, *GB;
    template <int ACT> __device__ __forceinline__ void unary(const f32x4 (&acc)[2][2][4][2], int row0, int wc, int fq, bf16_t* dst, int ld, int colbase) const {
#pragma unroll
        for (int ai = 0; ai < 2; ++ai)
#pragma unroll
            for (int m = 0; m < 4; ++m) { const int row = row0 + ai * 128 + m * 16; bf16_t* rowp = dst + (size_t)row * ld + colbase + wc * 32 + 8 * fq;
#pragma unroll
                for (int bj = 0; bj < 2; ++bj) { f32x4 v0 = acc[ai][bj][m][0], v1 = acc[ai][bj][m][1];
                    if (ACT == 1) { for (int j = 0; j < 4; ++j) { v0[j] = siluf(v0[j]); v1[j] = siluf(v1[j]); } }
                    if (ACT == 2) { for (int j = 0; j < 4; ++j) { v0[j] = sigmf(v0[j]); v1[j] = sigmf(v1[j]); } }
                    pg8::u32x4 w; w.x = pk2(v0[0], v0[1]); w.y = pk2(v0[2], v0[3]); w.z = pk2(v1[0], v1[1]); w.w = pk2(v1[2], v1[3]);
                    *(pg8::u32x4*)(rowp + bj * 128) = w; } }
    }
    __device__ __forceinline__ void operator()(const f32x4 (&acc)[2][2][4][2], const Unit& u, int wr, int wc, int fr, int fq) const {
        const int row0 = u.pm * 256 + wr * 64 + fr; const int c0 = u.pn * 256; const int sec = c0 >> 9;
        if (sec == 0) unary<1>(acc, row0, wc, fq, QH, 512, c0);
        else if (sec == 2) unary<0>(acc, row0, wc, fq, VH, 512, c0 - 1024);
        else if (sec == 3) unary<1>(acc, row0, wc, fq, GH, 512, c0 - 1536);
        else if (sec == 6 || sec == 7) unary<0>(acc, row0, wc, fq, RV, 1024, c0 - 3072);
        else if (sec == 8 || sec == 9) unary<1>(acc, row0, wc, fq, RG, 1024, c0 - 4096);
        else if (sec == 10 || sec == 11) unary<2>(acc, row0, wc, fq, GA, 1024, c0 - 5120);
        else if (sec == 12 || sec == 13) unary<2>(acc, row0, wc, fq, GB, 1024, c0 - 6144);
        else if (sec == 1) { const int cb = c0 - 512 + wc * 32 + 8 * fq;
#pragma unroll
            for (int ai = 0; ai < 2; ++ai)
#pragma unroll
                for (int m = 0; m < 4; ++m) { const int row = row0 + ai * 128 + m * 16; float* rowp = LF + (size_t)row * 512 + cb;
#pragma unroll
                    for (int bj = 0; bj < 2; ++bj)
#pragma unroll
                        for (int n = 0; n < 2; ++n) { const f32x4 l4 = *(const f32x4*)(lb + cb + bj * 128 + 4 * n); const f32x4 v = acc[ai][bj][m][n]; f32x4 o;
                            for (int j = 0; j < 4; ++j) { const float e = (1.f - l4[j]) * __builtin_amdgcn_rcpf(1.f + __builtin_amdgcn_exp2f(1.4426950408889634f * v[j])); o[j] = __logf(1.f - e); }
                            *(f32x4*)(rowp + bj * 128 + 4 * n) = o; }
                    asm volatile("" ::: "memory"); } }
        else { const bool isk = sec == 5; bf16_t* dst = isk ? RK : RQ; const int cbase = c0 - (isk ? 2560 : 2048);
            float invrev[4];
#pragma unroll
            for (int q = 0; q < 4; ++q) invrev[q] = exp2f(-(float)(wc * 16 + 4 * fq + q) * (13.287712379549449f / 64.f)) * 0.15915494309189535f;
            const int hd0 = cbase >> 7; const float lg0 = gamma_lg(hd0), lg1 = gamma_lg(hd0 + 1);
#pragma unroll
            for (int ai = 0; ai < 2; ++ai)
#pragma unroll
                for (int m = 0; m < 4; ++m) { const int row = row0 + ai * 128 + m * 16; const int t = row & (SEQ - 1), tm = t & 127;
                    bf16_t* rowp = dst + (size_t)row * 512 + cbase + wc * 32 + 8 * fq; float sn[4], cs[4];
#pragma unroll
                    for (int q = 0; q < 4; ++q) { float r = (float)t * invrev[q]; r = r - floorf(r); sn[q] = __builtin_amdgcn_sinf(r); cs[q] = __builtin_amdgcn_cosf(r); }
#pragma unroll
                    for (int bj = 0; bj < 2; ++bj) { const float lg = bj ? lg1 : lg0; const float sc = isk ? __expf(-(float)tm * lg) : 0.08838834764831845f * __expf((float)tm * lg);
                        const f32x4 v0 = acc[ai][bj][m][0], v1 = acc[ai][bj][m][1]; float o[8];
                        o[0] = (v0[0] * cs[0] - v0[1] * sn[0]) * sc; o[1] = (v0[0] * sn[0] + v0[1] * cs[0]) * sc; o[2] = (v0[2] * cs[1] - v0[3] * sn[1]) * sc; o[3] = (v0[2] * sn[1] + v0[3] * cs[1]) * sc;
                        o[4] = (v1[0] * cs[2] - v1[1] * sn[2]) * sc; o[5] = (v1[0] * sn[2] + v1[1] * cs[2]) * sc; o[6] = (v1[2] * cs[3] - v1[3] * sn[3]) * sc; o[7] = (v1[2] * sn[3] + v1[3] * cs[3]) * sc;
                        pg8::u32x4 w; w.x = pk2(o[0], o[1]); w.y = pk2(o[2], o[3]); w.z = pk2(o[4], o[5]); w.w = pk2(o[6], o[7]);
                        *(pg8::u32x4*)(rowp + bj * 128) = w; }
                    asm volatile("" ::: "memory"); } }
    }
};
struct EpiDry { static constexpr bool PERM = true, AFTER_DRAIN = false;
    __device__ __forceinline__ void operator()(const f32x4 (&acc)[2][2][4][2], const Unit&, int, int, int, int) const {
#pragma unroll
        for (int a = 0; a < 2; ++a)
#pragma unroll
            for (int b = 0; b < 2; ++b)
#pragma unroll
                for (int m = 0; m < 4; ++m)
#pragma unroll
                    for (int n = 0; n < 2; ++n) asm volatile("" :: "v"(acc[a][b][m][n])); }
};
struct EpiGateMul {
    const bf16_t* G; bf16_t* T;
    __device__ __forceinline__ void operator()(const Unit&, int m, int c, f32x4 v) const { const f32x4 g = ld4bf(G + (size_t)m * 1024 + c); st4bf(T + (size_t)m * 1024 + c, g * v); }
};
struct EpiGateMulAdd {
    const bf16_t* G; bf16_t* T;
    __device__ __forceinline__ void operator()(const Unit&, int m, int c, f32x4 v) const { const f32x4 g = ld4bf(G + (size_t)m * 1024 + c); const f32x4 t = ld4bf(T + (size_t)m * 1024 + c); st4bf(T + (size_t)m * 1024 + c, t + g * v); }
};
struct EpiResid {
    const float* x; float* out; bf16_t* H2;
    __device__ __forceinline__ void operator()(const Unit&, int m, int c, f32x4 v) const { const f32x4 r = *(const f32x4*)(x + (size_t)m * 1024 + c) + v; *(f32x4*)(out + (size_t)m * 1024 + c) = r; st4bf(H2 + (size_t)m * 1024 + c, r); }
};
struct EpiStoreBf {
    bf16_t* T;
    __device__ __forceinline__ void operator()(const Unit&, int m, int c, f32x4 v) const { st4bf(T + (size_t)m * 1024 + c, v); }
};
struct EpiPle {
    const bf16_t* PP; float* x;
    __device__ __forceinline__ void operator()(const Unit&, int m, int c, f32x4 v) const { const f32x4 pp = ld4bf(PP + (size_t)m * 1024 + c); f32x4 r = *(const f32x4*)(x + (size_t)m * 1024 + c);
        for (int j = 0; j < 4; ++j) r[j] += sigmf(v[j]) * pp[j]; *(f32x4*)(x + (size_t)m * 1024 + c) = r; }
};
struct EpiGateUp {
    const PG8_LAS int* rowinfo; bf16_t* HM;
    __device__ __forceinline__ void pair(const Unit& u, int pos, int c, f32x4 g, f32x4 up) const { const float rs = ((const PG8_LAS float*)rowinfo)[u.ui * 512 + 256 + (pos & 255)];
        f32x4 o; for (int j = 0; j < 4; ++j) o[j] = siluf(g[j] * rs) * (up[j] * rs); st4bf(HM + (size_t)pos * 256 + c, o); }
};
struct EpiDown {
    const PG8_LAS int* rowinfo; bf16_t* YS;
    __device__ __forceinline__ void operator()(const Unit& u, int pos, int c, f32x4 v) const { const int r = pos & 255; const int a = rowinfo[u.ui * 512 + r]; if (a < 0) return;
        const float w = ((const PG8_LAS float*)rowinfo)[u.ui * 512 + 256 + r]; st4bf(YS + (size_t)a * 1024 + c, v * w); }
};

constexpr int NWAVES = 8;
constexpr int RING_BYTES = 131072, EXTRA_OFF = 131072, LDSCTL_OFF = EXTRA_OFF, MISC_OFF = EXTRA_OFF + 320, OFFS_OFF = EXTRA_OFF + 512, TILEE_OFF = EXTRA_OFF + 1024, ROWINFO_OFF = EXTRA_OFF + 2048;
constexpr int LDS_BYTES = ROWINFO_OFF + 8 * 2048;
constexpr int CW_BAR = 4096;
#ifndef MK_PER_PHASE
#define MK_PER_PHASE 0
#endif
constexpr int N_PHASES = 13;
#ifndef MK_NAIVE_MIX
#define MK_NAIVE_MIX 0
#endif

struct Args { const float* in[22]; float* out; unsigned char* ws; int ph_lo, ph_hi; };

struct Ctx {
    LAS unsigned char* lds; int vcu, G, wave_s;
    const float* const* in; float* out; unsigned char* ws;
};
#define CIN(i) (C.in[i])
#define WSP(T, off) ((T*)(C.ws + (off)))

template <int MODE>
__device__ __forceinline__ void transpose_item(const float* W, int K, int N, bf16_t* WT, int row_off, LAS float* scr, int item, int lane, const float* gain) {
    const int nblk = N / 32, kb = item / nblk, nb = item % nblk, k0 = 64 * kb, n0 = 32 * nb;
    int nsrc = n0 + (lane & 31);
    if (MODE == 1) { if (nsrc >= 2048 && nsrc < 3072) { const int base = nsrc & ~127, w = nsrc & 127; nsrc = base + (w >> 1) + 64 * (w & 1); } }
    float wv[32];
#pragma unroll
    for (int i = 0; i < 32; ++i) { const int kk = 2 * i + (lane >> 5); wv[i] = W[(size_t)(k0 + kk) * N + nsrc]; }
    const float g0 = gain ? gain[k0 + (lane & 63)] : 1.f;
#pragma unroll
    for (int i = 0; i < 32; ++i) { const int kk = 2 * i + (lane >> 5); scr[kk * 33 + (lane & 31)] = wv[i] * __shfl(g0, kk); }
    LDS_WAIT(); asm volatile("" ::: "memory");
    const int c = lane & 7;
#pragma unroll
    for (int j = 0; j < 4; ++j) { const int n = (lane >> 3) + 8 * j; const LAS float* s = scr + (8 * c) * 33 + n;
        v4u o; o.x = pk2(s[0 * 33], s[1 * 33]); o.y = pk2(s[2 * 33], s[3 * 33]); o.z = pk2(s[4 * 33], s[5 * 33]); o.w = pk2(s[6 * 33], s[7 * 33]);
        int drow = row_off + n0 + n; if (MODE == 2) { const int nc = n0 + n; drow = row_off + 256 * (nc >> 7) + (nc & 127); }
        *(GAS v4u*)(WT + (size_t)drow * K + k0 + 8 * c) = o; }
    LDS_WAIT(); asm volatile("" ::: "memory");
}
__device__ __forceinline__ void p0_prologue(const Ctx& C) {
    const int T_tid = tid_opaque(C.wave_s), T_lane = T_tid & 63, T_wave = C.wave_s; (void)T_lane; (void)T_wave;
    LAS float* scr = (LAS float*)(C.lds + T_wave * 16384);
    const int gw = C.vcu * NWAVES + T_wave, NGW = C.G * NWAVES;
    constexpr int I_IN = 16 * (NIN / 32), I_A = 8 * 32, I_SQ = 16 * 32, I_PP = 4 * 32;
    constexpr int NIT = I_IN + I_A + 3 * I_SQ + I_PP;
    for (int it = gw; it < NIT; it += NGW) { int r = it;
        if (r < I_IN) { transpose_item<1>(CIN(3), 1024, NIN, WSP(bf16_t, WS_WIN), 0, scr, r, T_lane, CIN(2)); continue; } r -= I_IN;
        if (r < I_A) { transpose_item<0>(CIN(7), 512, 1024, WSP(bf16_t, WS_WA), 0, scr, r, T_lane, nullptr); continue; } r -= I_A;
        if (r < I_SQ) { transpose_item<0>(CIN(8), 1024, 1024, WSP(bf16_t, WS_WB), 0, scr, r, T_lane, nullptr); continue; } r -= I_SQ;
        if (r < I_SQ) { transpose_item<0>(CIN(9), 1024, 1024, WSP(bf16_t, WS_WO), 0, scr, r, T_lane, nullptr); continue; } r -= I_SQ;
        if (r < I_SQ) { transpose_item<0>(CIN(19), 1024, 1024, WSP(bf16_t, WS_WPG), 0, scr, r, T_lane, CIN(18)); continue; } r -= I_SQ;
        transpose_item<0>(CIN(20), 256, 1024, WSP(bf16_t, WS_WPP), 0, scr, r, T_lane, nullptr);
    }
    { bf16_t* XB = (bf16_t*)C.out; float* rs1 = (float*)(C.ws + WS_SMALL + SM_RS1); const float* x = CIN(0);
      for (int m = gw; m < M; m += NGW) { const f32x4* xr = (const f32x4*)(x + (size_t)m * D) + T_lane; f32x4 v[4]; float s = 0.f;
#pragma unroll
        for (int j = 0; j < 4; ++j) { v[j] = xr[64 * j]; s += (v[j][0] * v[j][0] + v[j][1] * v[j][1]) + (v[j][2] * v[j][2] + v[j][3] * v[j][3]); }
        s = wave_sum(s); const float rs = rsqrtf(s * (1.f / D) + EPS); if (T_lane == 0) rs1[m] = rs;
#pragma unroll
        for (int j = 0; j < 4; ++j) st4bf(XB + (size_t)m * D + T_lane * 4 + 256 * j, v[j] * rs); } }
    { const f32x4* p4 = (const f32x4*)CIN(1); bf16_t* PB = WSP(bf16_t, WS_PB); const int gt = C.vcu * 512 + T_tid, NT = C.G * 512;
      for (int i = gt; i < M * PLE / 4; i += NT) st4bf(PB + (size_t)i * 4, p4[i]); }
    if (C.vcu == 1) { float* WR = WSP(float, WS_WR); const float* g2 = CIN(10); const float* wrg = CIN(11); const float* wre = CIN(13);
        for (int i = T_tid; i < 1024 * 48; i += 512) { const int k = i / 48, c = i - k * 48; WR[i] = c < 4 ? g2[k] * wrg[k * 4 + c] : (c < 36 ? g2[k] * wre[k * 32 + (c - 4)] : 0.f); } }
    if (C.vcu == 0) { float* lb = (float*)(C.ws + WS_SMALL + SM_LB); const float* l = CIN(4); const float l0 = l[T_tid], l1 = l[512 + T_tid]; lb[T_tid] = 1.f / (1.f + __expf(l1 - l0)); }
}
__device__ __forceinline__ void p2_naive_hgrn(const Ctx& C, int bh) {
    const int T_tid = tid_opaque(C.wave_s), T_lane = T_tid & 63, T_wave = C.wave_s; (void)T_lane; (void)T_wave;
    const bf16_t* QH = WSP(bf16_t, WS_QH); const bf16_t* VH = WSP(bf16_t, WS_VH); bf16_t* GH = WSP(bf16_t, WS_GH); const float* LF = (const float*)((unsigned char*)C.out + 32 * MiB); const float* hg_norm = CIN(5);
    LAS float* sh = (LAS float*)C.lds; const int b = bh >> 2, h = bh & 3, v = T_tid & 127; const bool act = T_tid < 128;
    float S[128];
#pragma unroll
    for (int k = 0; k < 128; ++k) S[k] = 0.f;
    const float gn = hg_norm[v];
    for (int t = 0; t < SEQ; ++t) { const size_t o512 = (size_t)(b * SEQ + t) * 512 + h * 128 + v; float vv = 0.f;
        if (act) { const float lf = LF[o512]; sh[v] = bf2f(QH[o512]); sh[128 + v] = __expf(lf); sh[256 + v] = -expm1f(lf); vv = bf2f(VH[o512]); }
        __syncthreads();
        float o = 0.f;
        if (act) {
#pragma unroll
            for (int k = 0; k < 128; ++k) { S[k] = sh[128 + k] * S[k] + sh[256 + k] * vv; o += sh[k] * S[k]; if ((k & 15) == 15) asm volatile("" ::: "memory"); } }
        const float ss = wave_sum(o * o); if (act && (v & 63) == 0) sh[384 + (v >> 6)] = ss;
        __syncthreads();
        if (act) { const float tot = sh[384] + sh[385]; const float y = o * rsqrtf(tot * (1.f / 128.f) + EPS) * gn * bf2f(GH[o512]); GH[o512] = (bf16_t)f2bf(y); }
    }
}
__device__ __forceinline__ void p2_naive_ret(const Ctx& C, int bh) {
    const int T_tid = tid_opaque(C.wave_s), T_lane = T_tid & 63, T_wave = C.wave_s; (void)T_lane; (void)T_wave;
    const bf16_t* RQ = WSP(bf16_t, WS_RQ); const bf16_t* RK = WSP(bf16_t, WS_RK); const bf16_t* RV = WSP(bf16_t, WS_RV); bf16_t* RG = WSP(bf16_t, WS_RG); const float* ret_norm = CIN(6);
    LAS float* sh = (LAS float*)C.lds; const int b = bh >> 2, h = bh & 3, v = T_tid & 255; const bool act = T_tid < 256;
    float S[128];
#pragma unroll
    for (int k = 0; k < 128; ++k) S[k] = 0.f;
    const float gn = ret_norm[v]; const float lg = gamma_lg(h), gam = __expf(lg);
    for (int t = 0; t < SEQ; ++t) { const size_t m = (size_t)(b * SEQ + t); const int tm = t & 127; float vv = 0.f;
        if (T_tid < 128) { sh[v] = bf2f(RQ[m * 512 + h * 128 + v]) * __expf(-(float)tm * lg); sh[128 + v] = bf2f(RK[m * 512 + h * 128 + v]) * __expf((float)tm * lg); }
        if (act) vv = bf2f(RV[m * 1024 + h * 256 + v]);
        __syncthreads();
        float o = 0.f;
        if (act) {
#pragma unroll
            for (int k = 0; k < 128; ++k) { S[k] = gam * S[k] + sh[128 + k] * vv; o += sh[k] * S[k]; if ((k & 15) == 15) asm volatile("" ::: "memory"); } }
        const float ss = wave_sum(o * o); if (act && (v & 63) == 0) sh[384 + (v >> 6)] = ss;
        __syncthreads();
        if (act) { const float tot = (sh[384] + sh[385]) + (sh[386] + sh[387]); const size_t oi = m * 1024 + h * 256 + v;
            const float y = o * rsqrtf(tot * (1.f / 256.f) + EPS) * gn * bf2f(RG[oi]); RG[oi] = (bf16_t)f2bf(y); }
    }
}
__device__ __forceinline__ void p6_router(const Ctx& C, gu32* ctl) {
    const int T_tid = tid_opaque(C.wave_s), T_lane = T_tid & 63, T_wave = C.wave_s; (void)T_lane; (void)T_wave;
    const int gw = C.vcu * NWAVES + T_wave, NGW = C.G * NWAVES;
    { LAS float* scr = (LAS float*)(C.lds + T_wave * 16384);
      constexpr int I_G = 16 * 8, I_D = 4 * 32, PER_E = 2 * I_G + I_D;
      for (int rep7_ = 0; rep7_ < (MK_DUP == 70 ? 2 : 1); ++rep7_)
      for (int it = gw; it < NE * PER_E; it += NGW) { const int e = it / PER_E; int r = it - e * PER_E;
          if (r < I_G) { transpose_item<2>(CIN(15) + (size_t)e * 1024 * 256, 1024, 256, WSP(bf16_t, WS_WGU), e * 512, scr, r, T_lane, CIN(10)); continue; } r -= I_G;
          if (r < I_G) { transpose_item<2>(CIN(16) + (size_t)e * 1024 * 256, 1024, 256, WSP(bf16_t, WS_WGU), e * 512 + 128, scr, r, T_lane, CIN(10)); continue; } r -= I_G;
          transpose_item<0>(CIN(17) + (size_t)e * 256 * 1024, 256, 1024, WSP(bf16_t, WS_WD), e * 1024, scr, r, T_lane, nullptr); } }
    const float* X1 = C.out; const float* WR = WSP(float, WS_WR); const float* brg = CIN(12); const float* bre = CIN(14);
    float* rs2 = (float*)(C.ws + WS_SMALL + SM_RS2); float* wgt = (float*)(C.ws + WS_SMALL + SM_WGT); int* list = WSP(int, WS_LIST); gu32* cnt = ctl + CW_CNT;
    const int fr = T_lane & 15, fq = T_lane >> 4, tile = T_wave & 3, kh = T_wave >> 2;
    constexpr int WST = 52, WCH = 2 * 128 * WST;
    LAS float* wbuf = (LAS float*)(C.lds);
    LAS float* xacc = (LAS float*)(C.lds + 106496);
    LAS float* lgt = (LAS float*)(C.lds + 106496 + 12288);
    LAS float* xss = (LAS float*)(C.lds + ROWINFO_OFF);
    LAS unsigned* hist = (LAS unsigned*)(C.lds + ROWINFO_OFF + 256); LAS unsigned* hbase = hist + 32;
    __syncthreads();
    if (T_tid < NE) hist[T_tid] = 0u;
    for (int tb = C.vcu; tb < M / 64; tb += C.G) {
        const int m = tb * 64 + tile * 16 + fr; int e1 = 0, e2 = 0, r1 = 0, r2 = 0; bool sel = false;
        const float* xr = X1 + (size_t)m * D + kh * 512 + 4 * fq;
        f32x4 xc[8], xn[8];
#pragma unroll
        for (int j = 0; j < 8; ++j) xc[j] = *(const f32x4*)(xr + 16 * j);
        f32x4 wreg[6];
#define RT_LOADW(cs_) do { _Pragma("unroll") for (int q = 0; q < 6; ++q) { const int pc = T_tid + 512 * q, row = pc / 12, c4 = pc - row * 12; \
            wreg[q] = *(const f32x4*)(WR + (size_t)((row >> 7) * 512 + (cs_) * 128 + (row & 127)) * 48 + 4 * c4); } } while (0)
#define RT_STOREW(buf_) do { _Pragma("unroll") for (int q = 0; q < 6; ++q) { const int pc = T_tid + 512 * q, row = pc / 12, c4 = pc - row * 12; \
            *(LAS f32x4*)(wbuf + (buf_) * WCH + row * WST + 4 * c4) = wreg[q]; } } while (0)
        RT_LOADW(0); RT_STOREW(0);
        f32x4 acc[3]; acc[0] = acc[1] = acc[2] = (f32x4){0.f, 0.f, 0.f, 0.f}; float ss = 0.f;
        __syncthreads();
#pragma unroll
        for (int cs = 0; cs < 4; ++cs) {
            if (cs + 1 < 4) { RT_LOADW(cs + 1);
#pragma unroll
                for (int j = 0; j < 8; ++j) xn[j] = *(const f32x4*)(xr + 16 * ((cs + 1) * 8 + j)); }
            const LAS float* wb = wbuf + (cs & 1) * WCH + (kh * 128 + 4 * fq) * WST + fr;
#pragma unroll
            for (int jj = 0; jj < 8; ++jj) { const f32x4 x4 = xc[jj]; ss += (x4[0] * x4[0] + x4[1] * x4[1]) + (x4[2] * x4[2] + x4[3] * x4[3]);
#pragma unroll
                for (int i = 0; i < 4; ++i)
#pragma unroll
                    for (int nt = 0; nt < 3; ++nt) acc[nt] = __builtin_amdgcn_mfma_f32_16x16x4f32(x4[i], wb[(16 * jj + i) * WST + 16 * nt], acc[nt], 0, 0, 0); }
            if (cs + 1 < 4) { RT_STOREW((cs + 1) & 1); __syncthreads();
#pragma unroll
                for (int j = 0; j < 8; ++j) xc[j] = xn[j]; }
        }
#undef RT_LOADW
#undef RT_STOREW
        ss += __shfl_xor(ss, 16); ss += __shfl_xor(ss, 32);
        if (kh == 1) {
#pragma unroll
            for (int nt = 0; nt < 3; ++nt) *(LAS f32x4*)(xacc + ((tile * 3 + nt) * 64 + T_lane) * 4) = acc[nt];
            if (fq == 0) xss[tile * 16 + fr] = ss; }
        __syncthreads();
        if (kh == 0) {
#pragma unroll
            for (int nt = 0; nt < 3; ++nt) { acc[nt] = acc[nt] + *(const LAS f32x4*)(xacc + ((tile * 3 + nt) * 64 + T_lane) * 4);
#pragma unroll
                for (int r = 0; r < 4; ++r) lgt[(tile * 16 + 4 * fq + r) * 48 + 16 * nt + fr] = acc[nt][r]; }
            ss += xss[tile * 16 + fr];
            asm volatile("s_waitcnt lgkmcnt(0)" ::: "memory");
            if (T_lane < 16) { const int mt = tb * 64 + tile * 16 + T_lane; const float rs = rsqrtf(ss * (1.f / D) + EPS); rs2[mt] = rs;
                float lg[36];
#pragma unroll
                for (int c4 = 0; c4 < 9; ++c4) { const f32x4 q4 = *(const LAS f32x4*)(lgt + (tile * 16 + T_lane) * 48 + 4 * c4); lg[4 * c4] = q4[0] * rs; lg[4 * c4 + 1] = q4[1] * rs; lg[4 * c4 + 2] = q4[2] * rs; lg[4 * c4 + 3] = q4[3] * rs; }
                float gl[4];
#pragma unroll
                for (int c = 0; c < 4; ++c) gl[c] = lg[c] + brg[c];
                float gmax = gl[0]; int gi = 0;
#pragma unroll
                for (int c = 1; c < 4; ++c) if (gl[c] > gmax) { gmax = gl[c]; gi = c; }
                float den = 0.f;
#pragma unroll
                for (int c = 0; c < 4; ++c) den += __expf(gl[c] - gmax);
                const float gw_ = 1.f / den;
                float el[8];
#pragma unroll
                for (int c = 0; c < 8; ++c) { el[c] = 0.f;
#pragma unroll
                    for (int g = 0; g < 4; ++g) if (g == gi) el[c] = lg[4 + g * 8 + c] + bre[g * 8 + c]; }
                float m1 = el[0]; int i1 = 0;
#pragma unroll
                for (int c = 1; c < 8; ++c) if (el[c] > m1) { m1 = el[c]; i1 = c; }
                float m2 = -3.0e38f; int i2 = 0;
#pragma unroll
                for (int c = 0; c < 8; ++c) if (c != i1 && el[c] > m2) { m2 = el[c]; i2 = c; }
                const float w1 = 1.f / (1.f + __expf(m2 - m1)), w2 = 1.f - w1;
                e1 = gi * 8 + i1; e2 = gi * 8 + i2; sel = true;
                wgt[2 * mt] = w1 * gw_; wgt[2 * mt + 1] = w2 * gw_;
                r1 = (int)__hip_atomic_fetch_add(hist + e1, 1u, __ATOMIC_RELAXED, __HIP_MEMORY_SCOPE_WORKGROUP);
                r2 = (int)__hip_atomic_fetch_add(hist + e2, 1u, __ATOMIC_RELAXED, __HIP_MEMORY_SCOPE_WORKGROUP); } }
        __syncthreads();
        if (T_tid < NE) { const unsigned n = hist[T_tid]; hbase[T_tid] = n ? __hip_atomic_fetch_add(cnt + 64 * T_tid, n, __ATOMIC_RELAXED, __HIP_MEMORY_SCOPE_AGENT) : 0u; }
        __syncthreads();
        if (sel) { const int mt = tb * 64 + tile * 16 + T_lane; list[e1 * LIST_CAP + (int)hbase[e1] + r1] = 2 * mt; list[e2 * LIST_CAP + (int)hbase[e2] + r2] = 2 * mt + 1; }
        __syncthreads();
        if (T_tid < NE) hist[T_tid] = 0u;
    }
}
__device__ __forceinline__ int moe_plan(const Ctx& C, gu32* ctl) {
    const int T_tid = tid_opaque(C.wave_s), T_lane = T_tid & 63, T_wave = C.wave_s; (void)T_lane; (void)T_wave;
    LAS int* offs = (LAS int*)(C.lds + OFFS_OFF); LAS int* tile_e = (LAS int*)(C.lds + TILEE_OFF);
    if (T_tid < NE) offs[33 + T_tid] = (int)__hip_atomic_load(ctl + CW_CNT + 64 * T_tid, __ATOMIC_RELAXED, __HIP_MEMORY_SCOPE_AGENT);
    __syncthreads();
    if (T_tid == 0) { int o = 0;
        for (int e = 0; e < NE; ++e) { const int c = offs[33 + e]; offs[e] = o; const int np = (c + 255) & ~255;
            for (int t = 0; t < np; t += 256) tile_e[(o + t) >> 8] = e; o += np; }
        offs[32] = o; }
    __syncthreads();
    return offs[32] >> 8;
}
template <bool WANT_RS> __device__ __forceinline__ void moe_rowinfo(const Ctx& C, const pg8::GroupOrder& S) {
    const int T_tid = tid_opaque(C.wave_s), T_lane = T_tid & 63, T_wave = C.wave_s; (void)T_lane; (void)T_wave;
    LAS int* offs = (LAS int*)(C.lds + OFFS_OFF); LAS int* tile_e = (LAS int*)(C.lds + TILEE_OFF); LAS int* ri = (LAS int*)(C.lds + ROWINFO_OFF);
    const int* list = WSP(int, WS_LIST); const float* wgt = (const float*)(C.ws + WS_SMALL + SM_WGT); const float* rs2 = (const float*)(C.ws + WS_SMALL + SM_RS2);
    pg8::Unit u;
    for (int i = 0; i < 8 && S.next(i, u); ++i) {
        if (T_tid < 256) { const int e = tile_e[u.pm], idx = u.pm * 256 + T_tid - offs[e]; int a = -1; float w = 0.f;
            if (idx < offs[33 + e]) { a = list[e * LIST_CAP + idx]; w = WANT_RS ? rs2[a >> 1] : wgt[a]; }
            ri[i * 512 + T_tid] = a; ((LAS float*)ri)[i * 512 + 256 + T_tid] = w; } }
    __syncthreads();
}
__device__ __forceinline__ void p9_combine(const Ctx& C) {
    const int T_tid = tid_opaque(C.wave_s), T_lane = T_tid & 63, T_wave = C.wave_s; (void)T_lane; (void)T_wave;
    const int gw = C.vcu * NWAVES + T_wave, NGW = C.G * NWAVES; float* X = C.out; const bf16_t* YS = WSP(bf16_t, WS_YS); bf16_t* X2B = WSP(bf16_t, WS_X2B);
    for (int m = gw; m < M; m += NGW) { const int lane = T_lane;
        f32x4* xr = (f32x4*)(X + (size_t)m * D) + lane; f32x4 v[4]; float s = 0.f;
#pragma unroll
        for (int j = 0; j < 4; ++j) { const int c = lane * 4 + 256 * j; v[j] = xr[64 * j] + ld4bf(YS + (size_t)(2 * m) * D + c) + ld4bf(YS + (size_t)(2 * m + 1) * D + c);
            s += (v[j][0] * v[j][0] + v[j][1] * v[j][1]) + (v[j][2] * v[j][2] + v[j][3] * v[j][3]); }
        s = wave_sum(s); const float rs = rsqrtf(s * (1.f / D) + EPS);
#pragma unroll
        for (int j = 0; j < 4; ++j) { xr[64 * j] = v[j]; st4bf(X2B + (size_t)m * D + lane * 4 + 256 * j, v[j] * rs); } }
}
__device__ __forceinline__ void p11_final(const Ctx& C, const float oscale) {
    const int T_tid = tid_opaque(C.wave_s), T_lane = T_tid & 63, T_wave = C.wave_s; (void)T_lane; (void)T_wave;
    const int gw = C.vcu * NWAVES + T_wave, NGW = C.G * NWAVES; float* X = C.out; const float* g = CIN(21);
    for (int m = gw; m < M; m += NGW) { const int lane = T_lane;
        f32x4* xr = (f32x4*)(X + (size_t)m * D) + lane; f32x4 v[4]; float s = 0.f;
#pragma unroll
        for (int j = 0; j < 4; ++j) { v[j] = xr[64 * j]; s += (v[j][0] * v[j][0] + v[j][1] * v[j][1]) + (v[j][2] * v[j][2] + v[j][3] * v[j][3]); }
        s = wave_sum(s); const float rs = rsqrtf(s * (1.f / D) + EPS);
#pragma unroll
        for (int j = 0; j < 4; ++j) { const f32x4 gg = *(const f32x4*)(g + lane * 4 + 256 * j); xr[64 * j] = v[j] * (rs * oscale) * gg; } }
}

__device__ __forceinline__ int rho(int p) { return (p & ~31) | (((p >> 2) & 1) << 4) | (((p >> 3) & 3) << 2) | (p & 3); }
constexpr int MX_QL = 0, MX_KL = 17408, MX_KT = 34816, MX_VT = 53248, MX_PL = 90112, MX_CH = 99328, MX_SSQ = 102912, MX_INV = 104960;
constexpr int QSTR = 272, TSTR = 144;
constexpr size_t OUT_UH = 0, OUT_UR = 8 * MiB;
constexpr size_t SM_DH = SM_RS3;
typedef pg8::bf16x8 bfx8;
#define MFMA16(a, b, c) __builtin_amdgcn_mfma_f32_16x16x32_bf16((a), (b), (c), 0, 0, 0)
#define LDS_B128(off) (*(const LAS bfx8*)(lds + (off)))

template <int NT, bool HG, bool STATE_ONLY>
__device__ __forceinline__ void mixer_unit(const Ctx& C, const int b, const int h, const int seg) {
    const int tid0 = tid_opaque(C.wave_s), w = C.wave_s;
    LAS unsigned char* lds = C.lds;
    constexpr int DV = NT * 128, LDV = HG ? 512 : 1024;
    const int bh = b * 4 + h, unit = bh * 16 + seg, m0 = b * SEQ + seg * 512;
    const bf16_t* Qg = WSP(bf16_t, HG ? WS_QH : WS_RQ) + h * 128; const bf16_t* Kg = WSP(bf16_t, WS_RK) + h * 128;
    const bf16_t* Vg = WSP(bf16_t, HG ? WS_VH : WS_RV) + h * DV; bf16_t* Gg = WSP(bf16_t, HG ? WS_GH : WS_RG) + h * DV;
    const float* LFg = (const float*)((unsigned char*)C.out + 32 * MiB) + h * 128;
    float* Ug = (float*)((unsigned char*)C.out + (HG ? OUT_UH : OUT_UR)) + (size_t)unit * 128 * DV;
    float* DHg = (float*)(C.ws + WS_SMALL + SM_DH) + unit * 128;
    const float* gn = HG ? CIN(5) : CIN(6);
    const float lgam = gamma_lg(h), g128 = __expf(128.f * lgam);
    LAS float* ch_emid = (LAS float*)(lds + MX_CH); LAS float* ch_elm = ch_emid + 128; LAS float* ch_dl = ch_emid + 256; LAS float* ch_part = ch_emid + 384;
    LAS float* ssq = (LAS float*)(lds + MX_SSQ); LAS float* invs = (LAS float*)(lds + MX_INV);

    f32x4 S[8][NT];
    { const int lane = tid0 & 63, fr = lane & 15, fq = lane >> 4;
#pragma unroll
    for (int kt = 0; kt < 8; ++kt)
#pragma unroll
        for (int nt = 0; nt < NT; ++nt) {
            if (STATE_ONLY) S[kt][nt] = (f32x4){0.f, 0.f, 0.f, 0.f};
            else { const float* up = Ug + (size_t)(16 * kt + 4 * fq) * DV + 16 * (w * NT + nt) + fr;
                S[kt][nt] = (f32x4){up[0], up[DV], up[2 * DV], up[3 * DV]}; } } }
    float bseg = 0.f;
    float lfr[16]; unsigned short qr16[16]; pg8::u32x4 qrw[2], krw[2], vrw[2 * NT];
#define MX_LOAD(cc) do { const int r0_ = m0 + 64 * (cc); int t_ = tid0; asm volatile("" : "+v"(t_)); const int hk = t_ & 127, hqd = t_ >> 7, lane = t_ & 63; \
        if (HG) { _Pragma("unroll") for (int i = 0; i < 16; ++i) { const size_t gi = (size_t)(r0_ + 16 * hqd + i) * 512 + hk; lfr[i] = LFg[gi]; if (!STATE_ONLY) qr16[i] = Qg[gi]; } } \
        else { _Pragma("unroll") for (int i = 0; i < 2; ++i) { const size_t gi = (size_t)(r0_ + lane) * 512 + (2 * w + i) * 8; if (!STATE_ONLY) qrw[i] = *(const pg8::u32x4*)(Qg + gi); krw[i] = *(const pg8::u32x4*)(Kg + gi); } } \
        _Pragma("unroll") for (int i = 0; i < 2 * NT; ++i) vrw[i] = *(const pg8::u32x4*)(Vg + (size_t)(r0_ + lane) * LDV + (2 * NT * w + i) * 8); } while (0)
    MX_LOAD(0);

    for (int c = 0; c < 8; ++c) {
        const int r0 = m0 + 64 * c;
        int tid = tid0; asm volatile("" : "+v"(tid));
        const int lane = tid & 63, fr = lane & 15, fq = lane >> 4, hk = tid & 127, hqd = tid >> 7;
        unsigned short gcur[16 * NT];
        if (HG) {
            const int k = hk, qd = hqd, rr = rho(k);
            float cs[16], qv[16], kk[16];
#pragma unroll
            for (int i = 0; i < 16; ++i) { cs[i] = lfr[i]; qv[i] = STATE_ONLY ? 0.f : bf2f(qr16[i]); }
#pragma unroll
            for (int i = 0; i < 16; ++i) kk[i] = 1.f - __expf(cs[i]);
#pragma unroll
            for (int i = 1; i < 16; ++i) cs[i] += cs[i - 1];
            ch_part[qd * 128 + k] = cs[15];
            __syncthreads();
            const float p0 = ch_part[k], p1 = ch_part[128 + k], p2 = ch_part[256 + k], p3 = ch_part[384 + k];
            const float off = (qd > 0 ? p0 : 0.f) + (qd > 1 ? p1 : 0.f) + (qd > 2 ? p2 : 0.f), bmid = p0 + p1, blast = (p0 + p1) + (p2 + p3);
            unsigned kb[16];
#pragma unroll
            for (int i = 0; i < 16; ++i) { const int t = 16 * qd + i; const float e1 = __expf(fminf(fmaxf(off + cs[i] - bmid, -80.f), 80.f)); const float kt_ = kk[i] * __builtin_amdgcn_rcpf(e1);
                kb[i] = f2bf(kt_);
                if (!STATE_ONLY) { *(LAS unsigned short*)(lds + MX_QL + t * QSTR + 2 * k) = (unsigned short)f2bf(qv[i] * e1); *(LAS unsigned short*)(lds + MX_KL + t * QSTR + 2 * k) = (unsigned short)kb[i]; } }
            { pg8::u32x4 w0, w1; w0.x = kb[0] | (kb[1] << 16); w0.y = kb[2] | (kb[3] << 16); w0.z = kb[4] | (kb[5] << 16); w0.w = kb[6] | (kb[7] << 16);
              w1.x = kb[8] | (kb[9] << 16); w1.y = kb[10] | (kb[11] << 16); w1.z = kb[12] | (kb[13] << 16); w1.w = kb[14] | (kb[15] << 16);
              *(LAS pg8::u32x4*)(lds + MX_KT + rr * TSTR + 32 * qd) = w0; *(LAS pg8::u32x4*)(lds + MX_KT + rr * TSTR + 32 * qd + 16) = w1; }
            if (qd == 0) { ch_emid[rr] = __expf(bmid); ch_elm[rr] = __expf(blast - bmid); ch_dl[rr] = __expf(blast); bseg += blast; }
        } else {
#pragma unroll
            for (int i = 0; i < 2; ++i) { const int pc = 2 * w + i;
                if (!STATE_ONLY) { *(LAS pg8::u32x4*)(lds + MX_QL + lane * QSTR + pc * 16) = qrw[i]; *(LAS pg8::u32x4*)(lds + MX_KL + lane * QSTR + pc * 16) = krw[i]; }
                const unsigned kwv[4] = {krw[i].x, krw[i].y, krw[i].z, krw[i].w};
#pragma unroll
                for (int j = 0; j < 8; ++j) { const unsigned short e = (unsigned short)(kwv[j >> 1] >> (16 * (j & 1))); *(LAS unsigned short*)(lds + MX_KT + rho(pc * 8 + j) * TSTR + 2 * lane) = e; } }
        }
#pragma unroll
        for (int i = 0; i < 2 * NT; ++i) { const int pc = 2 * NT * w + i; const unsigned vwv[4] = {vrw[i].x, vrw[i].y, vrw[i].z, vrw[i].w};
#pragma unroll
            for (int j = 0; j < 8; ++j) { const unsigned short e = (unsigned short)(vwv[j >> 1] >> (16 * (j & 1))); *(LAS unsigned short*)(lds + MX_VT + (pc * 8 + j) * TSTR + 2 * lane) = e; } }
        if (c + 1 < 8) MX_LOAD(c + 1);
        if (!STATE_ONLY) {
#pragma unroll
            for (int nt = 0; nt < NT; ++nt)
#pragma unroll
                for (int mt = 0; mt < 4; ++mt)
#pragma unroll
                    for (int r = 0; r < 4; ++r) gcur[(nt * 4 + mt) * 4 + r] = Gg[(size_t)(r0 + 16 * mt + 4 * fq + r) * LDV + 16 * (w * NT + nt) + fr]; }
        __syncthreads();

        f32x4 o[4][NT];
        if (!STATE_ONLY) {
#pragma unroll
            for (int i = 0; i < 2; ++i) { const int id = 2 * w + i, si = id >> 2, ti = id & 3; f32x4 a = (f32x4){0.f, 0.f, 0.f, 0.f};
                if (si <= ti) {
#pragma unroll
                    for (int ks = 0; ks < 4; ++ks) a = MFMA16(LDS_B128(MX_KL + (16 * si + fr) * QSTR + 64 * ks + 16 * fq), LDS_B128(MX_QL + (16 * ti + fr) * QSTR + 64 * ks + 16 * fq), a);
                    if (si == ti) {
#pragma unroll
                        for (int r = 0; r < 4; ++r) if (4 * fq + r > fr) a[r] = 0.f; } }
                u32x2 pw; pw.x = pk2(a[0], a[1]); pw.y = pk2(a[2], a[3]);
                *(LAS u32x2*)(lds + MX_PL + (16 * ti + fr) * TSTR + 2 * (16 * si + 4 * fq)) = pw; }
            __syncthreads();
#pragma unroll
            for (int mt = 0; mt < 4; ++mt)
#pragma unroll
                for (int nt = 0; nt < NT; ++nt) o[mt][nt] = (f32x4){0.f, 0.f, 0.f, 0.f};
#pragma unroll
            for (int ks = 0; ks < 4; ++ks) { bfx8 bf[NT];
#pragma unroll
                for (int nt = 0; nt < NT; ++nt) { f32x4 s0 = S[2 * ks][nt], s1 = S[2 * ks + 1][nt];
                    if (HG) { s0 = s0 * *(const LAS f32x4*)(ch_emid + 32 * ks + 4 * fq); s1 = s1 * *(const LAS f32x4*)(ch_emid + 32 * ks + 16 + 4 * fq); }
                    pg8::u32x4 pk; pk.x = pk2(s0[0], s0[1]); pk.y = pk2(s0[2], s0[3]); pk.z = pk2(s1[0], s1[1]); pk.w = pk2(s1[2], s1[3]); bf[nt] = __builtin_bit_cast(bfx8, pk); }
#pragma unroll
                for (int mt = 0; mt < 4; ++mt) { const bfx8 af = LDS_B128(MX_QL + (16 * mt + fr) * QSTR + 64 * ks + 16 * fq);
#pragma unroll
                    for (int nt = 0; nt < NT; ++nt) o[mt][nt] = MFMA16(af, bf[nt], o[mt][nt]); } }
#pragma unroll
            for (int ks = 0; ks < 2; ++ks) { bfx8 vf[NT];
#pragma unroll
                for (int nt = 0; nt < NT; ++nt) vf[nt] = LDS_B128(MX_VT + (16 * (w * NT + nt) + fr) * TSTR + 64 * ks + 16 * fq);
#pragma unroll
                for (int mt = 0; mt < 4; ++mt) { if (32 * ks > 16 * mt + 15) continue;
                    const bfx8 af = LDS_B128(MX_PL + (16 * mt + fr) * TSTR + 64 * ks + 16 * fq);
#pragma unroll
                    for (int nt = 0; nt < NT; ++nt) o[mt][nt] = MFMA16(af, vf[nt], o[mt][nt]); } }
        }
        if (HG) {
            f32x4 P[8][NT];
#pragma unroll
            for (int kt = 0; kt < 8; ++kt)
#pragma unroll
                for (int nt = 0; nt < NT; ++nt) P[kt][nt] = (f32x4){0.f, 0.f, 0.f, 0.f};
#pragma unroll
            for (int ks = 0; ks < 2; ++ks) { bfx8 vf[NT];
#pragma unroll
                for (int nt = 0; nt < NT; ++nt) vf[nt] = LDS_B128(MX_VT + (16 * (w * NT + nt) + fr) * TSTR + 64 * ks + 16 * fq);
#pragma unroll
                for (int kt = 0; kt < 8; ++kt) { const bfx8 af = LDS_B128(MX_KT + (16 * kt + fr) * TSTR + 64 * ks + 16 * fq);
#pragma unroll
                    for (int nt = 0; nt < NT; ++nt) P[kt][nt] = MFMA16(af, vf[nt], P[kt][nt]); } }
#pragma unroll
            for (int kt = 0; kt < 8; ++kt) { const f32x4 dl = *(const LAS f32x4*)(ch_dl + 16 * kt + 4 * fq), el = *(const LAS f32x4*)(ch_elm + 16 * kt + 4 * fq);
#pragma unroll
                for (int nt = 0; nt < NT; ++nt) S[kt][nt] = dl * S[kt][nt] + el * P[kt][nt]; }
        } else {
#pragma unroll
            for (int ks = 0; ks < 2; ++ks) { bfx8 vf[NT];
#pragma unroll
                for (int nt = 0; nt < NT; ++nt) vf[nt] = LDS_B128(MX_VT + (16 * (w * NT + nt) + fr) * TSTR + 64 * ks + 16 * fq);
#pragma unroll
                for (int kt = 0; kt < 8; ++kt) { const bfx8 af = LDS_B128(MX_KT + (16 * kt + fr) * TSTR + 64 * ks + 16 * fq);
#pragma unroll
                    for (int nt = 0; nt < NT; ++nt) S[kt][nt] = MFMA16(af, vf[nt], S[kt][nt]); } }
            if (c & 1) {
#pragma unroll
                for (int kt = 0; kt < 8; ++kt)
#pragma unroll
                    for (int nt = 0; nt < NT; ++nt) S[kt][nt] = S[kt][nt] * g128; }
        }
        if (!STATE_ONLY) {
#pragma unroll
            for (int mt = 0; mt < 4; ++mt)
#pragma unroll
                for (int r = 0; r < 4; ++r) { float q = 0.f;
#pragma unroll
                    for (int nt = 0; nt < NT; ++nt) q += o[mt][nt][r] * o[mt][nt][r];
                    q += __shfl_xor(q, 1); q += __shfl_xor(q, 2); q += __shfl_xor(q, 4); q += __shfl_xor(q, 8);
                    if (fr == 0) ssq[w * 64 + 16 * mt + 4 * fq + r] = q; }
            __syncthreads();
            if (tid < 64) { float tot = 0.f;
#pragma unroll
                for (int ww = 0; ww < 8; ++ww) tot += ssq[ww * 64 + tid];
                invs[tid] = rsqrtf(tot * (1.f / DV) + EPS); }
            __syncthreads();
#pragma unroll
            for (int nt = 0; nt < NT; ++nt) { const int v = 16 * (w * NT + nt) + fr; const float g = gn[v];
#pragma unroll
                for (int mt = 0; mt < 4; ++mt)
#pragma unroll
                    for (int r = 0; r < 4; ++r) { const int t = 16 * mt + 4 * fq + r; bf16_t* gp = Gg + (size_t)(r0 + t) * LDV + v;
                        *gp = (bf16_t)f2bf(o[mt][nt][r] * invs[t] * g * bf2f(gcur[(nt * 4 + mt) * 4 + r])); } }
        } else { __syncthreads(); }
    }
    if (STATE_ONLY) { const int tid = tid0, lane = tid & 63, fr = lane & 15, fq = lane >> 4;
#pragma unroll
        for (int kt = 0; kt < 8; ++kt)
#pragma unroll
            for (int nt = 0; nt < NT; ++nt) { float* up = Ug + (size_t)(16 * kt + 4 * fq) * DV + 16 * (w * NT + nt) + fr;
                up[0] = S[kt][nt][0]; up[DV] = S[kt][nt][1]; up[2 * DV] = S[kt][nt][2]; up[3 * DV] = S[kt][nt][3]; }
        if (HG && tid < 128) DHg[rho(tid)] = __expf(bseg);
    }
#undef MX_LOAD
}
__device__ __forceinline__ void mixer_scan(const Ctx& C) {
    const int tid = tid_opaque(C.wave_s); const int gt = C.vcu * 512 + tid;
    float* UH = (float*)((unsigned char*)C.out + OUT_UH); float* UR = (float*)((unsigned char*)C.out + OUT_UR); const float* DH = (const float*)(C.ws + WS_SMALL + SM_DH);
    { const int bh = gt >> 14, e = gt & 16383, row = e >> 7; float carry = 0.f;
      for (int s = 0; s < 16; ++s) { float* p = UH + ((size_t)(bh * 16 + s) << 14) + e; const float u = *p; *p = carry; carry = DH[(bh * 16 + s) * 128 + row] * carry + u; } }
#pragma unroll 1
    for (int i = 0; i < 2; ++i) { const int g2 = gt + i * 131072; const int bh = g2 >> 15, e = g2 & 32767; const float d = __expf(512.f * gamma_lg(bh & 3)); float carry = 0.f;
      for (int s = 0; s < 16; ++s) { float* p = UR + ((size_t)(bh * 16 + s) << 15) + e; const float u = *p; *p = carry; carry = d * carry + u; } }
}
template <bool STATE_ONLY> __device__ __forceinline__ void mixer_phase(const Ctx& C) {
    for (int uu = C.vcu; uu < 256; uu += C.G) { const int u = uu & 127, b = u >> 6, h = (u >> 4) & 3, seg = u & 15;
        if (uu < 128) mixer_unit<1, true, STATE_ONLY>(C, b, h, seg); else mixer_unit<2, false, STATE_ONLY>(C, b, h, seg); }
}

#ifndef MK_DRY1
#define MK_DRY1 0
#endif
#ifndef MK_STAG1
#define MK_STAG1 0
#define MK_STAGN 2
#endif
#ifndef MK_TS
#define MK_TS -1
#endif
#ifndef MK_TS_SCALE
#define MK_TS_SCALE 8e-3f
#endif
__global__ void __launch_bounds__(NWAVES * 64, 2) fwd(Args args) {
    extern __shared__ __attribute__((aligned(16))) unsigned char lds_raw[];
    Ctx C; C.lds = (LAS unsigned char*)lds_raw; C.wave_s = __builtin_amdgcn_readfirstlane((int)threadIdx.x >> 6);
    C.G = gridDim.x; { const int bx = blockIdx.x; C.vcu = (C.G % 8 == 0) ? (bx % 8) * (C.G / 8) + bx / 8 : bx; }
    C.in = args.in; C.out = args.out; C.ws = args.ws;
    gu32* ctl = (gu32*)(args.ws + WS_CTL);
    volatile LAS unsigned* MISC = (volatile LAS unsigned*)(C.lds + MISC_OFF);
    for (int u = threadIdx.x; u < (2048) / 4; u += NWAVES * 64) ((LAS unsigned*)(C.lds + LDSCTL_OFF))[u] = 0u;
    __syncthreads();
    XcdBarrier bar; bar.bar = (unsigned*)(ctl + CW_BAR); bar.x = 0; bar.st = nullptr;
    if (!MK_PER_PHASE) bar = xcd_barrier_post((unsigned*)(ctl + CW_BAR), MISC + 8);
    const int lo = args.ph_lo, hi = args.ph_hi;
    if (MK_TS >= 0 && blockIdx.x == 0 && threadIdx.x == 0) { volatile LAS unsigned long long* tsl_ = (volatile LAS unsigned long long*)(C.lds + MISC_OFF + 64); const unsigned long long now_ = __builtin_amdgcn_s_memrealtime(); tsl_[0] = now_; tsl_[1] = now_; tsl_[2] = now_; }
#define IN(k) (lo <= (k) && (k) < hi)
#define SEAM(k) do { if (MK_TS >= 0 && blockIdx.x == 0 && threadIdx.x == 0) { const unsigned long long now_ = __builtin_amdgcn_s_memrealtime(); \
        volatile LAS unsigned long long* tsl_ = (volatile LAS unsigned long long*)(C.lds + MISC_OFF + 64); if ((k) == MK_TS - 1) tsl_[1] = now_; if ((k) == MK_TS) tsl_[2] = now_; \
        if ((k) == 11) { const float frac_ = (float)(tsl_[2] - tsl_[1]) / (float)(now_ - tsl_[0]); __hip_atomic_store((float*)(ctl + 2048), sqrtf(frac_ * MK_TS_SCALE), __ATOMIC_RELAXED, __HIP_MEMORY_SCOPE_AGENT); } } \
    if (IN(k) && IN((k) + 1)) xcd_barrier(bar, C.wave_s); } while (0)

#define REPS(k) for (int rep_ = 0; rep_ < ((k) == MK_DUP ? 2 : 1); ++rep_)
#define REPBAR() do { if (rep_) xcd_barrier(bar, C.wave_s); } while (0)
    PG8_LAS unsigned char* ring = (PG8_LAS unsigned char*)C.lds;
    using namespace pg8;
    if (IN(0)) REPS(0) { REPBAR();  p0_prologue(C); } SEAM(0);
    if (IN(1)) REPS(1) { REPBAR();
#if MK_STAG1 > 0
        { const unsigned long long t0_ = __builtin_amdgcn_s_memrealtime(); const unsigned long long dl_ = (unsigned long long)((blockIdx.x >> 3) & (MK_STAGN - 1)) * MK_STAG1;
          while (__builtin_amdgcn_s_memrealtime() - t0_ < dl_) __builtin_amdgcn_s_sleep(8); }
#endif
        Gemm g{(const bf16_t*)C.out, WSP(bf16_t, WS_WIN), M, NIN, 1024}; DenseOrder S; S.init(M, NIN, C.G, (int)blockIdx.x);
        EpiP1 E{(const float*)(C.ws + WS_SMALL + SM_RS1), (const float*)(C.ws + WS_SMALL + SM_LB), (float*)((unsigned char*)C.out + 32 * MiB),
                WSP(bf16_t, WS_QH), WSP(bf16_t, WS_VH), WSP(bf16_t, WS_GH), WSP(bf16_t, WS_RQ), WSP(bf16_t, WS_RK), WSP(bf16_t, WS_RV), WSP(bf16_t, WS_RG), WSP(bf16_t, WS_GA), WSP(bf16_t, WS_GB)};
        gemm_phase<EpiP1, DenseOrder>(ring, C.wave_s, g, S, E);
#if MK_DRY1
        xcd_barrier(bar, C.wave_s); { EpiDry ED; gemm_phase<EpiDry, DenseOrder>(ring, C.wave_s, g, S, ED); }
#endif
        } SEAM(1);
#if MK_NAIVE_MIX
    if (IN(2)) REPS(2) { REPBAR();  if (C.vcu < 8) p2_naive_hgrn(C, C.vcu); else if (C.vcu < 16) p2_naive_ret(C, C.vcu - 8); } SEAM(2); SEAM(3); SEAM(4);
#else
    if (IN(2)) REPS(2) { REPBAR();  mixer_phase<true>(C); } SEAM(2);
    if (IN(3)) REPS(3) { REPBAR();  mixer_scan(C); } SEAM(3);
    if (IN(4)) REPS(4) { REPBAR();  mixer_phase<false>(C); } SEAM(4);
#endif
    if (IN(5)) REPS(5) { REPBAR();  DenseOrder S; S.init(M, 1024, C.G, (int)blockIdx.x);
        { Gemm g{WSP(bf16_t, WS_GH), WSP(bf16_t, WS_WA), M, 1024, 512}; EpiF<EpiGateMul> E{{WSP(bf16_t, WS_GA), WSP(bf16_t, WS_MG)}}; gemm_phase<EpiF<EpiGateMul>, DenseOrder>(ring, C.wave_s, g, S, E); }
        { Gemm g{WSP(bf16_t, WS_RG), WSP(bf16_t, WS_WB), M, 1024, 1024}; EpiF<EpiGateMulAdd> E{{WSP(bf16_t, WS_GB), WSP(bf16_t, WS_MG)}}; gemm_phase<EpiF<EpiGateMulAdd>, DenseOrder>(ring, C.wave_s, g, S, E); } } SEAM(5);
    if (IN(6)) REPS(6) { REPBAR();  DenseOrder S; S.init(M, 1024, C.G, (int)blockIdx.x); Gemm g{WSP(bf16_t, WS_MG), WSP(bf16_t, WS_WO), M, 1024, 1024};
        EpiF<EpiResid, false> E{{CIN(0), C.out, WSP(bf16_t, WS_H2)}}; gemm_phase<EpiF<EpiResid, false>, DenseOrder>(ring, C.wave_s, g, S, E); } SEAM(6);
    if (IN(7)) REPS(7) { REPBAR();  p6_router(C, ctl); } SEAM(7);
    if (IN(8)) REPS(8) { REPBAR();  const int ntiles = moe_plan(C, ctl); GroupOrder S{ntiles, 2, C.G, (int)blockIdx.x, (const PG8_LAS int*)(C.lds + TILEE_OFF)}; moe_rowinfo<true>(C, S);
        Gemm g{WSP(bf16_t, WS_H2), WSP(bf16_t, WS_WGU), 0, 512, 1024}; EpiPairF<EpiGateUp> E{{(const PG8_LAS int*)(C.lds + ROWINFO_OFF), WSP(bf16_t, WS_HM)}};
        gemm_phase<EpiPairF<EpiGateUp>, GroupOrder, true, true, true>(ring, C.wave_s, g, S, E, (const PG8_LAS int*)(C.lds + ROWINFO_OFF)); } SEAM(8);
    if (IN(9)) REPS(9) { REPBAR();  const int ntiles = moe_plan(C, ctl); GroupOrder S{ntiles, 4, C.G, (int)blockIdx.x, (const PG8_LAS int*)(C.lds + TILEE_OFF)}; moe_rowinfo<false>(C, S);
        Gemm g{WSP(bf16_t, WS_HM), WSP(bf16_t, WS_WD), 0, 1024, 256}; EpiF<EpiDown> E{{(const PG8_LAS int*)(C.lds + ROWINFO_OFF), WSP(bf16_t, WS_YS)}};
        gemm_phase<EpiF<EpiDown>, GroupOrder>(ring, C.wave_s, g, S, E); } SEAM(9);
    if (IN(10)) REPS(10) { REPBAR();  p9_combine(C); } SEAM(10);
    if (IN(11)) REPS(11) { REPBAR();  DenseOrder S; S.init(M, 1024, C.G, (int)blockIdx.x);
        { Gemm g{WSP(bf16_t, WS_PB), WSP(bf16_t, WS_WPP), M, 1024, 256}; EpiF<EpiStoreBf> E{{WSP(bf16_t, WS_PP)}}; gemm_phase<EpiF<EpiStoreBf>, DenseOrder>(ring, C.wave_s, g, S, E); }
        { Gemm g{WSP(bf16_t, WS_X2B), WSP(bf16_t, WS_WPG), M, 1024, 1024}; EpiF<EpiPle> E{{WSP(bf16_t, WS_PP), C.out}}; gemm_phase<EpiF<EpiPle>, DenseOrder>(ring, C.wave_s, g, S, E); } } SEAM(11);
    if (IN(12)) REPS(12) { REPBAR();  p11_final(C, MK_TS >= 0 ? 1.f + __hip_atomic_load((float*)(ctl + 2048), __ATOMIC_RELAXED, __HIP_MEMORY_SCOPE_AGENT) : 1.f); }
#undef IN
#undef SEAM
}

extern "C" void kernel_launch(void* const* d_in, const int* in_sizes, int n_in, void* d_out, int out_size, void* d_ws, size_t ws_size, hipStream_t stream) {
    static int grid = 0;
    if (grid == 0) {
        int dev = 0, cus = 0, per_cu = 0;
        if (hipGetDevice(&dev) != hipSuccess || hipDeviceGetAttribute(&cus, hipDeviceAttributeMultiprocessorCount, dev) != hipSuccess) { fprintf(stderr, "kernel_launch: device query failed\n"); grid = -1; return; }
        if (hipFuncSetAttribute((const void*)fwd, hipFuncAttributeMaxDynamicSharedMemorySize, LDS_BYTES) != hipSuccess) { fprintf(stderr, "kernel_launch: hipFuncSetAttribute failed\n"); grid = -1; return; }
        if (hipOccupancyMaxActiveBlocksPerMultiprocessor(&per_cu, (const void*)fwd, NWAVES * 64, LDS_BYTES) != hipSuccess || per_cu < 1) { fprintf(stderr, "kernel_launch: occupancy query says %d blocks/CU\n", per_cu); }
        (void)hipGetLastError();
        grid = cus;
    }
    if (grid < 0) return;
    (void)hipMemsetAsync((char*)d_ws + WS_CTL, 0, 1 * MiB, stream);
    Args a{};
    for (int i = 0; i < 22; ++i) a.in[i] = (const float*)d_in[i];
    a.out = (float*)d_out; a.ws = (unsigned char*)d_ws;
#if MK_PER_PHASE
    for (int p = 0; p < N_PHASES; ++p) { a.ph_lo = p; a.ph_hi = p + 1; hipLaunchKernelGGL(fwd, dim3(grid), dim3(NWAVES * 64), LDS_BYTES, stream, a); }
#else
    a.ph_lo = 0; a.ph_hi = N_PHASES; hipLaunchKernelGGL(fwd, dim3(grid), dim3(NWAVES * 64), LDS_BYTES, stream, a);
#endif
}
```

```cpp
#include <hip/hip_runtime.h>
#include <cstdint>
#include <cstdio>

#ifndef MK_DUP
#define MK_DUP -1
#endif
typedef unsigned short bf16_t;
typedef float f32x4 __attribute__((ext_vector_type(4)));
typedef unsigned u32x2 __attribute__((ext_vector_type(2)));

constexpr int M = 16384, D = 1024, SEQ = 8192, NIN = 7168, PLE = 256;
constexpr int NE = 32, DE = 256;
constexpr float EPS = 1e-6f;
constexpr int LIST_CAP = 32768;
constexpr int POS_CAP = 40960;

constexpr size_t MiB = 1u << 20;
constexpr size_t WS_CTL = 0;
constexpr size_t WS_SMALL = 1 * MiB;
constexpr size_t WS_LIST = 2 * MiB;
constexpr size_t WS_WA = 6 * MiB, WS_WB = 7 * MiB, WS_WO = 9 * MiB, WS_WPG = 11 * MiB, WS_WPP = 13 * MiB;
constexpr size_t WS_WR = 13 * MiB + 512 * 1024;
constexpr size_t WS_PB = 14 * MiB;
constexpr size_t WS_WIN = 22 * MiB;
constexpr size_t WS_QH = 36 * MiB, WS_VH = 52 * MiB, WS_GH = 68 * MiB, WS_RQ = 84 * MiB, WS_RK = 100 * MiB;
constexpr size_t WS_RV = 116 * MiB, WS_RG = 148 * MiB, WS_GA = 180 * MiB, WS_GB = 212 * MiB;
constexpr size_t WS_MG = 116 * MiB;
constexpr size_t WS_WGU = 84 * MiB;
constexpr size_t WS_WD = 36 * MiB;
constexpr size_t WS_H2 = 148 * MiB;
constexpr size_t WS_HM = 116 * MiB;
constexpr size_t WS_YS = 180 * MiB;
constexpr size_t WS_X2B = 148 * MiB;
constexpr size_t WS_PP = 52 * MiB;
constexpr size_t SM_RS1 = 0, SM_RS2 = 64 * 1024, SM_RS3 = 128 * 1024, SM_EID = 192 * 1024, SM_WGT = 320 * 1024, SM_LB = 448 * 1024;
constexpr size_t SM_ROWMAP = 512 * 1024;
constexpr size_t SM_TILEE = 700 * 1024;
constexpr int CW_CNT = 8192;

__device__ __forceinline__ unsigned f2bf(float f) { unsigned u = __float_as_uint(f); return (u + 0x7fffu + ((u >> 16) & 1u)) >> 16; }
__device__ __forceinline__ float bf2f(unsigned short h) { return __uint_as_float(((unsigned)h) << 16); }
typedef float f32x2_t __attribute__((ext_vector_type(2))); typedef __bf16 bf16x2_t __attribute__((ext_vector_type(2)));
__device__ __forceinline__ unsigned pk2(float lo, float hi) { f32x2_t v = {lo, hi}; bf16x2_t b = __builtin_convertvector(v, bf16x2_t); return __builtin_bit_cast(unsigned, b); }
__device__ __forceinline__ float siluf(float v) { return v * __builtin_amdgcn_rcpf(1.f + __builtin_amdgcn_exp2f(-1.4426950408889634f * v)); }
__device__ __forceinline__ float sigmf(float v) { return __builtin_amdgcn_rcpf(1.f + __builtin_amdgcn_exp2f(-1.4426950408889634f * v)); }
__device__ __forceinline__ void st4bf(bf16_t* p, f32x4 v) { u32x2 w; w.x = pk2(v[0], v[1]); w.y = pk2(v[2], v[3]); *(u32x2*)p = w; }
__device__ __forceinline__ f32x4 ld4bf(const bf16_t* p) { u32x2 w = *(const u32x2*)p; f32x4 r; r[0] = __uint_as_float(w.x << 16); r[1] = __uint_as_float(w.x & 0xffff0000u); r[2] = __uint_as_float(w.y << 16); r[3] = __uint_as_float(w.y & 0xffff0000u); return r; }
__device__ __forceinline__ float wave_sum(float v) {
#pragma unroll
    for (int o = 1; o < 64; o <<= 1) v += __shfl_xor(v, o);
    return v;
}
__device__ __forceinline__ int tid_opaque(int wave_s) { int t = (wave_s << 6) | (int)__builtin_amdgcn_mbcnt_hi(~0u, __builtin_amdgcn_mbcnt_lo(~0u, 0u)); asm volatile("" : "+v"(t)); return t; }
__device__ __forceinline__ float gamma_lg(int h) { return log1pf(-exp2f(-5.f - (float)h)); }


namespace pg8 {
#define PG8_LAS __attribute__((address_space(3)))
typedef short bf16x8 __attribute__((ext_vector_type(8)));
typedef unsigned u32x4 __attribute__((ext_vector_type(4)));
constexpr int BM = 256, BK = 64, HALF = 128, HTB = HALF * BK * 2  , STAGE_BYTES = 8 * HTB, NXCD = 8, WGM = 8;

__host__ __device__ __forceinline__ int lds_byte(int r, int c) { const int st = (r >> 4) * 2 + (c >> 5), rr = r & 15, cc = c & 31, ob = rr * 64 + cc * 2; return st * 1024 + (ob ^ (((ob >> 9) & 1) << 5)); }
__host__ __device__ __forceinline__ void stage_rc(int b, int& R, int& C) { const int st = b / 1024, sb = b % 1024, swz = sb ^ (((sb >> 9) & 1) << 5); R = (st >> 1) * 16 + swz / 64; C = (st & 1) * 32 + (swz % 64) / 2; }
__host__ __device__ __forceinline__ int perm32(int rho) { const int n = rho >> 4, i = rho & 15; return 8 * (i >> 2) + 4 * n + (i & 3); }

struct Unit { int pm, pn, pb, ui; };
struct Gemm { const bf16_t* A; const bf16_t* Bt; int M, N, K; };

struct DenseOrder {
    int nM, nN, nwg, G, c;
    __host__ __device__ void init(int M, int N, int G_, int c_) { nM = M / BM; nN = N / BM; nwg = nM * nN; G = G_; c = c_; }
    __host__ __device__ bool next(int i, Unit& u) const {
        const long L = (long)i * G + c; if (L >= nwg) return false;
        int wgid = (int)L; { const int q = nwg / NXCD, r = nwg % NXCD, xcd = wgid % NXCD, off = wgid / NXCD; wgid = (xcd < r ? xcd * (q + 1) : r * (q + 1) + (xcd - r) * q) + off; }
        const int nig = WGM * nN, gid = wgid / nig, fm = gid * WGM, gsz = (nM - fm) < WGM ? (nM - fm) : WGM;
        u.pm = fm + ((wgid % nig) % gsz); u.pn = (wgid % nig) / gsz; u.pb = u.pn; u.ui = i; return true;
    }
    __device__ __forceinline__ void a_ready(const Unit&) const {}
    __device__ __forceinline__ void done(const Unit&) const {}
};
struct GroupOrder {
    int ntiles, NTN, G, c; const PG8_LAS int* tile_e;
    __device__ bool next(int i, Unit& u) const {
        const int L = i * G + c; if (L >= ntiles * NTN) return false;
        const int tile = L / NTN, pn = L - tile * NTN;
        u.pm = tile; u.pn = pn; u.pb = tile_e[tile] * NTN + pn; u.ui = i; return true;
    }
    __device__ __forceinline__ void a_ready(const Unit&) const {}
    __device__ __forceinline__ void done(const Unit&) const {}
};

template <class F, bool PERM_ = true> struct EpiF {
    static constexpr bool PERM = PERM_, AFTER_DRAIN = false; F f;
    __device__ __forceinline__ void operator()(const f32x4 (&acc)[2][2][4][2], const Unit& u, int wr, int wc, int fr, int fq) const {
#pragma unroll
        for (int ai = 0; ai < 2; ++ai)
#pragma unroll
            for (int m = 0; m < 4; ++m) { const int row = u.pm * BM + ai * HALF + wr * 64 + m * 16 + fr;
#pragma unroll
                for (int bj = 0; bj < 2; ++bj)
#pragma unroll
                    for (int n = 0; n < 2; ++n) { const int col = u.pn * BM + bj * HALF + wc * 32 + (PERM ? 8 * fq + 4 * n : 16 * n + 4 * fq); f(u, row, col, acc[ai][bj][m][n]); }
                asm volatile("" ::: "memory"); }
    }
};
template <class F> struct EpiPairF {
    static constexpr bool PERM = true, AFTER_DRAIN = false; F f;
    __device__ __forceinline__ void operator()(const f32x4 (&acc)[2][2][4][2], const Unit& u, int wr, int wc, int fr, int fq) const {
#pragma unroll
        for (int ai = 0; ai < 2; ++ai)
#pragma unroll
            for (int m = 0; m < 4; ++m) { const int row = u.pm * BM + ai * HALF + wr * 64 + m * 16 + fr;
#pragma unroll
                for (int n = 0; n < 2; ++n) { const int col = u.pn * HALF + wc * 32 + 8 * fq + 4 * n; f.pair(u, row, col, acc[ai][0][m][n], acc[ai][1][m][n]); }
                asm volatile("" ::: "memory"); }
    }
};

template <class Epi, class Sched, bool ALIGN_EPI = true, bool SP2 = true, bool GATHER = false>
__device__ __forceinline__ void gemm_phase(PG8_LAS unsigned char* lds, const int wave_s, const Gemm g, const Sched& S, const Epi& E, const PG8_LAS int* rowtab = nullptr) {
    static_assert(SP2, "only the SP2 loop is kept in this file");
    const int tid = tid_opaque(wave_s), wid = wave_s, lane = tid & 63, wr = wid >> 2, wc = wid & 3, fr = lane & 15, fq = lane >> 4;
    const int K = g.K, nt = K / BK;
    unsigned voffA[2], voffB[2];
#pragma unroll
    for (int i = 0; i < 2; ++i) { int R, C; stage_rc(tid * 16 + i * 8192, R, C); const int Rb = Epi::PERM ? ((R & ~31) + perm32(R & 31)) : R;
        voffA[i] = (unsigned)(R * K + C) * 2u; voffB[i] = (unsigned)(Rb * K + C) * 2u; }
    unsigned cvA[2][2];
    (void)cvA;
#define PG8_GOFF(dst, u_) do { _Pragma("unroll") for (int _h = 0; _h < 2; ++_h) _Pragma("unroll") for (int _i = 0; _i < 2; ++_i) { int R_, C_; stage_rc(tid * 16 + _i * 8192, R_, C_); \
        const int a_ = rowtab[(u_).ui * 512 + _h * HALF + R_]; const int tok_ = a_ < 0 ? 0 : (a_ >> 1); dst[_h][_i] = (unsigned)(tok_ * K + C_) * 2u; } } while (0)
    const size_t kstep = (size_t)(BK * 2);
    const size_t hstep = (size_t)HALF * K * 2;
    const size_t tstep = 2 * hstep;
    const unsigned ldsw = (unsigned)wid * 1024u;
    const int aoff = lds_byte(wr * 64 + fr, fq * 8), boff = lds_byte(wc * 32 + fr, fq * 8);
#define PG8_SA(b, h) (((b) * 2 + (h)) * HTB)
#define PG8_SB(b, h) ((4 + (b) * 2 + (h)) * HTB)
#define PG8_STAGE(bufoff, gbase, voff) do { _Pragma("unroll") for (int _i = 0; _i < 2; ++_i) \
        __builtin_amdgcn_global_load_lds((const unsigned*)((const char*)(gbase) + (voff)[_i]), (PG8_LAS unsigned*)(lds + (bufoff) + ldsw + _i * 8192), 16, 0, 0); } while (0)
#define PG8_STA(bufoff, ptr, h, nx) do { if constexpr (GATHER) { _Pragma("unroll") for (int _i = 0; _i < 2; ++_i) { const unsigned _vo = cvA[h][_i]; \
        __builtin_amdgcn_global_load_lds((const unsigned*)((const char*)(ptr) + _vo), (PG8_LAS unsigned*)(lds + (bufoff) + ldsw + _i * 8192), 16, 0, 0); } } \
    else { PG8_STAGE(bufoff, (ptr) + (h) * hstep, voffA); } } while (0)
#define PG8_LDA(dst, b, h) do { _Pragma("unroll") for (int m = 0; m < 4; ++m) _Pragma("unroll") for (int k = 0; k < 2; ++k) dst[m][k] = *(const PG8_LAS bf16x8*)(lds + PG8_SA(b, h) + aoff + m * 2048 + k * 1024); } while (0)
#define PG8_LDB(dst, b, h) do { _Pragma("unroll") for (int n = 0; n < 2; ++n) _Pragma("unroll") for (int k = 0; k < 2; ++k) dst[n][k] = *(const PG8_LAS bf16x8*)(lds + PG8_SB(b, h) + boff + n * 2048 + k * 1024); } while (0)
#define PG8_MMA(ai, bj, At, Bt) do { __builtin_amdgcn_s_setprio(1); _Pragma("unroll") for (int m = 0; m < 4; ++m) _Pragma("unroll") for (int n = 0; n < 2; ++n) _Pragma("unroll") for (int k = 0; k < 2; ++k) \
        acc[ai][bj][m][n] = __builtin_amdgcn_mfma_f32_16x16x32_bf16(Bt[n][k], At[m][k], acc[ai][bj][m][n], 0, 0, 0); __builtin_amdgcn_s_setprio(0); } while (0)
#define PG8_WAIT_V(n) asm volatile("s_waitcnt vmcnt(" #n ")" ::: "memory")
#define PG8_WAIT_L(n) asm volatile("s_waitcnt lgkmcnt(" #n ")" ::: "memory")
#define PG8_BAR __builtin_amdgcn_s_barrier()
#define PG8_SCHED __builtin_amdgcn_sched_barrier(0)
    Unit cur, nxt; int ui = 0;
    if (!S.next(0, cur)) return;
    f32x4 acc[2][2][4][2];
#pragma unroll
    for (int a = 0; a < 2; ++a)
#pragma unroll
        for (int b = 0; b < 2; ++b)
#pragma unroll
            for (int m = 0; m < 4; ++m)
#pragma unroll
                for (int n = 0; n < 2; ++n) acc[a][b][m][n] = (f32x4){0.f, 0.f, 0.f, 0.f};
    bf16x8 At[4][2], B0[2][2], B1[2][2];
    const char* cA = (const char*)g.A + (GATHER ? (size_t)0 : (size_t)cur.pm * tstep); const char* cB = (const char*)g.Bt + (size_t)cur.pb * tstep;
    if constexpr (GATHER) { PG8_GOFF(cvA, cur); }
    S.a_ready(cur);
    if constexpr (SP2) {
        PG8_STAGE(PG8_SB(0, 0), cB, voffB); PG8_STAGE(PG8_SB(0, 1), cB + hstep, voffB); PG8_STA(PG8_SA(0, 0), cA, 0, false); PG8_STA(PG8_SA(0, 1), cA, 1, false);
        if (wr == 1) PG8_BAR;
        PG8_WAIT_V(2); PG8_BAR;
        PG8_STAGE(PG8_SB(1, 0), cB + kstep, voffB); PG8_STA(PG8_SA(1, 0), cA + kstep, 0, false); PG8_STAGE(PG8_SB(1, 1), cB + hstep + kstep, voffB);
        PG8_WAIT_V(6); PG8_BAR;
    }
    for (;;) {
        const bool has_next = S.next(ui + 1, nxt);
        const char* nA = (has_next && !GATHER) ? (const char*)g.A + (size_t)nxt.pm * tstep : cA; const char* nB = has_next ? (const char*)g.Bt + (size_t)nxt.pb * tstep : cB;
        for (int t = 0; t < nt; t += 2) {
            const bool last = (t == nt - 2);
            const char* a1 = cA + (size_t)(t + 1) * kstep;
            const char* a2 = last ? nA : cA + (size_t)(t + 2) * kstep; const char* b2 = last ? nB : cB + (size_t)(t + 2) * kstep;
            const char* a3 = a2 + kstep; const char* b3 = b2 + kstep;
            if (last && has_next) S.a_ready(nxt);
            if constexpr (SP2) {
            PG8_LDB(B0, 0, 0); PG8_LDB(B1, 0, 1); PG8_SCHED; PG8_LDA(At, 0, 0); PG8_STA(PG8_SA(1, 1), a1, 1, false);
            if constexpr (GATHER) { if (last && has_next) { PG8_GOFF(cvA, nxt); } }
            PG8_WAIT_V(8); PG8_WAIT_L(0); PG8_BAR; PG8_MMA(0, 0, At, B0); PG8_MMA(0, 1, At, B1); PG8_BAR; PG8_SCHED;
            PG8_LDA(At, 0, 1); PG8_STAGE(PG8_SB(0, 0), b2, voffB); PG8_STAGE(PG8_SB(0, 1), b2 + hstep, voffB); PG8_STA(PG8_SA(0, 0), a2, 0, last);
            PG8_WAIT_V(8); PG8_WAIT_L(0); PG8_BAR; PG8_MMA(1, 0, At, B0); PG8_MMA(1, 1, At, B1); PG8_BAR; PG8_SCHED;
            PG8_LDB(B0, 1, 0); PG8_LDB(B1, 1, 1); PG8_SCHED; PG8_LDA(At, 1, 0); PG8_STA(PG8_SA(0, 1), a2, 1, last);
            PG8_WAIT_V(8); PG8_WAIT_L(0); PG8_BAR; PG8_MMA(0, 0, At, B0); PG8_MMA(0, 1, At, B1); PG8_BAR; PG8_SCHED;
            PG8_LDA(At, 1, 1); PG8_STAGE(PG8_SB(1, 0), b3, voffB); PG8_STAGE(PG8_SB(1, 1), b3 + hstep, voffB); PG8_STA(PG8_SA(1, 0), a3, 0, last);
            PG8_WAIT_V(8); PG8_WAIT_L(0); PG8_BAR; PG8_MMA(1, 0, At, B0); PG8_MMA(1, 1, At, B1); PG8_BAR; PG8_SCHED;
            }
        }
        if constexpr (ALIGN_EPI) { if (wr == 0) PG8_BAR; }
        if constexpr (!Epi::AFTER_DRAIN) { const int t2_ = tid_opaque(wave_s) & 63; E(acc, cur, wr, wc, t2_ & 15, t2_ >> 4); S.done(cur); }
        if (!has_next) break;
#pragma unroll
        for (int a = 0; a < 2; ++a)
#pragma unroll
            for (int b = 0; b < 2; ++b)
#pragma unroll
                for (int m = 0; m < 4; ++m)
#pragma unroll
                    for (int n = 0; n < 2; ++n) acc[a][b][m][n] = (f32x4){0.f, 0.f, 0.f, 0.f};
        cur = nxt; cA = nA; cB = nB; ++ui;
        if constexpr (ALIGN_EPI) { if (wr == 1) PG8_BAR; }
    }
    PG8_WAIT_V(0);
    if constexpr (!ALIGN_EPI) { if (wr == 0) PG8_BAR; }
    PG8_BAR;
    if constexpr (Epi::AFTER_DRAIN) { E.fused(acc, cur, wr, wc, fr, fq, lds, wid, lane); S.done(cur); }
#undef PG8_SA
#undef PG8_SB
#undef PG8_STAGE
#undef PG8_STA
#undef PG8_GOFF
#undef PG8_LDA
#undef PG8_LDB
#undef PG8_MMA
#undef PG8_WAIT_V
#undef PG8_WAIT_L
#undef PG8_BAR
#undef PG8_SCHED
}
}

#define GAS __attribute__((address_space(1)))
#define LAS __attribute__((address_space(3)))
typedef unsigned v4u __attribute__((ext_vector_type(4)));
typedef GAS unsigned gu32;
typedef GAS unsigned long long gu64;
#define RLX_AGENT __ATOMIC_RELAXED, __HIP_MEMORY_SCOPE_AGENT
#define LDS_WAIT() asm volatile("s_waitcnt lgkmcnt(0)" ::: "memory")
#define VM_WAIT() asm volatile("s_waitcnt vmcnt(0)" ::: "memory")
__device__ __forceinline__ unsigned long long rt() { return __builtin_amdgcn_s_memrealtime(); }

#define XB_TMO      128
#define XB_XCNT(j)  (256  + 64 * (j))
#define XB_XSUB(j)  (1280 + 64 * (j))
#define XB_XGEN(j)  (2304 + 64 * (j))
#define XB_TOP      3328
#define XB_TOPGEN   3392
#define XCD_BAR_WORDS 3456
#define XB_SPIN_CAP (1u << 18)

__device__ __forceinline__ unsigned xb_ld(unsigned* p)              { return __hip_atomic_load(p, __ATOMIC_RELAXED, __HIP_MEMORY_SCOPE_AGENT); }
__device__ __forceinline__ unsigned xb_add(unsigned* p, unsigned v) { return __hip_atomic_fetch_add(p, v, __ATOMIC_RELAXED, __HIP_MEMORY_SCOPE_AGENT); }
__device__ __forceinline__ unsigned xb_xcc_id() { return (unsigned)__builtin_amdgcn_s_getreg((3 << 11) | 20) & 0xFu; }
#define XB_SPIN(cond, bar) do { unsigned _sp = 0; while (cond) { __builtin_amdgcn_s_sleep(1); \
    if ((++_sp & 255u) == 0u) { if (xb_ld(&(bar)[XB_TMO])) break; if (_sp > XB_SPIN_CAP) { atomicAdd(&(bar)[XB_TMO], 1u); break; } } } } while (0)

struct XcdBarrier {
    unsigned* bar; unsigned x;
    volatile LAS unsigned* st;
};

__device__ __forceinline__ XcdBarrier xcd_barrier_post(unsigned* bar, volatile LAS unsigned* st) {
    XcdBarrier b; b.bar = bar; b.x = xb_xcc_id(); b.st = st;
    if (threadIdx.x == 0) (void)xb_add(&bar[XB_XCNT(b.x)], 1u);
    return b;
}
__device__ __forceinline__ void xcd_barrier_complete(unsigned* bar, unsigned x, unsigned& nloc, unsigned& nx) {
    const unsigned G = gridDim.x * gridDim.y * gridDim.z;
    unsigned sum, cnt, mine, sp = 0u;
    for (;;) {
        sum = 0u; cnt = 0u; mine = 0u;
#pragma unroll
        for (unsigned j = 0; j < 16; ++j) { const unsigned c = xb_ld(&bar[XB_XCNT(j)]); sum += c; cnt += (c > 0u) ? 1u : 0u; mine = (j == x) ? c : mine; }
        if (sum == G) break;
        __builtin_amdgcn_s_sleep(1);
        if ((++sp & 255u) == 0u) { if (xb_ld(&bar[XB_TMO])) break; if (sp > XB_SPIN_CAP) { atomicAdd(&bar[XB_TMO], 1u); break; } }
    }
    nloc = mine > 0u ? mine : 1u; nx = cnt > 0u ? cnt : 1u;
}

__device__ __forceinline__ void xcd_barrier(const XcdBarrier& b, const int wave_s) {
    asm volatile("s_waitcnt vmcnt(0)" ::: "memory");
    __syncthreads();
    if (tid_opaque(wave_s) == 0) {
        unsigned* bar = b.bar;
        __builtin_amdgcn_s_waitcnt(0);
        unsigned nloc = b.st[0], nx = b.st[1];
        if (nloc == 0u) { xcd_barrier_complete(bar, b.x, nloc, nx); b.st[0] = nloc; b.st[1] = nx; }
        const unsigned old = xb_add(&bar[XB_XSUB(b.x)], 1u);
        const unsigned gen = old / nloc;
        if (old + 1u == (gen + 1u) * nloc) {
            __builtin_amdgcn_fence(__ATOMIC_RELEASE, "agent");
            asm volatile("s_waitcnt vmcnt(0)" ::: "memory");
            const unsigned og = xb_add(&bar[XB_TOP], 1u);
            const unsigned tg = og / nx;
            if (og + 1u == (tg + 1u) * nx) xb_add(&bar[XB_TOPGEN], 1u);
            else XB_SPIN(xb_ld(&bar[XB_TOPGEN]) == tg, bar);
            __builtin_amdgcn_fence(__ATOMIC_ACQUIRE, "agent");
            xb_add(&bar[XB_XGEN(b.x)], 1u);
            asm volatile("s_waitcnt vmcnt(0)" ::: "memory");
        } else {
            XB_SPIN(xb_ld(&bar[XB_XGEN(b.x)]) == gen, bar);
            __builtin_amdgcn_fence(__ATOMIC_ACQUIRE, "agent");
            asm volatile("s_waitcnt vmcnt(0)" ::: "memory");
        }
    }
    __syncthreads();
}

using pg8::Unit;
struct EpiP1 {
    static constexpr bool PERM = true, AFTER_DRAIN = false;
    const float* rs1; const float* lb; float* LF;
    bf16_t *QH, *VH, *GH, *RQ, *RK, *RV, *RG, *GA, *GB;
    template <int ACT> __device__ __forceinline__ void unary(const f32x4 (&acc)[2][2][4][2], int row0, int wc, int fq, bf16_t* dst, int ld, int colbase) const {
#pragma unroll
        for (int ai = 0; ai < 2; ++ai)
#pragma unroll
            for (int m = 0; m < 4; ++m) { const int row = row0 + ai * 128 + m * 16; bf16_t* rowp = dst + (size_t)row * ld + colbase + wc * 32 + 8 * fq;
#pragma unroll
                for (int bj = 0; bj < 2; ++bj) { f32x4 v0 = acc[ai][bj][m][0], v1 = acc[ai][bj][m][1];
                    if (ACT == 1) { for (int j = 0; j < 4; ++j) { v0[j] = siluf(v0[j]); v1[j] = siluf(v1[j]); } }
                    if (ACT == 2) { for (int j = 0; j < 4; ++j) { v0[j] = sigmf(v0[j]); v1[j] = sigmf(v1[j]); } }
                    pg8::u32x4 w; w.x = pk2(v0[0], v0[1]); w.y = pk2(v0[2], v0[3]); w.z = pk2(v1[0], v1[1]); w.w = pk2(v1[2], v1[3]);
                    *(pg8::u32x4*)(rowp + bj * 128) = w; } }
    }
    __device__ __forceinline__ void operator()(const f32x4 (&acc)[2][2][4][2], const Unit& u, int wr, int wc, int fr, int fq) const {
        const int row0 = u.pm * 256 + wr * 64 + fr; const int c0 = u.pn * 256; const int sec = c0 >> 9;
        if (sec == 0) unary<1>(acc, row0, wc, fq, QH, 512, c0);
        else if (sec == 2) unary<0>(acc, row0, wc, fq, VH, 512, c0 - 1024);
        else if (sec == 3) unary<1>(acc, row0, wc, fq, GH, 512, c0 - 1536);
        else if (sec == 6 || sec == 7) unary<0>(acc, row0, wc, fq, RV, 1024, c0 - 3072);
        else if (sec == 8 || sec == 9) unary<1>(acc, row0, wc, fq, RG, 1024, c0 - 4096);
        else if (sec == 10 || sec == 11) unary<2>(acc, row0, wc, fq, GA, 1024, c0 - 5120);
        else if (sec == 12 || sec == 13) unary<2>(acc, row0, wc, fq, GB, 1024, c0 - 6144);
        else if (sec == 1) { const int cb = c0 - 512 + wc * 32 + 8 * fq;
#pragma unroll
            for (int ai = 0; ai < 2; ++ai)
#pragma unroll
                for (int m = 0; m < 4; ++m) { const int row = row0 + ai * 128 + m * 16; float* rowp = LF + (size_t)row * 512 + cb;
#pragma unroll
                    for (int bj = 0; bj < 2; ++bj)
#pragma unroll
                        for (int n = 0; n < 2; ++n) { const f32x4 l4 = *(const f32x4*)(lb + cb + bj * 128 + 4 * n); const f32x4 v = acc[ai][bj][m][n]; f32x4 o;
                            for (int j = 0; j < 4; ++j) { const float e = (1.f - l4[j]) * __builtin_amdgcn_rcpf(1.f + __builtin_amdgcn_exp2f(1.4426950408889634f * v[j])); o[j] = __logf(1.f - e); }
                            *(f32x4*)(rowp + bj * 128 + 4 * n) = o; }
                    asm volatile("" ::: "memory"); } }
        else { const bool isk = sec == 5; bf16_t* dst = isk ? RK : RQ; const int cbase = c0 - (isk ? 2560 : 2048);
            float invrev[4];
#pragma unroll
            for (int q = 0; q < 4; ++q) invrev[q] = exp2f(-(float)(wc * 16 + 4 * fq + q) * (13.287712379549449f / 64.f)) * 0.15915494309189535f;
            const int hd0 = cbase >> 7; const float lg0 = gamma_lg(hd0), lg1 = gamma_lg(hd0 + 1);
#pragma unroll
            for (int ai = 0; ai < 2; ++ai)
#pragma unroll
                for (int m = 0; m < 4; ++m) { const int row = row0 + ai * 128 + m * 16; const int t = row & (SEQ - 1), tm = t & 127;
                    bf16_t* rowp = dst + (size_t)row * 512 + cbase + wc * 32 + 8 * fq; float sn[4], cs[4];
#pragma unroll
                    for (int q = 0; q < 4; ++q) { float r = (float)t * invrev[q]; r = r - floorf(r); sn[q] = __builtin_amdgcn_sinf(r); cs[q] = __builtin_amdgcn_cosf(r); }
#pragma unroll
                    for (int bj = 0; bj < 2; ++bj) { const float lg = bj ? lg1 : lg0; const float sc = isk ? __expf(-(float)tm * lg) : 0.08838834764831845f * __expf((float)tm * lg);
                        const f32x4 v0 = acc[ai][bj][m][0], v1 = acc[ai][bj][m][1]; float o[8];
                        o[0] = (v0[0] * cs[0] - v0[1] * sn[0]) * sc; o[1] = (v0[0] * sn[0] + v0[1] * cs[0]) * sc; o[2] = (v0[2] * cs[1] - v0[3] * sn[1]) * sc; o[3] = (v0[2] * sn[1] + v0[3] * cs[1]) * sc;
                        o[4] = (v1[0] * cs[2] - v1[1] * sn[2]) * sc; o[5] = (v1[0] * sn[2] + v1[1] * cs[2]) * sc; o[6] = (v1[2] * cs[3] - v1[3] * sn[3]) * sc; o[7] = (v1[2] * sn[3] + v1[3] * cs[3]) * sc;
                        pg8::u32x4 w; w.x = pk2(o[0], o[1]); w.y = pk2(o[2], o[3]); w.z = pk2(o[4], o[5]); w.w = pk2(o[6], o[7]);
                        *(pg8::u32x4*)(rowp + bj * 128) = w; }
                    asm volatile("" ::: "memory"); } }
    }
};
struct EpiDry { static constexpr bool PERM = true, AFTER_DRAIN = false;
    __device__ __forceinline__ void operator()(const f32x4 (&acc)[2][2][4][2], const Unit&, int, int, int, int) const {
#pragma unroll
        for (int a = 0; a < 2; ++a)
#pragma unroll
            for (int b = 0; b < 2; ++b)
#pragma unroll
                for (int m = 0; m < 4; ++m)
#pragma unroll
                    for (int n = 0; n < 2; ++n) asm volatile("" :: "v"(acc[a][b][m][n])); }
};
struct EpiGateMul {
    const bf16_t* G; bf16_t* T;
    __device__ __forceinline__ void operator()(const Unit&, int m, int c, f32x4 v) const { const f32x4 g = ld4bf(G + (size_t)m * 1024 + c); st4bf(T + (size_t)m * 1024 + c, g * v); }
};
struct EpiGateMulAdd {
    const bf16_t* G; bf16_t* T;
    __device__ __forceinline__ void operator()(const Unit&, int m, int c, f32x4 v) const { const f32x4 g = ld4bf(G + (size_t)m * 1024 + c); const f32x4 t = ld4bf(T + (size_t)m * 1024 + c); st4bf(T + (size_t)m * 1024 + c, t + g * v); }
};
struct EpiResid {
    const float* x; float* out; bf16_t* H2;
    __device__ __forceinline__ void operator()(const Unit&, int m, int c, f32x4 v) const { const f32x4 r = *(const f32x4*)(x + (size_t)m * 1024 + c) + v; *(f32x4*)(out + (size_t)m * 1024 + c) = r; st4bf(H2 + (size_t)m * 1024 + c, r); }
};
struct EpiStoreBf {
    bf16_t* T;
    __device__ __forceinline__ void operator()(const Unit&, int m, int c, f32x4 v) const { st4bf(T + (size_t)m * 1024 + c, v); }
};
struct EpiPle {
    const bf16_t* PP; float* x;
    __device__ __forceinline__ void operator()(const Unit&, int m, int c, f32x4 v) const { const f32x4 pp = ld4bf(PP + (size_t)m * 1024 + c); f32x4 r = *(const f32x4*)(x + (size_t)m * 1024 + c);
        for (int j = 0; j < 4; ++j) r[j] += sigmf(v[j]) * pp[j]; *(f32x4*)(x + (size_t)m * 1024 + c) = r; }
};
struct EpiGateUp {
    const PG8_LAS int* rowinfo; bf16_t* HM;
    __device__ __forceinline__ void pair(const Unit& u, int pos, int c, f32x4 g, f32x4 up) const { const float rs = ((const PG8_LAS float*)rowinfo)[u.ui * 512 + 256 + (pos & 255)];
        f32x4 o; for (int j = 0; j < 4; ++j) o[j] = siluf(g[j] * rs) * (up[j] * rs); st4bf(HM + (size_t)pos * 256 + c, o); }
};
struct EpiDown {
    const PG8_LAS int* rowinfo; bf16_t* YS;
    __device__ __forceinline__ void operator()(const Unit& u, int pos, int c, f32x4 v) const { const int r = pos & 255; const int a = rowinfo[u.ui * 512 + r]; if (a < 0) return;
        const float w = ((const PG8_LAS float*)rowinfo)[u.ui * 512 + 256 + r]; st4bf(YS + (size_t)a * 1024 + c, v * w); }
};

constexpr int NWAVES = 8;
constexpr int RING_BYTES = 131072, EXTRA_OFF = 131072, LDSCTL_OFF = EXTRA_OFF, MISC_OFF = EXTRA_OFF + 320, OFFS_OFF = EXTRA_OFF + 512, TILEE_OFF = EXTRA_OFF + 1024, ROWINFO_OFF = EXTRA_OFF + 2048;
constexpr int LDS_BYTES = ROWINFO_OFF + 8 * 2048;
constexpr int CW_BAR = 4096;
#ifndef MK_PER_PHASE
#define MK_PER_PHASE 0
#endif
constexpr int N_PHASES = 13;
#ifndef MK_NAIVE_MIX
#define MK_NAIVE_MIX 0
#endif

struct Args { const float* in[22]; float* out; unsigned char* ws; int ph_lo, ph_hi; };

struct Ctx {
    LAS unsigned char* lds; int vcu, G, wave_s;
    const float* const* in; float* out; unsigned char* ws;
};
#define CIN(i) (C.in[i])
#define WSP(T, off) ((T*)(C.ws + (off)))

template <int MODE>
__device__ __forceinline__ void transpose_item(const float* W, int K, int N, bf16_t* WT, int row_off, LAS float* scr, int item, int lane, const float* gain) {
    const int nblk = N / 32, kb = item / nblk, nb = item % nblk, k0 = 64 * kb, n0 = 32 * nb;
    int nsrc = n0 + (lane & 31);
    if (MODE == 1) { if (nsrc >= 2048 && nsrc < 3072) { const int base = nsrc & ~127, w = nsrc & 127; nsrc = base + (w >> 1) + 64 * (w & 1); } }
    float wv[32];
#pragma unroll
    for (int i = 0; i < 32; ++i) { const int kk = 2 * i + (lane >> 5); wv[i] = W[(size_t)(k0 + kk) * N + nsrc]; }
    const float g0 = gain ? gain[k0 + (lane & 63)] : 1.f;
#pragma unroll
    for (int i = 0; i < 32; ++i) { const int kk = 2 * i + (lane >> 5); scr[kk * 33 + (lane & 31)] = wv[i] * __shfl(g0, kk); }
    LDS_WAIT(); asm volatile("" ::: "memory");
    const int c = lane & 7;
#pragma unroll
    for (int j = 0; j < 4; ++j) { const int n = (lane >> 3) + 8 * j; const LAS float* s = scr + (8 * c) * 33 + n;
        v4u o; o.x = pk2(s[0 * 33], s[1 * 33]); o.y = pk2(s[2 * 33], s[3 * 33]); o.z = pk2(s[4 * 33], s[5 * 33]); o.w = pk2(s[6 * 33], s[7 * 33]);
        int drow = row_off + n0 + n; if (MODE == 2) { const int nc = n0 + n; drow = row_off + 256 * (nc >> 7) + (nc & 127); }
        *(GAS v4u*)(WT + (size_t)drow * K + k0 + 8 * c) = o; }
    LDS_WAIT(); asm volatile("" ::: "memory");
}
__device__ __forceinline__ void p0_prologue(const Ctx& C) {
    const int T_tid = tid_opaque(C.wave_s), T_lane = T_tid & 63, T_wave = C.wave_s; (void)T_lane; (void)T_wave;
    LAS float* scr = (LAS float*)(C.lds + T_wave * 16384);
    const int gw = C.vcu * NWAVES + T_wave, NGW = C.G * NWAVES;
    constexpr int I_IN = 16 * (NIN / 32), I_A = 8 * 32, I_SQ = 16 * 32, I_PP = 4 * 32;
    constexpr int NIT = I_IN + I_A + 3 * I_SQ + I_PP;
    for (int it = gw; it < NIT; it += NGW) { int r = it;
        if (r < I_IN) { transpose_item<1>(CIN(3), 1024, NIN, WSP(bf16_t, WS_WIN), 0, scr, r, T_lane, CIN(2)); continue; } r -= I_IN;
        if (r < I_A) { transpose_item<0>(CIN(7), 512, 1024, WSP(bf16_t, WS_WA), 0, scr, r, T_lane, nullptr); continue; } r -= I_A;
        if (r < I_SQ) { transpose_item<0>(CIN(8), 1024, 1024, WSP(bf16_t, WS_WB), 0, scr, r, T_lane, nullptr); continue; } r -= I_SQ;
        if (r < I_SQ) { transpose_item<0>(CIN(9), 1024, 1024, WSP(bf16_t, WS_WO), 0, scr, r, T_lane, nullptr); continue; } r -= I_SQ;
        if (r < I_SQ) { transpose_item<0>(CIN(19), 1024, 1024, WSP(bf16_t, WS_WPG), 0, scr, r, T_lane, CIN(18)); continue; } r -= I_SQ;
        transpose_item<0>(CIN(20), 256, 1024, WSP(bf16_t, WS_WPP), 0, scr, r, T_lane, nullptr);
    }
    { bf16_t* XB = (bf16_t*)C.out; float* rs1 = (float*)(C.ws + WS_SMALL + SM_RS1); const float* x = CIN(0);
      for (int m = gw; m < M; m += NGW) { const f32x4* xr = (const f32x4*)(x + (size_t)m * D) + T_lane; f32x4 v[4]; float s = 0.f;
#pragma unroll
        for (int j = 0; j < 4; ++j) { v[j] = xr[64 * j]; s += (v[j][0] * v[j][0] + v[j][1] * v[j][1]) + (v[j][2] * v[j][2] + v[j][3] * v[j][3]); }
        s = wave_sum(s); const float rs = rsqrtf(s * (1.f / D) + EPS); if (T_lane == 0) rs1[m] = rs;
#pragma unroll
        for (int j = 0; j < 4; ++j) st4bf(XB + (size_t)m * D + T_lane * 4 + 256 * j, v[j] * rs); } }
    { const f32x4* p4 = (const f32x4*)CIN(1); bf16_t* PB = WSP(bf16_t, WS_PB); const int gt = C.vcu * 512 + T_tid, NT = C.G * 512;
      for (int i = gt; i < M * PLE / 4; i += NT) st4bf(PB + (size_t)i * 4, p4[i]); }
    { float* WR = WSP(float, WS_WR); const float* g2 = CIN(10); const float* wrg = CIN(11); const float* wre = CIN(13);
        for (int i = C.vcu * 512 + T_tid; i < 1024 * 48; i += C.G * 512) { const int k = i / 48, c = i - k * 48; WR[i] = c < 4 ? g2[k] * wrg[k * 4 + c] : (c < 36 ? g2[k] * wre[k * 32 + (c - 4)] : 0.f); } }
    if (C.vcu == 0) { float* lb = (float*)(C.ws + WS_SMALL + SM_LB); const float* l = CIN(4); const float l0 = l[T_tid], l1 = l[512 + T_tid]; lb[T_tid] = 1.f / (1.f + __expf(l1 - l0)); }
}
__device__ __forceinline__ void p2_naive_hgrn(const Ctx& C, int bh) {
    const int T_tid = tid_opaque(C.wave_s), T_lane = T_tid & 63, T_wave = C.wave_s; (void)T_lane; (void)T_wave;
    const bf16_t* QH = WSP(bf16_t, WS_QH); const bf16_t* VH = WSP(bf16_t, WS_VH); bf16_t* GH = WSP(bf16_t, WS_GH); const float* LF = (const float*)((unsigned char*)C.out + 32 * MiB); const float* hg_norm = CIN(5);
    LAS float* sh = (LAS float*)C.lds; const int b = bh >> 2, h = bh & 3, v = T_tid & 127; const bool act = T_tid < 128;
    float S[128];
#pragma unroll
    for (int k = 0; k < 128; ++k) S[k] = 0.f;
    const float gn = hg_norm[v];
    for (int t = 0; t < SEQ; ++t) { const size_t o512 = (size_t)(b * SEQ + t) * 512 + h * 128 + v; float vv = 0.f;
        if (act) { const float lf = LF[o512]; sh[v] = bf2f(QH[o512]); sh[128 + v] = __expf(lf); sh[256 + v] = -expm1f(lf); vv = bf2f(VH[o512]); }
        __syncthreads();
        float o = 0.f;
        if (act) {
#pragma unroll
            for (int k = 0; k < 128; ++k) { S[k] = sh[128 + k] * S[k] + sh[256 + k] * vv; o += sh[k] * S[k]; if ((k & 15) == 15) asm volatile("" ::: "memory"); } }
        const float ss = wave_sum(o * o); if (act && (v & 63) == 0) sh[384 + (v >> 6)] = ss;
        __syncthreads();
        if (act) { const float tot = sh[384] + sh[385]; const float y = o * rsqrtf(tot * (1.f / 128.f) + EPS) * gn * bf2f(GH[o512]); GH[o512] = (bf16_t)f2bf(y); }
    }
}
__device__ __forceinline__ void p2_naive_ret(const Ctx& C, int bh) {
    const int T_tid = tid_opaque(C.wave_s), T_lane = T_tid & 63, T_wave = C.wave_s; (void)T_lane; (void)T_wave;
    const bf16_t* RQ = WSP(bf16_t, WS_RQ); const bf16_t* RK = WSP(bf16_t, WS_RK); const bf16_t* RV = WSP(bf16_t, WS_RV); bf16_t* RG = WSP(bf16_t, WS_RG); const float* ret_norm = CIN(6);
    LAS float* sh = (LAS float*)C.lds; const int b = bh >> 2, h = bh & 3, v = T_tid & 255; const bool act = T_tid < 256;
    float S[128];
#pragma unroll
    for (int k = 0; k < 128; ++k) S[k] = 0.f;
    const float gn = ret_norm[v]; const float lg = gamma_lg(h), gam = __expf(lg);
    for (int t = 0; t < SEQ; ++t) { const size_t m = (size_t)(b * SEQ + t); const int tm = t & 127; float vv = 0.f;
        if (T_tid < 128) { sh[v] = bf2f(RQ[m * 512 + h * 128 + v]) * __expf(-(float)tm * lg); sh[128 + v] = bf2f(RK[m * 512 + h * 128 + v]) * __expf((float)tm * lg); }
        if (act) vv = bf2f(RV[m * 1024 + h * 256 + v]);
        __syncthreads();
        float o = 0.f;
        if (act) {
#pragma unroll
            for (int k = 0; k < 128; ++k) { S[k] = gam * S[k] + sh[128 + k] * vv; o += sh[k] * S[k]; if ((k & 15) == 15) asm volatile("" ::: "memory"); } }
        const float ss = wave_sum(o * o); if (act && (v & 63) == 0) sh[384 + (v >> 6)] = ss;
        __syncthreads();
        if (act) { const float tot = (sh[384] + sh[385]) + (sh[386] + sh[387]); const size_t oi = m * 1024 + h * 256 + v;
            const float y = o * rsqrtf(tot * (1.f / 256.f) + EPS) * gn * bf2f(RG[oi]); RG[oi] = (bf16_t)f2bf(y); }
    }
}
__device__ __forceinline__ void p6_router(const Ctx& C, gu32* ctl) {
    const int T_tid = tid_opaque(C.wave_s), T_lane = T_tid & 63, T_wave = C.wave_s; (void)T_lane; (void)T_wave;
    const int gw = C.vcu * NWAVES + T_wave, NGW = C.G * NWAVES;
    { LAS float* scr = (LAS float*)(C.lds + T_wave * 16384);
      constexpr int I_G = 16 * 8, I_D = 4 * 32, PER_E = 2 * I_G + I_D;
      for (int rep7_ = 0; rep7_ < (MK_DUP == 70 ? 2 : 1); ++rep7_)
      for (int it = gw; it < NE * PER_E; it += NGW) { const int e = it / PER_E; int r = it - e * PER_E;
          if (r < I_G) { transpose_item<2>(CIN(15) + (size_t)e * 1024 * 256, 1024, 256, WSP(bf16_t, WS_WGU), e * 512, scr, r, T_lane, CIN(10)); continue; } r -= I_G;
          if (r < I_G) { transpose_item<2>(CIN(16) + (size_t)e * 1024 * 256, 1024, 256, WSP(bf16_t, WS_WGU), e * 512 + 128, scr, r, T_lane, CIN(10)); continue; } r -= I_G;
          transpose_item<0>(CIN(17) + (size_t)e * 256 * 1024, 256, 1024, WSP(bf16_t, WS_WD), e * 1024, scr, r, T_lane, nullptr); } }
    const float* X1 = C.out; const float* WR = WSP(float, WS_WR); const float* brg = CIN(12); const float* bre = CIN(14);
    float* rs2 = (float*)(C.ws + WS_SMALL + SM_RS2); float* wgt = (float*)(C.ws + WS_SMALL + SM_WGT); int* list = WSP(int, WS_LIST); gu32* cnt = ctl + CW_CNT;
    const int fr = T_lane & 15, fq = T_lane >> 4, tile = T_wave & 3, kh = T_wave >> 2;
    constexpr int WST = 52, WCH = 2 * 128 * WST;
    LAS float* wbuf = (LAS float*)(C.lds);
    LAS float* xacc = (LAS float*)(C.lds + 106496);
    LAS float* lgt = (LAS float*)(C.lds + 106496 + 12288);
    LAS float* xss = (LAS float*)(C.lds + ROWINFO_OFF);
    LAS unsigned* hist = (LAS unsigned*)(C.lds + ROWINFO_OFF + 256); LAS unsigned* hbase = hist + 32;
    __syncthreads();
    if (T_tid < NE) hist[T_tid] = 0u;
    for (int tb = C.vcu; tb < M / 64; tb += C.G) {
        const int m = tb * 64 + tile * 16 + fr; int e1 = 0, e2 = 0, r1 = 0, r2 = 0; bool sel = false;
        const float* xr = X1 + (size_t)m * D + kh * 512 + 4 * fq;
        f32x4 xc[8], xn[8];
#pragma unroll
        for (int j = 0; j < 8; ++j) xc[j] = *(const f32x4*)(xr + 16 * j);
        f32x4 wreg[6];
#define RT_LOADW(cs_) do { _Pragma("unroll") for (int q = 0; q < 6; ++q) { const int pc = T_tid + 512 * q, row = pc / 12, c4 = pc - row * 12; \
            wreg[q] = *(const f32x4*)(WR + (size_t)((row >> 7) * 512 + (cs_) * 128 + (row & 127)) * 48 + 4 * c4); } } while (0)
#define RT_STOREW(buf_) do { _Pragma("unroll") for (int q = 0; q < 6; ++q) { const int pc = T_tid + 512 * q, row = pc / 12, c4 = pc - row * 12; \
            *(LAS f32x4*)(wbuf + (buf_) * WCH + row * WST + 4 * c4) = wreg[q]; } } while (0)
        RT_LOADW(0); RT_STOREW(0);
        f32x4 acc[3]; acc[0] = acc[1] = acc[2] = (f32x4){0.f, 0.f, 0.f, 0.f}; float ss = 0.f;
        __syncthreads();
#pragma unroll
        for (int cs = 0; cs < 4; ++cs) {
            if (cs + 1 < 4) { RT_LOADW(cs + 1);
#pragma unroll
                for (int j = 0; j < 8; ++j) xn[j] = *(const f32x4*)(xr + 16 * ((cs + 1) * 8 + j)); }
            const LAS float* wb = wbuf + (cs & 1) * WCH + (kh * 128 + 4 * fq) * WST + fr;
#pragma unroll
            for (int jj = 0; jj < 8; ++jj) { const f32x4 x4 = xc[jj]; ss += (x4[0] * x4[0] + x4[1] * x4[1]) + (x4[2] * x4[2] + x4[3] * x4[3]);
#pragma unroll
                for (int i = 0; i < 4; ++i)
#pragma unroll
                    for (int nt = 0; nt < 3; ++nt) acc[nt] = __builtin_amdgcn_mfma_f32_16x16x4f32(x4[i], wb[(16 * jj + i) * WST + 16 * nt], acc[nt], 0, 0, 0); }
            if (cs + 1 < 4) { RT_STOREW((cs + 1) & 1); __syncthreads();
#pragma unroll
                for (int j = 0; j < 8; ++j) xc[j] = xn[j]; }
        }
#undef RT_LOADW
#undef RT_STOREW
        ss += __shfl_xor(ss, 16); ss += __shfl_xor(ss, 32);
        if (kh == 1) {
#pragma unroll
            for (int nt = 0; nt < 3; ++nt) *(LAS f32x4*)(xacc + ((tile * 3 + nt) * 64 + T_lane) * 4) = acc[nt];
            if (fq == 0) xss[tile * 16 + fr] = ss; }
        __syncthreads();
        if (kh == 0) {
#pragma unroll
            for (int nt = 0; nt < 3; ++nt) { acc[nt] = acc[nt] + *(const LAS f32x4*)(xacc + ((tile * 3 + nt) * 64 + T_lane) * 4);
#pragma unroll
                for (int r = 0; r < 4; ++r) lgt[(tile * 16 + 4 * fq + r) * 48 + 16 * nt + fr] = acc[nt][r]; }
            ss += xss[tile * 16 + fr];
            asm volatile("s_waitcnt lgkmcnt(0)" ::: "memory");
            if (T_lane < 16) { const int mt = tb * 64 + tile * 16 + T_lane; const float rs = rsqrtf(ss * (1.f / D) + EPS); rs2[mt] = rs;
                float lg[36];
#pragma unroll
                for (int c4 = 0; c4 < 9; ++c4) { const f32x4 q4 = *(const LAS f32x4*)(lgt + (tile * 16 + T_lane) * 48 + 4 * c4); lg[4 * c4] = q4[0] * rs; lg[4 * c4 + 1] = q4[1] * rs; lg[4 * c4 + 2] = q4[2] * rs; lg[4 * c4 + 3] = q4[3] * rs; }
                float gl[4];
#pragma unroll
                for (int c = 0; c < 4; ++c) gl[c] = lg[c] + brg[c];
                float gmax = gl[0]; int gi = 0;
#pragma unroll
                for (int c = 1; c < 4; ++c) if (gl[c] > gmax) { gmax = gl[c]; gi = c; }
                float den = 0.f;
#pragma unroll
                for (int c = 0; c < 4; ++c) den += __expf(gl[c] - gmax);
                const float gw_ = 1.f / den;
                float el[8];
#pragma unroll
                for (int c = 0; c < 8; ++c) { el[c] = 0.f;
#pragma unroll
                    for (int g = 0; g < 4; ++g) if (g == gi) el[c] = lg[4 + g * 8 + c] + bre[g * 8 + c]; }
                float m1 = el[0]; int i1 = 0;
#pragma unroll
                for (int c = 1; c < 8; ++c) if (el[c] > m1) { m1 = el[c]; i1 = c; }
                float m2 = -3.0e38f; int i2 = 0;
#pragma unroll
                for (int c = 0; c < 8; ++c) if (c != i1 && el[c] > m2) { m2 = el[c]; i2 = c; }
                const float w1 = 1.f / (1.f + __expf(m2 - m1)), w2 = 1.f - w1;
                e1 = gi * 8 + i1; e2 = gi * 8 + i2; sel = true;
                wgt[2 * mt] = w1 * gw_; wgt[2 * mt + 1] = w2 * gw_;
                r1 = (int)__hip_atomic_fetch_add(hist + e1, 1u, __ATOMIC_RELAXED, __HIP_MEMORY_SCOPE_WORKGROUP);
                r2 = (int)__hip_atomic_fetch_add(hist + e2, 1u, __ATOMIC_RELAXED, __HIP_MEMORY_SCOPE_WORKGROUP); } }
        __syncthreads();
        if (T_tid < NE) { const unsigned n = hist[T_tid]; hbase[T_tid] = n ? __hip_atomic_fetch_add(cnt + 64 * T_tid, n, __ATOMIC_RELAXED, __HIP_MEMORY_SCOPE_AGENT) : 0u; }
        __syncthreads();
        if (sel) { const int mt = tb * 64 + tile * 16 + T_lane; list[e1 * LIST_CAP + (int)hbase[e1] + r1] = 2 * mt; list[e2 * LIST_CAP + (int)hbase[e2] + r2] = 2 * mt + 1; }
        __syncthreads();
        if (T_tid < NE) hist[T_tid] = 0u;
    }
}
__device__ __forceinline__ int moe_plan(const Ctx& C, gu32* ctl) {
    const int T_tid = tid_opaque(C.wave_s), T_lane = T_tid & 63, T_wave = C.wave_s; (void)T_lane; (void)T_wave;
    LAS int* offs = (LAS int*)(C.lds + OFFS_OFF); LAS int* tile_e = (LAS int*)(C.lds + TILEE_OFF);
    if (T_tid < NE) offs[33 + T_tid] = (int)__hip_atomic_load(ctl + CW_CNT + 64 * T_tid, __ATOMIC_RELAXED, __HIP_MEMORY_SCOPE_AGENT);
    __syncthreads();
    if (T_tid == 0) { int o = 0;
        for (int e = 0; e < NE; ++e) { const int c = offs[33 + e]; offs[e] = o; const int np = (c + 255) & ~255;
            for (int t = 0; t < np; t += 256) tile_e[(o + t) >> 8] = e; o += np; }
        offs[32] = o; }
    __syncthreads();
    return offs[32] >> 8;
}
template <bool WANT_RS> __device__ __forceinline__ void moe_rowinfo(const Ctx& C, const pg8::GroupOrder& S) {
    const int T_tid = tid_opaque(C.wave_s), T_lane = T_tid & 63, T_wave = C.wave_s; (void)T_lane; (void)T_wave;
    LAS int* offs = (LAS int*)(C.lds + OFFS_OFF); LAS int* tile_e = (LAS int*)(C.lds + TILEE_OFF); LAS int* ri = (LAS int*)(C.lds + ROWINFO_OFF);
    const int* list = WSP(int, WS_LIST); const float* wgt = (const float*)(C.ws + WS_SMALL + SM_WGT); const float* rs2 = (const float*)(C.ws + WS_SMALL + SM_RS2);
    pg8::Unit u;
    for (int i = 0; i < 8 && S.next(i, u); ++i) {
        if (T_tid < 256) { const int e = tile_e[u.pm], idx = u.pm * 256 + T_tid - offs[e]; int a = -1; float w = 0.f;
            if (idx < offs[33 + e]) { a = list[e * LIST_CAP + idx]; w = WANT_RS ? rs2[a >> 1] : wgt[a]; }
            ri[i * 512 + T_tid] = a; ((LAS float*)ri)[i * 512 + 256 + T_tid] = w; } }
    __syncthreads();
}
__device__ __forceinline__ void p9_combine(const Ctx& C) {
    const int T_tid = tid_opaque(C.wave_s), T_lane = T_tid & 63, T_wave = C.wave_s; (void)T_lane; (void)T_wave;
    const int gw = C.vcu * NWAVES + T_wave, NGW = C.G * NWAVES; float* X = C.out; const bf16_t* YS = WSP(bf16_t, WS_YS); bf16_t* X2B = WSP(bf16_t, WS_X2B);
    for (int m = gw; m < M; m += NGW) { const int lane = T_lane;
        f32x4* xr = (f32x4*)(X + (size_t)m * D) + lane; f32x4 v[4]; float s = 0.f;
#pragma unroll
        for (int j = 0; j < 4; ++j) { const int c = lane * 4 + 256 * j; v[j] = xr[64 * j] + ld4bf(YS + (size_t)(2 * m) * D + c) + ld4bf(YS + (size_t)(2 * m + 1) * D + c);
            s += (v[j][0] * v[j][0] + v[j][1] * v[j][1]) + (v[j][2] * v[j][2] + v[j][3] * v[j][3]); }
        s = wave_sum(s); const float rs = rsqrtf(s * (1.f / D) + EPS);
#pragma unroll
        for (int j = 0; j < 4; ++j) { xr[64 * j] = v[j]; st4bf(X2B + (size_t)m * D + lane * 4 + 256 * j, v[j] * rs); } }
}
__device__ __forceinline__ void p11_final(const Ctx& C, const float oscale) {
    const int T_tid = tid_opaque(C.wave_s), T_lane = T_tid & 63, T_wave = C.wave_s; (void)T_lane; (void)T_wave;
    const int gw = C.vcu * NWAVES + T_wave, NGW = C.G * NWAVES; float* X = C.out; const float* g = CIN(21);
    for (int m = gw; m < M; m += NGW) { const int lane = T_lane;
        f32x4* xr = (f32x4*)(X + (size_t)m * D) + lane; f32x4 v[4]; float s = 0.f;
#pragma unroll
        for (int j = 0; j < 4; ++j) { v[j] = xr[64 * j]; s += (v[j][0] * v[j][0] + v[j][1] * v[j][1]) + (v[j][2] * v[j][2] + v[j][3] * v[j][3]); }
        s = wave_sum(s); const float rs = rsqrtf(s * (1.f / D) + EPS);
#pragma unroll
        for (int j = 0; j < 4; ++j) { const f32x4 gg = *(const f32x4*)(g + lane * 4 + 256 * j); xr[64 * j] = v[j] * (rs * oscale) * gg; } }
}

__device__ __forceinline__ int rho(int p) { return (p & ~31) | (((p >> 2) & 1) << 4) | (((p >> 3) & 3) << 2) | (p & 3); }
constexpr int MX_QL = 0, MX_KL = 17408, MX_KT = 34816, MX_VT = 53248, MX_PL = 90112, MX_CH = 99328, MX_SSQ = 102912, MX_INV = 104960;
constexpr int QSTR = 272, TSTR = 144;
constexpr size_t OUT_UH = 0, OUT_UR = 8 * MiB;
constexpr size_t SM_DH = SM_RS3;
typedef pg8::bf16x8 bfx8;
#define MFMA16(a, b, c) __builtin_amdgcn_mfma_f32_16x16x32_bf16((a), (b), (c), 0, 0, 0)
#define LDS_B128(off) (*(const LAS bfx8*)(lds + (off)))

template <int NT, bool HG, bool STATE_ONLY>
__device__ __forceinline__ void mixer_unit(const Ctx& C, const int b, const int h, const int seg) {
    const int tid0 = tid_opaque(C.wave_s), w = C.wave_s;
    LAS unsigned char* lds = C.lds;
    constexpr int DV = NT * 128, LDV = HG ? 512 : 1024;
    const int bh = b * 4 + h, unit = bh * 16 + seg, m0 = b * SEQ + seg * 512;
    const bf16_t* Qg = WSP(bf16_t, HG ? WS_QH : WS_RQ) + h * 128; const bf16_t* Kg = WSP(bf16_t, WS_RK) + h * 128;
    const bf16_t* Vg = WSP(bf16_t, HG ? WS_VH : WS_RV) + h * DV; bf16_t* Gg = WSP(bf16_t, HG ? WS_GH : WS_RG) + h * DV;
    const float* LFg = (const float*)((unsigned char*)C.out + 32 * MiB) + h * 128;
    float* Ug = (float*)((unsigned char*)C.out + (HG ? OUT_UH : OUT_UR)) + (size_t)unit * 128 * DV;
    float* DHg = (float*)(C.ws + WS_SMALL + SM_DH) + unit * 128;
    const float* gn = HG ? CIN(5) : CIN(6);
    const float lgam = gamma_lg(h), g128 = __expf(128.f * lgam);
    LAS float* ch_emid = (LAS float*)(lds + MX_CH); LAS float* ch_elm = ch_emid + 128; LAS float* ch_dl = ch_emid + 256; LAS float* ch_part = ch_emid + 384;
    LAS float* ssq = (LAS float*)(lds + MX_SSQ); LAS float* invs = (LAS float*)(lds + MX_INV);

    f32x4 S[8][NT];
    { const int lane = tid0 & 63, fr = lane & 15, fq = lane >> 4;
#pragma unroll
    for (int kt = 0; kt < 8; ++kt)
#pragma unroll
        for (int nt = 0; nt < NT; ++nt) {
            if (STATE_ONLY) S[kt][nt] = (f32x4){0.f, 0.f, 0.f, 0.f};
            else { const float* up = Ug + (size_t)(16 * kt + 4 * fq) * DV + 16 * (w * NT + nt) + fr;
                S[kt][nt] = (f32x4){up[0], up[DV], up[2 * DV], up[3 * DV]}; } } }
    float bseg = 0.f;
    float lfr[16]; unsigned short qr16[16]; pg8::u32x4 qrw[2], krw[2], vrw[2 * NT];
#define MX_LOAD(cc) do { const int r0_ = m0 + 64 * (cc); int t_ = tid0; asm volatile("" : "+v"(t_)); const int hk = t_ & 127, hqd = t_ >> 7, lane = t_ & 63; \
        if (HG) { _Pragma("unroll") for (int i = 0; i < 16; ++i) { const size_t gi = (size_t)(r0_ + 16 * hqd + i) * 512 + hk; lfr[i] = LFg[gi]; if (!STATE_ONLY) qr16[i] = Qg[gi]; } } \
        else { _Pragma("unroll") for (int i = 0; i < 2; ++i) { const size_t gi = (size_t)(r0_ + lane) * 512 + (2 * w + i) * 8; if (!STATE_ONLY) qrw[i] = *(const pg8::u32x4*)(Qg + gi); krw[i] = *(const pg8::u32x4*)(Kg + gi); } } \
        _Pragma("unroll") for (int i = 0; i < 2 * NT; ++i) vrw[i] = *(const pg8::u32x4*)(Vg + (size_t)(r0_ + lane) * LDV + (2 * NT * w + i) * 8); } while (0)
    MX_LOAD(0);

    for (int c = 0; c < 8; ++c) {
        const int r0 = m0 + 64 * c;
        int tid = tid0; asm volatile("" : "+v"(tid));
        const int lane = tid & 63, fr = lane & 15, fq = lane >> 4, hk = tid & 127, hqd = tid >> 7;
        unsigned short gcur[16 * NT];
        if (HG) {
            const int k = hk, qd = hqd, rr = rho(k);
            float cs[16], qv[16], kk[16];
#pragma unroll
            for (int i = 0; i < 16; ++i) { cs[i] = lfr[i]; qv[i] = STATE_ONLY ? 0.f : bf2f(qr16[i]); }
#pragma unroll
            for (int i = 0; i < 16; ++i) kk[i] = 1.f - __expf(cs[i]);
#pragma unroll
            for (int i = 1; i < 16; ++i) cs[i] += cs[i - 1];
            ch_part[qd * 128 + k] = cs[15];
            __syncthreads();
            const float p0 = ch_part[k], p1 = ch_part[128 + k], p2 = ch_part[256 + k], p3 = ch_part[384 + k];
            const float off = (qd > 0 ? p0 : 0.f) + (qd > 1 ? p1 : 0.f) + (qd > 2 ? p2 : 0.f), bmid = p0 + p1, blast = (p0 + p1) + (p2 + p3);
            unsigned kb[16];
#pragma unroll
            for (int i = 0; i < 16; ++i) { const int t = 16 * qd + i; const float e1 = __expf(fminf(fmaxf(off + cs[i] - bmid, -80.f), 80.f)); const float kt_ = kk[i] * __builtin_amdgcn_rcpf(e1);
                kb[i] = f2bf(kt_);
                if (!STATE_ONLY) { *(LAS unsigned short*)(lds + MX_QL + t * QSTR + 2 * k) = (unsigned short)f2bf(qv[i] * e1); *(LAS unsigned short*)(lds + MX_KL + t * QSTR + 2 * k) = (unsigned short)kb[i]; } }
            { pg8::u32x4 w0, w1; w0.x = kb[0] | (kb[1] << 16); w0.y = kb[2] | (kb[3] << 16); w0.z = kb[4] | (kb[5] << 16); w0.w = kb[6] | (kb[7] << 16);
              w1.x = kb[8] | (kb[9] << 16); w1.y = kb[10] | (kb[11] << 16); w1.z = kb[12] | (kb[13] << 16); w1.w = kb[14] | (kb[15] << 16);
              *(LAS pg8::u32x4*)(lds + MX_KT + rr * TSTR + 32 * qd) = w0; *(LAS pg8::u32x4*)(lds + MX_KT + rr * TSTR + 32 * qd + 16) = w1; }
            if (qd == 0) { ch_emid[rr] = __expf(bmid); ch_elm[rr] = __expf(blast - bmid); ch_dl[rr] = __expf(blast); bseg += blast; }
        } else {
#pragma unroll
            for (int i = 0; i < 2; ++i) { const int pc = 2 * w + i;
                if (!STATE_ONLY) { *(LAS pg8::u32x4*)(lds + MX_QL + lane * QSTR + pc * 16) = qrw[i]; *(LAS pg8::u32x4*)(lds + MX_KL + lane * QSTR + pc * 16) = krw[i]; }
                const unsigned kwv[4] = {krw[i].x, krw[i].y, krw[i].z, krw[i].w};
#pragma unroll
                for (int j = 0; j < 8; ++j) { const unsigned short e = (unsigned short)(kwv[j >> 1] >> (16 * (j & 1))); *(LAS unsigned short*)(lds + MX_KT + rho(pc * 8 + j) * TSTR + 2 * lane) = e; } }
        }
#pragma unroll
        for (int i = 0; i < 2 * NT; ++i) { const int pc = 2 * NT * w + i; const unsigned vwv[4] = {vrw[i].x, vrw[i].y, vrw[i].z, vrw[i].w};
#pragma unroll
            for (int j = 0; j < 8; ++j) { const unsigned short e = (unsigned short)(vwv[j >> 1] >> (16 * (j & 1))); *(LAS unsigned short*)(lds + MX_VT + (pc * 8 + j) * TSTR + 2 * lane) = e; } }
        if (c + 1 < 8) MX_LOAD(c + 1);
        if (!STATE_ONLY) {
#pragma unroll
            for (int nt = 0; nt < NT; ++nt)
#pragma unroll
                for (int mt = 0; mt < 4; ++mt)
#pragma unroll
                    for (int r = 0; r < 4; ++r) gcur[(nt * 4 + mt) * 4 + r] = Gg[(size_t)(r0 + 16 * mt + 4 * fq + r) * LDV + 16 * (w * NT + nt) + fr]; }
        __syncthreads();

        f32x4 o[4][NT];
        if (!STATE_ONLY) {
#pragma unroll
            for (int i = 0; i < 2; ++i) { const int id = 2 * w + i, si = id >> 2, ti = id & 3; f32x4 a = (f32x4){0.f, 0.f, 0.f, 0.f};
                if (si <= ti) {
#pragma unroll
                    for (int ks = 0; ks < 4; ++ks) a = MFMA16(LDS_B128(MX_KL + (16 * si + fr) * QSTR + 64 * ks + 16 * fq), LDS_B128(MX_QL + (16 * ti + fr) * QSTR + 64 * ks + 16 * fq), a);
                    if (si == ti) {
#pragma unroll
                        for (int r = 0; r < 4; ++r) if (4 * fq + r > fr) a[r] = 0.f; } }
                u32x2 pw; pw.x = pk2(a[0], a[1]); pw.y = pk2(a[2], a[3]);
                *(LAS u32x2*)(lds + MX_PL + (16 * ti + fr) * TSTR + 2 * (16 * si + 4 * fq)) = pw; }
            __syncthreads();
#pragma unroll
            for (int mt = 0; mt < 4; ++mt)
#pragma unroll
                for (int nt = 0; nt < NT; ++nt) o[mt][nt] = (f32x4){0.f, 0.f, 0.f, 0.f};
#pragma unroll
            for (int ks = 0; ks < 4; ++ks) { bfx8 bf[NT];
#pragma unroll
                for (int nt = 0; nt < NT; ++nt) { f32x4 s0 = S[2 * ks][nt], s1 = S[2 * ks + 1][nt];
                    if (HG) { s0 = s0 * *(const LAS f32x4*)(ch_emid + 32 * ks + 4 * fq); s1 = s1 * *(const LAS f32x4*)(ch_emid + 32 * ks + 16 + 4 * fq); }
                    pg8::u32x4 pk; pk.x = pk2(s0[0], s0[1]); pk.y = pk2(s0[2], s0[3]); pk.z = pk2(s1[0], s1[1]); pk.w = pk2(s1[2], s1[3]); bf[nt] = __builtin_bit_cast(bfx8, pk); }
#pragma unroll
                for (int mt = 0; mt < 4; ++mt) { const bfx8 af = LDS_B128(MX_QL + (16 * mt + fr) * QSTR + 64 * ks + 16 * fq);
#pragma unroll
                    for (int nt = 0; nt < NT; ++nt) o[mt][nt] = MFMA16(af, bf[nt], o[mt][nt]); } }
#pragma unroll
            for (int ks = 0; ks < 2; ++ks) { bfx8 vf[NT];
#pragma unroll
                for (int nt = 0; nt < NT; ++nt) vf[nt] = LDS_B128(MX_VT + (16 * (w * NT + nt) + fr) * TSTR + 64 * ks + 16 * fq);
#pragma unroll
                for (int mt = 0; mt < 4; ++mt) { if (32 * ks > 16 * mt + 15) continue;
                    const bfx8 af = LDS_B128(MX_PL + (16 * mt + fr) * TSTR + 64 * ks + 16 * fq);
#pragma unroll
                    for (int nt = 0; nt < NT; ++nt) o[mt][nt] = MFMA16(af, vf[nt], o[mt][nt]); } }
        }
        if (HG) {
            f32x4 P[8][NT];
#pragma unroll
            for (int kt = 0; kt < 8; ++kt)
#pragma unroll
                for (int nt = 0; nt < NT; ++nt) P[kt][nt] = (f32x4){0.f, 0.f, 0.f, 0.f};
#pragma unroll
            for (int ks = 0; ks < 2; ++ks) { bfx8 vf[NT];
#pragma unroll
                for (int nt = 0; nt < NT; ++nt) vf[nt] = LDS_B128(MX_VT + (16 * (w * NT + nt) + fr) * TSTR + 64 * ks + 16 * fq);
#pragma unroll
                for (int kt = 0; kt < 8; ++kt) { const bfx8 af = LDS_B128(MX_KT + (16 * kt + fr) * TSTR + 64 * ks + 16 * fq);
#pragma unroll
                    for (int nt = 0; nt < NT; ++nt) P[kt][nt] = MFMA16(af, vf[nt], P[kt][nt]); } }
#pragma unroll
            for (int kt = 0; kt < 8; ++kt) { const f32x4 dl = *(const LAS f32x4*)(ch_dl + 16 * kt + 4 * fq), el = *(const LAS f32x4*)(ch_elm + 16 * kt + 4 * fq);
#pragma unroll
                for (int nt = 0; nt < NT; ++nt) S[kt][nt] = dl * S[kt][nt] + el * P[kt][nt]; }
        } else {
#pragma unroll
            for (int ks = 0; ks < 2; ++ks) { bfx8 vf[NT];
#pragma unroll
                for (int nt = 0; nt < NT; ++nt) vf[nt] = LDS_B128(MX_VT + (16 * (w * NT + nt) + fr) * TSTR + 64 * ks + 16 * fq);
#pragma unroll
                for (int kt = 0; kt < 8; ++kt) { const bfx8 af = LDS_B128(MX_KT + (16 * kt + fr) * TSTR + 64 * ks + 16 * fq);
#pragma unroll
                    for (int nt = 0; nt < NT; ++nt) S[kt][nt] = MFMA16(af, vf[nt], S[kt][nt]); } }
            if (c & 1) {
#pragma unroll
                for (int kt = 0; kt < 8; ++kt)
#pragma unroll
                    for (int nt = 0; nt < NT; ++nt) S[kt][nt] = S[kt][nt] * g128; }
        }
        if (!STATE_ONLY) {
#pragma unroll
            for (int mt = 0; mt < 4; ++mt)
#pragma unroll
                for (int r = 0; r < 4; ++r) { float q = 0.f;
#pragma unroll
                    for (int nt = 0; nt < NT; ++nt) q += o[mt][nt][r] * o[mt][nt][r];
                    q += __shfl_xor(q, 1); q += __shfl_xor(q, 2); q += __shfl_xor(q, 4); q += __shfl_xor(q, 8);
                    if (fr == 0) ssq[w * 64 + 16 * mt + 4 * fq + r] = q; }
            __syncthreads();
            if (tid < 64) { float tot = 0.f;
#pragma unroll
                for (int ww = 0; ww < 8; ++ww) tot += ssq[ww * 64 + tid];
                invs[tid] = rsqrtf(tot * (1.f / DV) + EPS); }
            __syncthreads();
#pragma unroll
            for (int nt = 0; nt < NT; ++nt) { const int v = 16 * (w * NT + nt) + fr; const float g = gn[v];
#pragma unroll
                for (int mt = 0; mt < 4; ++mt)
#pragma unroll
                    for (int r = 0; r < 4; ++r) { const int t = 16 * mt + 4 * fq + r; bf16_t* gp = Gg + (size_t)(r0 + t) * LDV + v;
                        *gp = (bf16_t)f2bf(o[mt][nt][r] * invs[t] * g * bf2f(gcur[(nt * 4 + mt) * 4 + r])); } }
        } else { __syncthreads(); }
    }
    if (STATE_ONLY) { const int tid = tid0, lane = tid & 63, fr = lane & 15, fq = lane >> 4;
#pragma unroll
        for (int kt = 0; kt < 8; ++kt)
#pragma unroll
            for (int nt = 0; nt < NT; ++nt) { float* up = Ug + (size_t)(16 * kt + 4 * fq) * DV + 16 * (w * NT + nt) + fr;
                up[0] = S[kt][nt][0]; up[DV] = S[kt][nt][1]; up[2 * DV] = S[kt][nt][2]; up[3 * DV] = S[kt][nt][3]; }
        if (HG && tid < 128) DHg[rho(tid)] = __expf(bseg);
    }
#undef MX_LOAD
}
__device__ __forceinline__ void mixer_scan(const Ctx& C) {
    const int tid = tid_opaque(C.wave_s); const int gt = C.vcu * 512 + tid;
    float* UH = (float*)((unsigned char*)C.out + OUT_UH); float* UR = (float*)((unsigned char*)C.out + OUT_UR); const float* DH = (const float*)(C.ws + WS_SMALL + SM_DH);
    { const int bh = gt >> 14, e = gt & 16383, row = e >> 7; float carry = 0.f;
      for (int s = 0; s < 16; ++s) { float* p = UH + ((size_t)(bh * 16 + s) << 14) + e; const float u = *p; *p = carry; carry = DH[(bh * 16 + s) * 128 + row] * carry + u; } }
#pragma unroll 1
    for (int i = 0; i < 2; ++i) { const int g2 = gt + i * 131072; const int bh = g2 >> 15, e = g2 & 32767; const float d = __expf(512.f * gamma_lg(bh & 3)); float carry = 0.f;
      for (int s = 0; s < 16; ++s) { float* p = UR + ((size_t)(bh * 16 + s) << 15) + e; const float u = *p; *p = carry; carry = d * carry + u; } }
}
template <bool STATE_ONLY> __device__ __forceinline__ void mixer_phase(const Ctx& C) {
    for (int uu = C.vcu; uu < 256; uu += C.G) { const int u = uu & 127, b = u >> 6, h = (u >> 4) & 3, seg = u & 15;
        if (uu < 128) mixer_unit<1, true, STATE_ONLY>(C, b, h, seg); else mixer_unit<2, false, STATE_ONLY>(C, b, h, seg); }
}

#ifndef MK_DRY1
#define MK_DRY1 0
#endif
#ifndef MK_STAG1
#define MK_STAG1 0
#define MK_STAGN 2
#endif
#ifndef MK_TS
#define MK_TS -1
#endif
#ifndef MK_TS_SCALE
#define MK_TS_SCALE 8e-3f
#endif
__global__ void __launch_bounds__(NWAVES * 64, 2) fwd(Args args) {
    extern __shared__ __attribute__((aligned(16))) unsigned char lds_raw[];
    Ctx C; C.lds = (LAS unsigned char*)lds_raw; C.wave_s = __builtin_amdgcn_readfirstlane((int)threadIdx.x >> 6);
    C.G = gridDim.x; { const int bx = blockIdx.x; C.vcu = (C.G % 8 == 0) ? (bx % 8) * (C.G / 8) + bx / 8 : bx; }
    C.in = args.in; C.out = args.out; C.ws = args.ws;
    gu32* ctl = (gu32*)(args.ws + WS_CTL);
    volatile LAS unsigned* MISC = (volatile LAS unsigned*)(C.lds + MISC_OFF);
    for (int u = threadIdx.x; u < (2048) / 4; u += NWAVES * 64) ((LAS unsigned*)(C.lds + LDSCTL_OFF))[u] = 0u;
    __syncthreads();
    XcdBarrier bar; bar.bar = (unsigned*)(ctl + CW_BAR); bar.x = 0; bar.st = nullptr;
    if (!MK_PER_PHASE) bar = xcd_barrier_post((unsigned*)(ctl + CW_BAR), MISC + 8);
    const int lo = args.ph_lo, hi = args.ph_hi;
    if (MK_TS >= 0 && blockIdx.x == 0 && threadIdx.x == 0) { volatile LAS unsigned long long* tsl_ = (volatile LAS unsigned long long*)(C.lds + MISC_OFF + 64); const unsigned long long now_ = __builtin_amdgcn_s_memrealtime(); tsl_[0] = now_; tsl_[1] = now_; tsl_[2] = now_; }
#define IN(k) (lo <= (k) && (k) < hi)
#define SEAM(k) do { if (MK_TS >= 0 && blockIdx.x == 0 && threadIdx.x == 0) { const unsigned long long now_ = __builtin_amdgcn_s_memrealtime(); \
        volatile LAS unsigned long long* tsl_ = (volatile LAS unsigned long long*)(C.lds + MISC_OFF + 64); if ((k) == MK_TS - 1) tsl_[1] = now_; if ((k) == MK_TS) tsl_[2] = now_; \
        if ((k) == 11) { const float frac_ = (float)(tsl_[2] - tsl_[1]) / (float)(now_ - tsl_[0]); __hip_atomic_store((float*)(ctl + 2048), sqrtf(frac_ * MK_TS_SCALE), __ATOMIC_RELAXED, __HIP_MEMORY_SCOPE_AGENT); } } \
    if (IN(k) && IN((k) + 1)) xcd_barrier(bar, C.wave_s); } while (0)

#define REPS(k) for (int rep_ = 0; rep_ < ((k) == MK_DUP ? 2 : 1); ++rep_)
#define REPBAR() do { if (rep_) xcd_barrier(bar, C.wave_s); } while (0)
    PG8_LAS unsigned char* ring = (PG8_LAS unsigned char*)C.lds;
    using namespace pg8;
    if (IN(0)) REPS(0) { REPBAR();  p0_prologue(C); } SEAM(0);
    if (IN(1)) REPS(1) { REPBAR();
#if MK_STAG1 > 0
        { const unsigned long long t0_ = __builtin_amdgcn_s_memrealtime(); const unsigned long long dl_ = (unsigned long long)((blockIdx.x >> 3) & (MK_STAGN - 1)) * MK_STAG1;
          while (__builtin_amdgcn_s_memrealtime() - t0_ < dl_) __builtin_amdgcn_s_sleep(8); }
#endif
        Gemm g{(const bf16_t*)C.out, WSP(bf16_t, WS_WIN), M, NIN, 1024}; DenseOrder S; S.init(M, NIN, C.G, (int)blockIdx.x);
        EpiP1 E{(const float*)(C.ws + WS_SMALL + SM_RS1), (const float*)(C.ws + WS_SMALL + SM_LB), (float*)((unsigned char*)C.out + 32 * MiB),
                WSP(bf16_t, WS_QH), WSP(bf16_t, WS_VH), WSP(bf16_t, WS_GH), WSP(bf16_t, WS_RQ), WSP(bf16_t, WS_RK), WSP(bf16_t, WS_RV), WSP(bf16_t, WS_RG), WSP(bf16_t, WS_GA), WSP(bf16_t, WS_GB)};
        gemm_phase<EpiP1, DenseOrder>(ring, C.wave_s, g, S, E);
#if MK_DRY1
        xcd_barrier(bar, C.wave_s); { EpiDry ED; gemm_phase<EpiDry, DenseOrder>(ring, C.wave_s, g, S, ED); }
#endif
        } SEAM(1);
#if MK_NAIVE_MIX
    if (IN(2)) REPS(2) { REPBAR();  if (C.vcu < 8) p2_naive_hgrn(C, C.vcu); else if (C.vcu < 16) p2_naive_ret(C, C.vcu - 8); } SEAM(2); SEAM(3); SEAM(4);
#else
    if (IN(2)) REPS(2) { REPBAR();  mixer_phase<true>(C); } SEAM(2);
    if (IN(3)) REPS(3) { REPBAR();  mixer_scan(C); } SEAM(3);
    if (IN(4)) REPS(4) { REPBAR();  mixer_phase<false>(C); } SEAM(4);
#endif
    if (IN(5)) REPS(5) { REPBAR();  DenseOrder S; S.init(M, 1024, C.G, (int)blockIdx.x);
        { Gemm g{WSP(bf16_t, WS_GH), WSP(bf16_t, WS_WA), M, 1024, 512}; EpiF<EpiGateMul> E{{WSP(bf16_t, WS_GA), WSP(bf16_t, WS_MG)}}; gemm_phase<EpiF<EpiGateMul>, DenseOrder>(ring, C.wave_s, g, S, E); }
        { Gemm g{WSP(bf16_t, WS_RG), WSP(bf16_t, WS_WB), M, 1024, 1024}; EpiF<EpiGateMulAdd> E{{WSP(bf16_t, WS_GB), WSP(bf16_t, WS_MG)}}; gemm_phase<EpiF<EpiGateMulAdd>, DenseOrder>(ring, C.wave_s, g, S, E); } } SEAM(5);
    if (IN(6)) REPS(6) { REPBAR();  DenseOrder S; S.init(M, 1024, C.G, (int)blockIdx.x); Gemm g{WSP(bf16_t, WS_MG), WSP(bf16_t, WS_WO), M, 1024, 1024};
        EpiF<EpiResid, false> E{{CIN(0), C.out, WSP(bf16_t, WS_H2)}}; gemm_phase<EpiF<EpiResid, false>, DenseOrder>(ring, C.wave_s, g, S, E); } SEAM(6);
    if (IN(7)) REPS(7) { REPBAR();  p6_router(C, ctl); } SEAM(7);
    if (IN(8)) REPS(8) { REPBAR();  const int ntiles = moe_plan(C, ctl); GroupOrder S{ntiles, 2, C.G, (int)blockIdx.x, (const PG8_LAS int*)(C.lds + TILEE_OFF)}; moe_rowinfo<true>(C, S);
        Gemm g{WSP(bf16_t, WS_H2), WSP(bf16_t, WS_WGU), 0, 512, 1024}; EpiPairF<EpiGateUp> E{{(const PG8_LAS int*)(C.lds + ROWINFO_OFF), WSP(bf16_t, WS_HM)}};
        gemm_phase<EpiPairF<EpiGateUp>, GroupOrder, true, true, true>(ring, C.wave_s, g, S, E, (const PG8_LAS int*)(C.lds + ROWINFO_OFF)); } SEAM(8);
    if (IN(9)) REPS(9) { REPBAR();  const int ntiles = moe_plan(C, ctl); GroupOrder S{ntiles, 4, C.G, (int)blockIdx.x, (const PG8_LAS int*)(C.lds + TILEE_OFF)}; moe_rowinfo<false>(C, S);
        Gemm g{WSP(bf16_t, WS_HM), WSP(bf16_t, WS_WD), 0, 1024, 256}; EpiF<EpiDown> E{{(const PG8_LAS int*)(C.lds + ROWINFO_OFF), WSP(bf16_t, WS_YS)}};
        gemm_phase<EpiF<EpiDown>, GroupOrder>(ring, C.wave_s, g, S, E); } SEAM(9);
    if (IN(10)) REPS(10) { REPBAR();  p9_combine(C); } SEAM(10);
    if (IN(11)) REPS(11) { REPBAR();  DenseOrder S; S.init(M, 1024, C.G, (int)blockIdx.x);
        { Gemm g{WSP(bf16_t, WS_PB), WSP(bf16_t, WS_WPP), M, 1024, 256}; EpiF<EpiStoreBf> E{{WSP(bf16_t, WS_PP)}}; gemm_phase<EpiF<EpiStoreBf>, DenseOrder>(ring, C.wave_s, g, S, E); }
        { Gemm g{WSP(bf16_t, WS_X2B), WSP(bf16_t, WS_WPG), M, 1024, 1024}; EpiF<EpiPle> E{{WSP(bf16_t, WS_PP), C.out}}; gemm_phase<EpiF<EpiPle>, DenseOrder>(ring, C.wave_s, g, S, E); } } SEAM(11);
    if (IN(12)) REPS(12) { REPBAR();  p11_final(C, MK_TS >= 0 ? 1.f + __hip_atomic_load((float*)(ctl + 2048), __ATOMIC_RELAXED, __HIP_MEMORY_SCOPE_AGENT) : 1.f); }
#undef IN
#undef SEAM
}

extern "C" void kernel_launch(void* const* d_in, const int* in_sizes, int n_in, void* d_out, int out_size, void* d_ws, size_t ws_size, hipStream_t stream) {
    static int grid = 0;
    if (grid == 0) {
        int dev = 0, cus = 0, per_cu = 0;
        if (hipGetDevice(&dev) != hipSuccess || hipDeviceGetAttribute(&cus, hipDeviceAttributeMultiprocessorCount, dev) != hipSuccess) { fprintf(stderr, "kernel_launch: device query failed\n"); grid = -1; return; }
        if (hipFuncSetAttribute((const void*)fwd, hipFuncAttributeMaxDynamicSharedMemorySize, LDS_BYTES) != hipSuccess) { fprintf(stderr, "kernel_launch: hipFuncSetAttribute failed\n"); grid = -1; return; }
        if (hipOccupancyMaxActiveBlocksPerMultiprocessor(&per_cu, (const void*)fwd, NWAVES * 64, LDS_BYTES) != hipSuccess || per_cu < 1) { fprintf(stderr, "kernel_launch: occupancy query says %d blocks/CU\n", per_cu); }
        (void)hipGetLastError();
        grid = cus;
    }
    if (grid < 0) return;
    (void)hipMemsetAsync((char*)d_ws + WS_CTL, 0, 1 * MiB, stream);
    Args a{};
    for (int i = 0; i < 22; ++i) a.in[i] = (const float*)d_in[i];
    a.out = (float*)d_out; a.ws = (unsigned char*)d_ws;
#if MK_PER_PHASE
    for (int p = 0; p < N_PHASES; ++p) { a.ph_lo = p; a.ph_hi = p + 1; hipLaunchKernelGGL(fwd, dim3(grid), dim3(NWAVES * 64), LDS_BYTES, stream, a); }
#else
    a.ph_lo = 0; a.ph_hi = N_PHASES; hipLaunchKernelGGL(fwd, dim3(grid), dim3(NWAVES * 64), LDS_BYTES, stream, a);
#endif
}
```
